# Optimizing an MI355X kernel written in HIP

```python
import jax, jax.numpy as jnp
from jax import lax
import numpy as np

D_MODEL = 2048
BATCH = 2
SEQ = 4096
DEPTH = 1

CHUNK = 64
D_CONV = 1024
CONV_WIDTH = 31
N_HEADS = 16
HEAD_DIM = 64
D_ATTN = N_HEADS * HEAD_DIM
IDX_HEADS = 16
IDX_DIM = 64
TOPK_MAX = 256
Q_BLOCK = 128
N_BRANCH = 2
D_FF = -(-8 * D_MODEL // (3 * 256)) * 256
EPS = 1e-6

SZ_GLU = 2 * D_CONV
SZ_IQ = IDX_HEADS * IDX_DIM
SZ_GATE = N_BRANCH * D_MODEL
OFF_1 = SZ_GLU
OFF_2 = OFF_1 + D_ATTN
OFF_3 = OFF_2 + D_ATTN
OFF_4 = OFF_3 + D_ATTN
OFF_5 = OFF_4 + SZ_IQ
OFF_6 = OFF_5 + IDX_DIM
OFF_7 = OFF_6 + IDX_HEADS
D_IN = OFF_7 + SZ_GATE

kernel_name = "hybrid_conformer_dsa_block"


def rms_norm(x, g):
    xf = x.astype(jnp.float32)
    y = xf * lax.rsqrt(jnp.mean(xf * xf, axis=-1, keepdims=True) + EPS)
    return (y * g.astype(jnp.float32)).astype(x.dtype)


def layer_norm(x, g, b):
    xf = x.astype(jnp.float32)
    mu = jnp.mean(xf, axis=-1, keepdims=True)
    var = jnp.mean(jnp.square(xf - mu), axis=-1, keepdims=True)
    y = (xf - mu) * lax.rsqrt(var + EPS)
    return (y * g.astype(jnp.float32) + b.astype(jnp.float32)).astype(x.dtype)


def conv_branch(u_glu, w_dw, b_dw, g_ln, b_ln, w_out):
    a, gt = jnp.split(u_glu, 2, axis=-1)
    u = a * jax.nn.sigmoid(gt)
    u = lax.conv_general_dilated(
        u, w_dw[:, None, :], window_strides=(1,),
        padding=[(CONV_WIDTH - 1, 0)],
        dimension_numbers=("NWC", "WIO", "NWC"),
        feature_group_count=D_CONV) + b_dw
    u = jax.nn.silu(layer_norm(u, g_ln, b_ln))
    return u @ w_out


def sparse_attn_branch(q, k, v, q_idx, k_idx, w_idx, w_out):
    B, S = q.shape[0], q.shape[1]
    topk = min(TOPK_MAX, S // 4)
    nblk = S // Q_BLOCK
    qb_all = q.reshape(B, nblk, Q_BLOCK, N_HEADS, HEAD_DIM).transpose(1, 0, 2, 3, 4)
    qi_all = q_idx.reshape(B, nblk, Q_BLOCK, IDX_HEADS, IDX_DIM).transpose(1, 0, 2, 3, 4)
    wi_all = w_idx.reshape(B, nblk, Q_BLOCK, IDX_HEADS).transpose(1, 0, 2, 3)
    k4 = k.reshape(B, S, N_HEADS, HEAD_DIM)
    v4 = v.reshape(B, S, N_HEADS, HEAD_DIM)
    k_idx_f = k_idx.astype(jnp.float32)
    key_chunk = jnp.arange(S) // CHUNK
    idx_scale = (IDX_DIM ** -0.5) * (IDX_HEADS ** -0.5)
    attn_scale = HEAD_DIM ** -0.5
    gather = jax.vmap(lambda t, i: t[i])

    def block(args):
        blk, qb, qib, wb = args
        pos = blk * Q_BLOCK + jnp.arange(Q_BLOCK)
        q_chunk = pos // CHUNK
        admissible = key_chunk[None, :] <= q_chunk[:, None]
        rel = jax.nn.relu(jnp.einsum("bqhd,bsd->bqhs", qib.astype(jnp.float32), k_idx_f))
        score = jnp.einsum("bqhs,bqh->bqs", rel, wb.astype(jnp.float32)) * idx_scale
        score = jnp.where(admissible[None], score, -jnp.inf)
        _, sel = lax.top_k(score, topk)
        valid = key_chunk[sel] <= q_chunk[None, :, None]
        k_sel = gather(k4, sel)
        v_sel = gather(v4, sel)
        logits = jnp.einsum("bqhd,bqkhd->bqhk", qb, k_sel).astype(jnp.float32) * attn_scale
        logits = jnp.where(valid[:, :, None, :], logits, -jnp.inf)
        p = jax.nn.softmax(logits, axis=-1).astype(v4.dtype)
        return jnp.einsum("bqhk,bqkhd->bqhd", p, v_sel)

    out = lax.map(block, (jnp.arange(nblk), qb_all, qi_all, wi_all))
    out = out.transpose(1, 0, 2, 3, 4).reshape(B, S, D_ATTN)
    return out @ w_out


def setup_inputs(seed: int = 0) -> dict:
    key = jax.random.key(seed)
    ks = jax.random.split(key, 20)
    f32 = jnp.float32

    def nrm(k, shape, fan_in, gain=1.0):
        return jax.random.normal(k, shape, f32) * (gain * fan_in ** -0.5)

    def ones_noise(k, shape):
        return 1.0 + 0.05 * jax.random.normal(k, shape, f32)

    L = DEPTH
    return {
        "x": jax.random.normal(ks[0], (BATCH, SEQ, D_MODEL), f32),
        "c": jax.random.normal(ks[1], (BATCH, D_MODEL), f32),
        "w_ada": nrm(ks[2], (L, D_MODEL, 6 * D_MODEL), D_MODEL, 0.5),
        "b_ada": 0.02 * jax.random.normal(ks[3], (L, 6 * D_MODEL), f32),
        "g_pre_mix": ones_noise(ks[4], (L, D_MODEL)),
        "w_in": nrm(ks[5], (L, D_MODEL, D_IN), D_MODEL),
        "w_dw": nrm(ks[6], (L, CONV_WIDTH, D_CONV), CONV_WIDTH),
        "b_dw": 0.02 * jax.random.normal(ks[7], (L, D_CONV), f32),
        "g_conv_ln": ones_noise(ks[8], (L, D_CONV)),
        "b_conv_ln": 0.02 * jax.random.normal(ks[9], (L, D_CONV), f32),
        "w_conv_out": nrm(ks[10], (L, D_CONV, D_MODEL), D_CONV),
        "w_attn_out": nrm(ks[11], (L, D_ATTN, D_MODEL), D_ATTN),
        "w_o": nrm(ks[12], (L, D_MODEL, D_MODEL), D_MODEL),
        "g_post_mix": ones_noise(ks[13], (L, D_MODEL)),
        "g_pre_ffn": ones_noise(ks[14], (L, D_MODEL)),
        "w_gate": nrm(ks[15], (L, D_MODEL, D_FF), D_MODEL),
        "w_up": nrm(ks[16], (L, D_MODEL, D_FF), D_MODEL),
        "w_down": nrm(ks[17], (L, D_FF, D_MODEL), D_FF),
        "g_post_ffn": ones_noise(ks[18], (L, D_MODEL)),
    }


def reference(x, c, w_ada, b_ada, g_pre_mix, w_in, w_dw, b_dw, g_conv_ln, b_conv_ln,
              w_conv_out, w_attn_out, w_o, g_post_mix, g_pre_ffn, w_gate, w_up, w_down,
              g_post_ffn):
    c_act = jax.nn.silu(c)
    for l in range(DEPTH):
        mod = c_act @ w_ada[l] + b_ada[l]
        sh1, sc1, gt1, sh2, sc2, gt2 = jnp.split(mod[:, None, :], 6, axis=-1)

        h = rms_norm(x, g_pre_mix[l]) * (1.0 + sc1) + sh1
        proj = h @ w_in[l]
        u_glu, q, k, v, qi, ki, wi, gates = jnp.split(
            proj, [OFF_1, OFF_2, OFF_3, OFF_4, OFF_5, OFF_6, OFF_7], axis=-1)
        y_conv = conv_branch(u_glu, w_dw[l], b_dw[l], g_conv_ln[l], b_conv_ln[l], w_conv_out[l])
        y_attn = sparse_attn_branch(q, k, v, qi, ki, wi, w_attn_out[l])
        g = jax.nn.sigmoid(gates.astype(jnp.float32)).astype(x.dtype)
        g_conv, g_attn = jnp.split(g, 2, axis=-1)
        mixed = (g_conv * y_conv + g_attn * y_attn) @ w_o[l]
        x = x + gt1 * rms_norm(mixed, g_post_mix[l])

        h = rms_norm(x, g_pre_ffn[l]) * (1.0 + sc2) + sh2
        f = (jax.nn.silu(h @ w_gate[l]) * (h @ w_up[l])) @ w_down[l]
        x = x + gt2 * rms_norm(f, g_post_ffn[l])
    return x
```

```cpp
#define MK_N_LAUNCHES 1
#include <hip/hip_runtime.h>
#include <cstdio>
#include <cstdint>
namespace pg8 {
#define PG8_LAS __attribute__((address_space(3)))
typedef unsigned short bf16_t;
typedef short bf16x8 __attribute__((ext_vector_type(8)));
typedef float f32x4 __attribute__((ext_vector_type(4)));
typedef unsigned u32x4 __attribute__((ext_vector_type(4)));
constexpr int BM = 256, BK = 64, HALF = 128, HTB = HALF * BK * 2  , STAGE_BYTES = 8 * HTB, NXCD = 8, WGM = 8;

__host__ __device__ __forceinline__ int lds_byte(int r, int c) { const int st = (r >> 4) * 2 + (c >> 5), rr = r & 15, cc = c & 31, ob = rr * 64 + cc * 2; return st * 1024 + (ob ^ (((ob >> 9) & 1) << 5)); }
__host__ __device__ __forceinline__ void stage_rc(int b, int& R, int& C) { const int st = b / 1024, sb = b % 1024, swz = sb ^ (((sb >> 9) & 1) << 5); R = (st >> 1) * 16 + swz / 64; C = (st & 1) * 32 + (swz % 64) / 2; }
__host__ __device__ __forceinline__ int perm32(int rho) { const int n = rho >> 4, i = rho & 15; return 8 * (i >> 2) + 4 * n + (i & 3); }

struct Unit { int pm, pn; };
struct Gemm { const bf16_t* A; const bf16_t* Bt; int M, N, K; };

struct StaticOrder {
    int nM, nN, nwg, G, c;
    __host__ __device__ void init(int M, int N, int G_, int c_) { nM = M / BM; nN = N / BM; nwg = nM * nN; G = G_; c = c_; }
    __host__ __device__ bool next(int i, Unit& u) const {
        const long L = (long)i * G + c; if (L >= nwg) return false;
        int wgid = (int)L; { const int q = nwg / NXCD, r = nwg % NXCD, xcd = wgid % NXCD, off = wgid / NXCD; wgid = (xcd < r ? xcd * (q + 1) : r * (q + 1) + (xcd - r) * q) + off; }
        const int nig = WGM * nN, gid = wgid / nig, fm = gid * WGM, gsz = (nM - fm) < WGM ? (nM - fm) : WGM;
        u.pm = fm + ((wgid % nig) % gsz); u.pn = (wgid % nig) / gsz; return true;
    }
    __device__ __forceinline__ void a_ready(const Unit&) const {}
    __device__ __forceinline__ void done(const Unit&) const {}
};

__device__ __forceinline__ unsigned cvt_pk_bf16(float lo, float hi) { unsigned r; asm volatile("v_cvt_pk_bf16_f32 %0, %1, %2" : "=v"(r) : "v"(lo), "v"(hi)); return r; }
typedef float f32x2 __attribute__((ext_vector_type(2)));
template <class Epi, class Sched, bool ALIGN_EPI = false, bool SP2 = false>
__device__ __forceinline__ void gemm_phase(PG8_LAS unsigned char* lds, const Gemm g, const Sched& S, const Epi& E) {
    const int tid = threadIdx.x, wid = __builtin_amdgcn_readfirstlane(tid >> 6), lane = tid & 63, wr = wid >> 2, wc = wid & 3, fr = lane & 15, fq = lane >> 4;
    const int K = g.K, nt = K / BK;
    unsigned voffA[2], voffB[2];
#pragma unroll
    for (int i = 0; i < 2; ++i) { int R, C; stage_rc(tid * 16 + i * 8192, R, C); const int Rb = Epi::PERM ? ((R & ~31) + perm32(R & 31)) : R;
        voffA[i] = (unsigned)(R * K + C) * 2u; voffB[i] = (unsigned)(Rb * K + C) * 2u; }
    const size_t kstep = (size_t)(BK * 2);
    const size_t hstep = (size_t)HALF * K * 2;
    const size_t tstep = 2 * hstep;
    const unsigned ldsw = (unsigned)wid * 1024u;
    const int aoff = lds_byte(wr * 64 + fr, fq * 8), boff = lds_byte(wc * 32 + fr, fq * 8);
#define PG8_SA(b, h) (((b) * 2 + (h)) * HTB)
#define PG8_SB(b, h) ((4 + (b) * 2 + (h)) * HTB)
#define PG8_STAGE(bufoff, gbase, voff) do { _Pragma("unroll") for (int _i = 0; _i < 2; ++_i) \
        __builtin_amdgcn_global_load_lds((const unsigned*)((const char*)(gbase) + (voff)[_i]), (PG8_LAS unsigned*)(lds + (bufoff) + ldsw + _i * 8192), 16, 0, 0); } while (0)
#define PG8_LDA(dst, b, h) do { _Pragma("unroll") for (int m = 0; m < 4; ++m) _Pragma("unroll") for (int k = 0; k < 2; ++k) dst[m][k] = *(const PG8_LAS bf16x8*)(lds + PG8_SA(b, h) + aoff + m * 2048 + k * 1024); } while (0)
#define PG8_LDB(dst, b, h) do { _Pragma("unroll") for (int n = 0; n < 2; ++n) _Pragma("unroll") for (int k = 0; k < 2; ++k) dst[n][k] = *(const PG8_LAS bf16x8*)(lds + PG8_SB(b, h) + boff + n * 2048 + k * 1024); } while (0)
#define PG8_MMA(ai, bj, At, Bt) do { __builtin_amdgcn_s_setprio(1); _Pragma("unroll") for (int m = 0; m < 4; ++m) _Pragma("unroll") for (int n = 0; n < 2; ++n) _Pragma("unroll") for (int k = 0; k < 2; ++k) \
        acc[ai][bj][m][n] = __builtin_amdgcn_mfma_f32_16x16x32_bf16(Bt[n][k], At[m][k], acc[ai][bj][m][n], 0, 0, 0); __builtin_amdgcn_s_setprio(0); } while (0)
#define PG8_WAIT_V(n) asm volatile("s_waitcnt vmcnt(" #n ")" ::: "memory")
#define PG8_WAIT_L(n) asm volatile("s_waitcnt lgkmcnt(" #n ")" ::: "memory")
#define PG8_BAR __builtin_amdgcn_s_barrier()
#define PG8_SCHED __builtin_amdgcn_sched_barrier(0)
    Unit cur, nxt; int ui = 0;
    if (!S.next(0, cur)) return;
    f32x4 acc[2][2][4][2];
#pragma unroll
    for (int a = 0; a < 2; ++a)
#pragma unroll
        for (int b = 0; b < 2; ++b)
#pragma unroll
            for (int m = 0; m < 4; ++m)
#pragma unroll
                for (int n = 0; n < 2; ++n) acc[a][b][m][n] = (f32x4){0.f, 0.f, 0.f, 0.f};
    bf16x8 At[4][2], B0[2][2], B1[2][2];
    const char* cA = (const char*)g.A + (size_t)cur.pm * tstep; const char* cB = (const char*)g.Bt + (size_t)cur.pn * tstep;
    S.a_ready(cur);
    if constexpr (SP2) {
        PG8_STAGE(PG8_SB(0, 0), cB, voffB); PG8_STAGE(PG8_SB(0, 1), cB + hstep, voffB); PG8_STAGE(PG8_SA(0, 0), cA, voffA); PG8_STAGE(PG8_SA(0, 1), cA + hstep, voffA);
        if (wr == 1) PG8_BAR;
        PG8_WAIT_V(2); PG8_BAR;
        PG8_STAGE(PG8_SB(1, 0), cB + kstep, voffB); PG8_STAGE(PG8_SA(1, 0), cA + kstep, voffA); PG8_STAGE(PG8_SB(1, 1), cB + hstep + kstep, voffB);
        PG8_WAIT_V(6); PG8_BAR;
    } else {
        PG8_STAGE(PG8_SB(0, 0), cB, voffB); PG8_STAGE(PG8_SA(0, 0), cA, voffA); PG8_STAGE(PG8_SB(0, 1), cB + hstep, voffB); PG8_STAGE(PG8_SA(0, 1), cA + hstep, voffA);
        if (wr == 1) PG8_BAR;
        PG8_WAIT_V(4); PG8_BAR;
        PG8_STAGE(PG8_SB(1, 0), cB + kstep, voffB); PG8_STAGE(PG8_SA(1, 0), cA + kstep, voffA); PG8_STAGE(PG8_SB(1, 1), cB + hstep + kstep, voffB);
        PG8_WAIT_V(6); PG8_BAR;
    }
    for (;;) {
        const bool has_next = S.next(ui + 1, nxt);
        const char* nA = has_next ? (const char*)g.A + (size_t)nxt.pm * tstep : cA; const char* nB = has_next ? (const char*)g.Bt + (size_t)nxt.pn * tstep : cB;
        for (int t = 0; t < nt; t += 2) {
            const bool last = (t == nt - 2);
            const char* a1 = cA + (size_t)(t + 1) * kstep;
            const char* a2 = last ? nA : cA + (size_t)(t + 2) * kstep; const char* b2 = last ? nB : cB + (size_t)(t + 2) * kstep;
            const char* a3 = a2 + kstep; const char* b3 = b2 + kstep;
            if (last && has_next) S.a_ready(nxt);
            if constexpr (SP2) {
            PG8_LDB(B0, 0, 0); PG8_LDB(B1, 0, 1); PG8_SCHED; PG8_LDA(At, 0, 0); PG8_STAGE(PG8_SA(1, 1), a1 + hstep, voffA);
            PG8_WAIT_V(8); PG8_WAIT_L(0); PG8_BAR; PG8_MMA(0, 0, At, B0); PG8_MMA(0, 1, At, B1); PG8_BAR; PG8_SCHED;
            PG8_LDA(At, 0, 1); PG8_STAGE(PG8_SB(0, 0), b2, voffB); PG8_STAGE(PG8_SB(0, 1), b2 + hstep, voffB); PG8_STAGE(PG8_SA(0, 0), a2, voffA);
            PG8_WAIT_V(8); PG8_WAIT_L(0); PG8_BAR; PG8_MMA(1, 0, At, B0); PG8_MMA(1, 1, At, B1); PG8_BAR; PG8_SCHED;
            PG8_LDB(B0, 1, 0); PG8_LDB(B1, 1, 1); PG8_SCHED; PG8_LDA(At, 1, 0); PG8_STAGE(PG8_SA(0, 1), a2 + hstep, voffA);
            PG8_WAIT_V(8); PG8_WAIT_L(0); PG8_BAR; PG8_MMA(0, 0, At, B0); PG8_MMA(0, 1, At, B1); PG8_BAR; PG8_SCHED;
            PG8_LDA(At, 1, 1); PG8_STAGE(PG8_SB(1, 0), b3, voffB); PG8_STAGE(PG8_SB(1, 1), b3 + hstep, voffB); PG8_STAGE(PG8_SA(1, 0), a3, voffA);
            PG8_WAIT_V(8); PG8_WAIT_L(0); PG8_BAR; PG8_MMA(1, 0, At, B0); PG8_MMA(1, 1, At, B1); PG8_BAR; PG8_SCHED;
            } else {
            PG8_LDB(B0, 0, 0); PG8_SCHED; PG8_LDA(At, 0, 0); PG8_STAGE(PG8_SA(1, 1), a1 + hstep, voffA);
            PG8_WAIT_L(8); PG8_BAR; PG8_WAIT_L(0); PG8_MMA(0, 0, At, B0); PG8_BAR; PG8_SCHED;
            PG8_LDB(B1, 0, 1); PG8_STAGE(PG8_SB(0, 0), b2, voffB);
            PG8_BAR; PG8_WAIT_L(0); PG8_MMA(0, 1, At, B1); PG8_BAR;
            PG8_LDA(At, 0, 1); PG8_STAGE(PG8_SA(0, 0), a2, voffA);
            PG8_BAR; PG8_WAIT_L(0); PG8_MMA(1, 0, At, B0); PG8_BAR; PG8_SCHED;
            PG8_STAGE(PG8_SB(0, 1), b2 + hstep, voffB);
            PG8_WAIT_V(6); PG8_BAR; PG8_MMA(1, 1, At, B1); PG8_BAR;
            PG8_LDB(B0, 1, 0); PG8_SCHED; PG8_LDA(At, 1, 0); PG8_STAGE(PG8_SA(0, 1), a2 + hstep, voffA);
            PG8_WAIT_L(8); PG8_BAR; PG8_WAIT_L(0); PG8_MMA(0, 0, At, B0); PG8_BAR; PG8_SCHED;
            PG8_LDB(B1, 1, 1); PG8_STAGE(PG8_SB(1, 0), b3, voffB);
            PG8_BAR; PG8_WAIT_L(0); PG8_MMA(0, 1, At, B1); PG8_BAR;
            PG8_LDA(At, 1, 1); PG8_STAGE(PG8_SA(1, 0), a3, voffA);
            PG8_BAR; PG8_WAIT_L(0); PG8_MMA(1, 0, At, B0); PG8_BAR; PG8_SCHED;
            PG8_STAGE(PG8_SB(1, 1), b3 + hstep, voffB);
            PG8_WAIT_V(6); PG8_BAR; PG8_MMA(1, 1, At, B1); PG8_BAR;
            }
        }
        if constexpr (ALIGN_EPI) { if (wr == 0) PG8_BAR; }
        if constexpr (!Epi::AFTER_DRAIN) { E(acc, cur, wr, wc, fr, fq); S.done(cur); }
        if (!has_next) break;
#pragma unroll
        for (int a = 0; a < 2; ++a)
#pragma unroll
            for (int b = 0; b < 2; ++b)
#pragma unroll
                for (int m = 0; m < 4; ++m)
#pragma unroll
                    for (int n = 0; n < 2; ++n) acc[a][b][m][n] = (f32x4){0.f, 0.f, 0.f, 0.f};
        cur = nxt; cA = nA; cB = nB; ++ui;
        if constexpr (ALIGN_EPI) { if (wr == 1) PG8_BAR; }
    }
    PG8_WAIT_V(0);
    if constexpr (!ALIGN_EPI) { if (wr == 0) PG8_BAR; }
    PG8_BAR;
    if constexpr (Epi::AFTER_DRAIN) { E.fused(acc, cur, wr, wc, fr, fq, lds, wid, lane); S.done(cur); }
#undef PG8_SA
#undef PG8_SB
#undef PG8_STAGE
#undef PG8_LDA
#undef PG8_LDB
#undef PG8_MMA
#undef PG8_WAIT_V
#undef PG8_WAIT_L
#undef PG8_BAR
#undef PG8_SCHED
}
}
#define GAS __attribute__((address_space(1)))
#define LAS __attribute__((address_space(3)))
typedef unsigned short bf16;
typedef unsigned v4u __attribute__((ext_vector_type(4)));
typedef float f32x4 __attribute__((ext_vector_type(4)));
typedef short bf16x8 __attribute__((ext_vector_type(8)));
typedef GAS unsigned gu32;
typedef GAS unsigned long long gu64;
#define RLX_AGENT __ATOMIC_RELAXED, __HIP_MEMORY_SCOPE_AGENT
#define LDS_WAIT() asm volatile("s_waitcnt lgkmcnt(0)" ::: "memory")
#define VM_WAIT() asm volatile("s_waitcnt vmcnt(0)" ::: "memory")
__device__ __forceinline__ unsigned long long rt() { return __builtin_amdgcn_s_memrealtime(); }
__device__ __forceinline__ unsigned f2bf(float f) { unsigned u = __builtin_bit_cast(unsigned, f); return (u + 0x7fffu + ((u >> 16) & 1u)) >> 16; }
__device__ __forceinline__ unsigned pk2(float lo, float hi) { return f2bf(lo) | (f2bf(hi) << 16); }
#define XB_TMO      128
#define XB_XCNT(j)  (256  + 64 * (j))
#define XB_XSUB(j)  (1280 + 64 * (j))
#define XB_XGEN(j)  (2304 + 64 * (j))
#define XB_TOP      3328
#define XB_TOPGEN   3392
#define XCD_BAR_WORDS 3456
#define XB_SPIN_CAP (1u << 18)

__device__ __forceinline__ unsigned xb_ld(unsigned* p)              { return __hip_atomic_load(p, __ATOMIC_RELAXED, __HIP_MEMORY_SCOPE_AGENT); }
__device__ __forceinline__ unsigned xb_add(unsigned* p, unsigned v) { return __hip_atomic_fetch_add(p, v, __ATOMIC_RELAXED, __HIP_MEMORY_SCOPE_AGENT); }
__device__ __forceinline__ unsigned xb_xcc_id() { return (unsigned)__builtin_amdgcn_s_getreg((3 << 11) | 20) & 0xFu; }
#define XB_SPIN(cond, bar) do { unsigned _sp = 0; while (cond) { __builtin_amdgcn_s_sleep(1); \
    if ((++_sp & 255u) == 0u) { if (xb_ld(&(bar)[XB_TMO])) break; if (_sp > XB_SPIN_CAP) { atomicAdd(&(bar)[XB_TMO], 1u); break; } } } } while (0)

struct XcdBarrier {
    unsigned* bar; unsigned x;
    volatile LAS unsigned* st;
};

__device__ __forceinline__ XcdBarrier xcd_barrier_post(unsigned* bar, volatile LAS unsigned* st) {
    XcdBarrier b; b.bar = bar; b.x = xb_xcc_id(); b.st = st;
    if (threadIdx.x == 0) (void)xb_add(&bar[XB_XCNT(b.x)], 1u);
    return b;
}
__device__ __forceinline__ void xcd_barrier_complete(unsigned* bar, unsigned x, unsigned& nloc, unsigned& nx) {
    const unsigned G = gridDim.x * gridDim.y * gridDim.z;
    unsigned sum, cnt, mine, sp = 0u;
    for (;;) {
        sum = 0u; cnt = 0u; mine = 0u;
#pragma unroll
        for (unsigned j = 0; j < 16; ++j) { const unsigned c = xb_ld(&bar[XB_XCNT(j)]); sum += c; cnt += (c > 0u) ? 1u : 0u; mine = (j == x) ? c : mine; }
        if (sum == G) break;
        __builtin_amdgcn_s_sleep(1);
        if ((++sp & 255u) == 0u) { if (xb_ld(&bar[XB_TMO])) break; if (sp > XB_SPIN_CAP) { atomicAdd(&bar[XB_TMO], 1u); break; } }
    }
    nloc = mine > 0u ? mine : 1u; nx = cnt > 0u ? cnt : 1u;
}

__device__ __forceinline__ void xcd_barrier(const XcdBarrier& b) {
    asm volatile("s_waitcnt vmcnt(0)" ::: "memory");
    __syncthreads();
    if (threadIdx.x == 0) {
        unsigned* bar = b.bar;
        __builtin_amdgcn_s_waitcnt(0);
        unsigned nloc = b.st[0], nx = b.st[1];
        if (nloc == 0u) { xcd_barrier_complete(bar, b.x, nloc, nx); b.st[0] = nloc; b.st[1] = nx; }
        const unsigned old = xb_add(&bar[XB_XSUB(b.x)], 1u);
        const unsigned gen = old / nloc;
        if (old + 1u == (gen + 1u) * nloc) {
            __builtin_amdgcn_fence(__ATOMIC_RELEASE, "agent");
            asm volatile("s_waitcnt vmcnt(0)" ::: "memory");
            const unsigned og = xb_add(&bar[XB_TOP], 1u);
            const unsigned tg = og / nx;
            if (og + 1u == (tg + 1u) * nx) xb_add(&bar[XB_TOPGEN], 1u);
            else XB_SPIN(xb_ld(&bar[XB_TOPGEN]) == tg, bar);
            __builtin_amdgcn_fence(__ATOMIC_ACQUIRE, "agent");
            xb_add(&bar[XB_XGEN(b.x)], 1u);
            asm volatile("s_waitcnt vmcnt(0)" ::: "memory");
        } else {
            XB_SPIN(xb_ld(&bar[XB_XGEN(b.x)]) == gen, bar);
            __builtin_amdgcn_fence(__ATOMIC_ACQUIRE, "agent");
            asm volatile("s_waitcnt vmcnt(0)" ::: "memory");
        }
    }
    __syncthreads();
}
constexpr int NWAVES = 8;
constexpr int DM = 2048, NBATCH = 2, SEQ = 4096, MTOK = NBATCH * SEQ;
constexpr int DCONV = 1024, CONVW = 31, NHEAD = 16, HDIM = 64, TOPK = 256, DFF = 5632;
constexpr int OFF_GLU = 0, OFF_Q = 2048, OFF_K = 3072, OFF_V = 4096, OFF_QI = 5120, OFF_KI = 6144, OFF_WI = 6208, OFF_G = 6224, D_IN = 10320;
constexpr int NP = 10496;
constexpr int NGU = 2 * DFF;
constexpr int KSPLIT = 32, NMOD = 6 * DM;
constexpr float EPS = 1e-6f;
constexpr float LOG2E = 1.4426950408889634f;

constexpr size_t MiB = 1u << 20;
constexpr size_t WS_CTL = 0, CTL_ZERO_BYTES = 1 * MiB;
constexpr size_t WS_MODP = 1 * MiB;
constexpr size_t WS_MODF = 4 * MiB;
constexpr size_t WS_BT_GU = 5 * MiB;
constexpr size_t WS_BT_DN = 49 * MiB;
constexpr size_t WS_BT_O = 71 * MiB;
constexpr size_t WS_BT_CO = 79 * MiB;
constexpr size_t WS_BT_AO = 83 * MiB;
constexpr size_t WS_BT_IN = 87 * MiB;
constexpr size_t WS_H = 128 * MiB;
constexpr size_t WS_PROJ = 160 * MiB;
constexpr size_t WS_CACT = 324 * MiB;
constexpr size_t WS_AOUT = 340 * MiB;
constexpr size_t WS_VT = 356 * MiB;
constexpr size_t WS_MASK = 372 * MiB;
constexpr size_t WS_END = 376 * MiB;
constexpr size_t WS_SCORES = 87 * MiB;
constexpr size_t WS_MERGED = 96 * MiB;
constexpr size_t WS_GU = 160 * MiB;
constexpr size_t WS_F = 248 * MiB;
constexpr int CW_BAR = 4096;

constexpr int RING_OFF = 0, RING_BYTES = 131072;
constexpr int LDSCTL_OFF = RING_BYTES, MISC_OFF = LDSCTL_OFF + 320;
constexpr int LDS_BYTES = 147456;

typedef float f32x16 __attribute__((ext_vector_type(16)));
typedef float f32x2v __attribute__((ext_vector_type(2)));
typedef unsigned u32x2v __attribute__((ext_vector_type(2)));

__device__ __forceinline__ float bf_lo(unsigned u) { return __builtin_bit_cast(float, u << 16); }
__device__ __forceinline__ float bf_hi(unsigned u) { return __builtin_bit_cast(float, u & 0xffff0000u); }
__device__ __forceinline__ float sigmoidf_fast(float v) { return __builtin_amdgcn_rcpf(1.0f + __builtin_amdgcn_exp2f(-v * LOG2E)); }
__device__ __forceinline__ float wave_sum(float v) {
#pragma unroll
    for (int o = 1; o < 64; o <<= 1) v += __shfl_xor(v, o);
    return v;
}

struct EpiStoreBf16 {
    static constexpr bool PERM = true, AFTER_DRAIN = false;
    bf16* O; int ldc;
    __device__ __forceinline__ void operator()(const f32x4 (&acc)[2][2][4][2], const pg8::Unit& u, int wr, int wc, int fr, int fq) const {
        const int row0 = u.pm * pg8::BM + wr * 64 + fr, col0 = u.pn * pg8::BM + wc * 32 + 8 * fq;
#pragma unroll
        for (int ai = 0; ai < 2; ++ai)
#pragma unroll
            for (int m = 0; m < 4; ++m) { bf16* rowp = O + (size_t)(row0 + ai * pg8::HALF + m * 16) * ldc + col0;
#pragma unroll
                for (int bj = 0; bj < 2; ++bj) { const f32x4 v0 = acc[ai][bj][m][0], v1 = acc[ai][bj][m][1];
                    v4u w; w.x = pg8::cvt_pk_bf16(v0[0], v0[1]); w.y = pg8::cvt_pk_bf16(v0[2], v0[3]); w.z = pg8::cvt_pk_bf16(v1[0], v1[1]); w.w = pg8::cvt_pk_bf16(v1[2], v1[3]);
                    *(v4u*)(rowp + bj * pg8::HALF) = w; } }
    }
};
struct EpiStoreF32 {
    static constexpr bool PERM = false, AFTER_DRAIN = false;
    float* C; int ldc;
    __device__ __forceinline__ void operator()(const f32x4 (&acc)[2][2][4][2], const pg8::Unit& u, int wr, int wc, int fr, int fq) const {
        const int row0 = u.pm * pg8::BM + wr * 64 + fr, col0 = u.pn * pg8::BM + wc * 32 + 4 * fq;
#pragma unroll
        for (int ai = 0; ai < 2; ++ai)
#pragma unroll
            for (int m = 0; m < 4; ++m) { float* rowp = C + (size_t)(row0 + ai * pg8::HALF + m * 16) * ldc + col0;
#pragma unroll
                for (int bj = 0; bj < 2; ++bj)
#pragma unroll
                    for (int n = 0; n < 2; ++n) *(f32x4*)(rowp + bj * pg8::HALF + n * 16) = acc[ai][bj][m][n]; }
    }
};
struct EpiGateConv {
    static constexpr bool PERM = true, AFTER_DRAIN = false;
    float* C; const bf16* G; int ldg;
    __device__ __forceinline__ void operator()(const f32x4 (&acc)[2][2][4][2], const pg8::Unit& u, int wr, int wc, int fr, int fq) const {
        const int row0 = u.pm * pg8::BM + wr * 64 + fr, col0 = u.pn * pg8::BM + wc * 32 + 8 * fq;
#pragma unroll
        for (int ai = 0; ai < 2; ++ai)
#pragma unroll
            for (int m = 0; m < 4; ++m) { const int row = row0 + ai * pg8::HALF + m * 16; float* rowp = C + (size_t)row * DM + col0; const bf16* gp = G + (size_t)row * ldg + col0;
#pragma unroll
                for (int bj = 0; bj < 2; ++bj) { const v4u g = *(const v4u*)(gp + bj * pg8::HALF); const f32x4 a0 = acc[ai][bj][m][0], a1 = acc[ai][bj][m][1];
                    f32x4 o0, o1;
                    o0[0] = a0[0] * sigmoidf_fast(bf_lo(g.x)); o0[1] = a0[1] * sigmoidf_fast(bf_hi(g.x)); o0[2] = a0[2] * sigmoidf_fast(bf_lo(g.y)); o0[3] = a0[3] * sigmoidf_fast(bf_hi(g.y));
                    o1[0] = a1[0] * sigmoidf_fast(bf_lo(g.z)); o1[1] = a1[1] * sigmoidf_fast(bf_hi(g.z)); o1[2] = a1[2] * sigmoidf_fast(bf_lo(g.w)); o1[3] = a1[3] * sigmoidf_fast(bf_hi(g.w));
                    *(f32x4*)(rowp + bj * pg8::HALF) = o0; *(f32x4*)(rowp + bj * pg8::HALF + 4) = o1; } }
    }
};
struct EpiGateAttn {
    static constexpr bool PERM = true, AFTER_DRAIN = false;
    const float* T; const bf16* G; int ldg; bf16* O;
    __device__ __forceinline__ void operator()(const f32x4 (&acc)[2][2][4][2], const pg8::Unit& u, int wr, int wc, int fr, int fq) const {
        const int row0 = u.pm * pg8::BM + wr * 64 + fr, col0 = u.pn * pg8::BM + wc * 32 + 8 * fq;
#pragma unroll
        for (int ai = 0; ai < 2; ++ai)
#pragma unroll
            for (int m = 0; m < 4; ++m) { const int row = row0 + ai * pg8::HALF + m * 16; const float* tp = T + (size_t)row * DM + col0; const bf16* gp = G + (size_t)row * ldg + col0; bf16* op = O + (size_t)row * DM + col0;
#pragma unroll
                for (int bj = 0; bj < 2; ++bj) { const v4u g = *(const v4u*)(gp + bj * pg8::HALF); const f32x4 t0 = *(const f32x4*)(tp + bj * pg8::HALF), t1 = *(const f32x4*)(tp + bj * pg8::HALF + 4);
                    const f32x4 a0 = acc[ai][bj][m][0], a1 = acc[ai][bj][m][1];
                    const float o0 = t0[0] + a0[0] * sigmoidf_fast(bf_lo(g.x)), o1 = t0[1] + a0[1] * sigmoidf_fast(bf_hi(g.x)), o2 = t0[2] + a0[2] * sigmoidf_fast(bf_lo(g.y)), o3 = t0[3] + a0[3] * sigmoidf_fast(bf_hi(g.y));
                    const float o4 = t1[0] + a1[0] * sigmoidf_fast(bf_lo(g.z)), o5 = t1[1] + a1[1] * sigmoidf_fast(bf_hi(g.z)), o6 = t1[2] + a1[2] * sigmoidf_fast(bf_lo(g.w)), o7 = t1[3] + a1[3] * sigmoidf_fast(bf_hi(g.w));
                    v4u w; w.x = pg8::cvt_pk_bf16(o0, o1); w.y = pg8::cvt_pk_bf16(o2, o3); w.z = pg8::cvt_pk_bf16(o4, o5); w.w = pg8::cvt_pk_bf16(o6, o7);
                    *(v4u*)(op + bj * pg8::HALF) = w; } }
    }
};
struct EpiSwiGLU {
    static constexpr bool PERM = true, AFTER_DRAIN = false;
    bf16* O;
    __device__ __forceinline__ void operator()(const f32x4 (&acc)[2][2][4][2], const pg8::Unit& u, int wr, int wc, int fr, int fq) const {
        const int row0 = u.pm * pg8::BM + wr * 64 + fr, col0 = (u.pn * pg8::BM + wc * 32 + 8 * fq) >> 1;
#pragma unroll
        for (int ai = 0; ai < 2; ++ai)
#pragma unroll
            for (int m = 0; m < 4; ++m) { bf16* rowp = O + (size_t)(row0 + ai * pg8::HALF + m * 16) * DFF + col0;
#pragma unroll
                for (int bj = 0; bj < 2; ++bj) { const f32x4 g = acc[ai][bj][m][0], up = acc[ai][bj][m][1];
                    const float h0 = g[0] * sigmoidf_fast(g[0]) * up[0], h1 = g[1] * sigmoidf_fast(g[1]) * up[1], h2 = g[2] * sigmoidf_fast(g[2]) * up[2], h3 = g[3] * sigmoidf_fast(g[3]) * up[3];
                    u32x2v w; w.x = pg8::cvt_pk_bf16(h0, h1); w.y = pg8::cvt_pk_bf16(h2, h3);
                    *(u32x2v*)(rowp + bj * (pg8::HALF / 2)) = w; } }
    }
};

struct Frame {
    LAS unsigned char* lds;
    volatile LAS unsigned* MISC;
    gu32* ctl;
    int tid, lane, wave, G, bid;
    const float* in[19]; float* out; unsigned char* ws;
};
enum { I_X = 0, I_C, I_WADA, I_BADA, I_GPREMIX, I_WIN, I_WDW, I_BDW, I_GLN, I_BLN, I_WCO, I_WAO, I_WO, I_GPOSTMIX, I_GPREFFN, I_WGATE, I_WUP, I_WDOWN, I_GPOSTFFN };

template <int MODE>
__device__ __forceinline__ void p0_transpose_item(const float* W, int K, int N, bf16* WT, int row_off, LAS float* scr, int item, int lane) {
    const int nblk = (N + 31) / 32, kb = item / nblk, nb = item % nblk, k0 = 64 * kb, n0 = 32 * nb;
    const int nn = n0 + (lane & 31); const bool nok = nn < N;
#pragma unroll 8
    for (int i = 0; i < 32; ++i) { const int kk = 2 * i + (lane >> 5); scr[kk * 33 + (lane & 31)] = nok ? W[(size_t)(k0 + kk) * N + nn] : 0.f; }
    LDS_WAIT(); asm volatile("" ::: "memory");
    const int c = lane & 7;
#pragma unroll
    for (int j = 0; j < 4; ++j) { const int n = (lane >> 3) + 8 * j; const LAS float* s = scr + (8 * c) * 33 + n;
        v4u o; o.x = pk2(s[0 * 33], s[1 * 33]); o.y = pk2(s[2 * 33], s[3 * 33]); o.z = pk2(s[4 * 33], s[5 * 33]); o.w = pk2(s[6 * 33], s[7 * 33]);
        const int gn = n0 + n;
        if (gn < N) { const int dr = (MODE == 0) ? (row_off + gn) : (8 * (gn >> 2) + (gn & 3) + row_off);
            *(GAS v4u*)(WT + (size_t)dr * K + k0 + 8 * c) = o; } }
    LDS_WAIT(); asm volatile("" ::: "memory");
}

__device__ __forceinline__ void p0_prologue(Frame& F) {
    const int gw = F.bid * NWAVES + F.wave, NGW = F.G * NWAVES;
    {
        const float* c = F.in[I_C]; const float* wada = F.in[I_WADA]; float* modp = (float*)(F.ws + WS_MODP);
        for (int unit = gw; unit < KSPLIT * (NMOD / 256); unit += NGW) {
            const int ks = unit / (NMOD / 256), nt = unit % (NMOD / 256), k0 = 64 * ks, col0 = 256 * nt + 4 * F.lane;
            const float c0 = c[k0 + F.lane], c1 = c[DM + k0 + F.lane];
            const float s0 = c0 / (1.0f + __expf(-c0)), s1 = c1 / (1.0f + __expf(-c1));
            f32x4 a0 = {0.f, 0.f, 0.f, 0.f}, a1 = {0.f, 0.f, 0.f, 0.f};
            const float* wp = wada + (size_t)k0 * NMOD + col0;
            for (int kk0 = 0; kk0 < 64; kk0 += 16) {
                f32x4 w[16];
#pragma unroll
                for (int q = 0; q < 16; ++q) w[q] = __builtin_nontemporal_load((const f32x4*)(wp + (size_t)(kk0 + q) * NMOD));
#pragma unroll
                for (int q = 0; q < 16; ++q) { const float t0 = __builtin_bit_cast(float, __builtin_amdgcn_readlane(__builtin_bit_cast(int, s0), kk0 + q)), t1 = __builtin_bit_cast(float, __builtin_amdgcn_readlane(__builtin_bit_cast(int, s1), kk0 + q)); a0 += t0 * w[q]; a1 += t1 * w[q]; }
            }
            *(f32x4*)(modp + (size_t)(ks * 2 + 0) * NMOD + col0) = a0;
            *(f32x4*)(modp + (size_t)(ks * 2 + 1) * NMOD + col0) = a1;
        }
    }
    LAS float* scr = (LAS float*)(F.lds + RING_OFF + F.wave * 16384);
    bf16* bt_in = (bf16*)(F.ws + WS_BT_IN); bf16* bt_gu = (bf16*)(F.ws + WS_BT_GU); bf16* bt_dn = (bf16*)(F.ws + WS_BT_DN);
    bf16* bt_o = (bf16*)(F.ws + WS_BT_O); bf16* bt_co = (bf16*)(F.ws + WS_BT_CO); bf16* bt_ao = (bf16*)(F.ws + WS_BT_AO);
    constexpr int I_IN = (DM / 64) * ((D_IN + 31) / 32), I_GT = (DM / 64) * (DFF / 32), I_DN = (DFF / 64) * (DM / 32), I_O = (DM / 64) * (DM / 32), I_CO = (DCONV / 64) * (DM / 32);
    constexpr int NITEMS = I_IN + 2 * I_GT + I_DN + I_O + 2 * I_CO;
    for (int it = gw; it < NITEMS; it += NGW) {
        int r = it;
        if (r < I_IN) { p0_transpose_item<0>(F.in[I_WIN], DM, D_IN, bt_in, 0, scr, r, F.lane); continue; } r -= I_IN;
        if (r < I_GT) { p0_transpose_item<1>(F.in[I_WGATE], DM, DFF, bt_gu, 0, scr, r, F.lane); continue; } r -= I_GT;
        if (r < I_GT) { p0_transpose_item<1>(F.in[I_WUP], DM, DFF, bt_gu, 4, scr, r, F.lane); continue; } r -= I_GT;
        if (r < I_DN) { p0_transpose_item<0>(F.in[I_WDOWN], DFF, DM, bt_dn, 0, scr, r, F.lane); continue; } r -= I_DN;
        if (r < I_O) { p0_transpose_item<0>(F.in[I_WO], DM, DM, bt_o, 0, scr, r, F.lane); continue; } r -= I_O;
        if (r < I_CO) { p0_transpose_item<0>(F.in[I_WCO], DCONV, DM, bt_co, 0, scr, r, F.lane); continue; } r -= I_CO;
        p0_transpose_item<0>(F.in[I_WAO], DCONV, DM, bt_ao, 0, scr, r, F.lane);
    }
    {
        GAS v4u* z = (GAS v4u*)(bt_in + (size_t)D_IN * DM); const int nz = (NP - D_IN) * DM * 2 / 16;
        for (int i = F.bid * (NWAVES * 64) + F.tid; i < nz; i += F.G * NWAVES * 64) z[i] = (v4u){0u, 0u, 0u, 0u};
    }
}

__device__ __forceinline__ float mod_sum(const float* modp, const float* bada, int bb, int col) {
    float s = bada[col];
#pragma unroll 8
    for (int ks = 0; ks < KSPLIT; ++ks) s += modp[(size_t)(ks * 2 + bb) * NMOD + col];
    return s;
}
__device__ __forceinline__ void p1_h1(Frame& F) {
    const float* modp = (const float*)(F.ws + WS_MODP); float* modf = (float*)(F.ws + WS_MODF); const float* bada = F.in[I_BADA];
    LAS float* scaleL = (LAS float*)(F.lds + RING_OFF); LAS float* shiftL = scaleL + DM;
    bf16* H = (bf16*)(F.ws + WS_H);
    for (int idx = F.bid * (NWAVES * 64) + F.tid; idx < 2 * NMOD; idx += F.G * NWAVES * 64) { const int bb = idx / NMOD, col = idx % NMOD; modf[idx] = mod_sum(modp, bada, bb, col); }
    for (int tile = F.bid; tile < MTOK / 32; tile += F.G) {
        const int bb = tile / (SEQ / 32);
        __syncthreads();
        for (int j = 0; j < 8; ++j) { const int col = F.tid + 512 * j; const float s = mod_sum(modp, bada, bb, col);
            if (col < DM) shiftL[col] = s; else scaleL[col - DM] = F.in[I_GPREMIX][col - DM] * (1.0f + s); }
        __syncthreads();
        for (int i = 0; i < 4; ++i) {
            const int row = tile * 32 + F.wave * 4 + i;
            const f32x4* xr = (const f32x4*)(F.in[I_X] + (size_t)row * DM) + F.lane;
            f32x4 v[8]; float ss = 0.f;
#pragma unroll
            for (int j = 0; j < 8; ++j) { v[j] = xr[64 * j]; ss += (v[j][0] * v[j][0] + v[j][1] * v[j][1]) + (v[j][2] * v[j][2] + v[j][3] * v[j][3]); }
            const float rstd = 1.0f / sqrtf(wave_sum(ss) * (1.0f / DM) + EPS);
            unsigned long long* o8 = (unsigned long long*)(H + (size_t)row * DM) + F.lane;
#pragma unroll
            for (int j = 0; j < 8; ++j) { const f32x4 sc = *(const LAS f32x4*)(scaleL + 4 * F.lane + 256 * j), sh = *(const LAS f32x4*)(shiftL + 4 * F.lane + 256 * j);
                const f32x4 h = v[j] * rstd * sc + sh;
                o8[64 * j] = (unsigned long long)pk2(h[0], h[1]) | ((unsigned long long)pk2(h[2], h[3]) << 32); }
        }
    }
    __syncthreads();
}

template <int II> struct ConvLoop {
    static __device__ __forceinline__ void run(f32x2v (&acc)[32], const f32x2v (&w)[CONVW], const bf16* PROJ, int bb, int s0, int ch) {
        const int sin = s0 - 30 + II; const int sc = sin < 0 ? 0 : sin; const float ok = sin < 0 ? 0.f : 1.f;
        const bf16* rp = PROJ + (size_t)(bb * SEQ + sc) * NP + OFF_GLU + ch;
        const unsigned a2 = *(const unsigned*)rp, g2 = *(const unsigned*)(rp + DCONV);
        f32x2v u; u.x = ok * bf_lo(a2) * sigmoidf_fast(bf_lo(g2)); u.y = ok * bf_hi(a2) * sigmoidf_fast(bf_hi(g2));
        constexpr int lo = II > 30 ? II - 30 : 0, hi = II < 31 ? II : 31;
#pragma unroll
        for (int o = lo; o <= hi; ++o) acc[o] += w[II - o] * u;
        if ((II & 7) == 7) asm volatile("" ::: "memory");
        ConvLoop<II + 1>::run(acc, w, PROJ, bb, s0, ch);
    }
};
template <> struct ConvLoop<62> { static __device__ __forceinline__ void run(f32x2v (&)[32], const f32x2v (&)[CONVW], const bf16*, int, int, int) {} };

__device__ __forceinline__ void p3_conv_tile(Frame& F, int tile) {
    const bf16* PROJ = (const bf16*)(F.ws + WS_PROJ); bf16* CACT = (bf16*)(F.ws + WS_CACT);
    LAS float* red = (LAS float*)(F.lds + RING_OFF);
    LAS float* stat = red + 8 * 64;
    const int bb = tile / (SEQ / 32), s0 = (tile % (SEQ / 32)) * 32, ch = 2 * F.tid;
    f32x2v w[CONVW];
#pragma unroll
    for (int j = 0; j < CONVW; ++j) w[j] = *(const f32x2v*)(F.in[I_WDW] + j * DCONV + ch);
    f32x2v acc[32];
#pragma unroll
    for (int o = 0; o < 32; ++o) acc[o] = (f32x2v){0.f, 0.f};
    ConvLoop<0>::run(acc, w, PROJ, bb, s0, ch);
    const f32x2v bdw = *(const f32x2v*)(F.in[I_BDW] + ch);
    float vals[64];
#pragma unroll
    for (int o = 0; o < 32; ++o) { acc[o] += bdw; vals[2 * o] = acc[o].x + acc[o].y; vals[2 * o + 1] = acc[o].x * acc[o].x + acc[o].y * acc[o].y; }
#define BFLY(d, n) do { const bool up = (F.lane & (d)) != 0; _Pragma("unroll") for (int k = 0; k < (n); ++k) { const float send = up ? vals[k] : vals[k + (n)], keep = up ? vals[k + (n)] : vals[k]; vals[k] = keep + __shfl_xor(send, (d)); } } while (0)
    BFLY(32, 32); BFLY(16, 16); BFLY(8, 8); BFLY(4, 4); BFLY(2, 2); BFLY(1, 1);
#undef BFLY
    __syncthreads();
    red[F.wave * 64 + F.lane] = vals[0];
    __syncthreads();
    if (F.tid < 32) { float s = 0.f, q = 0.f;
#pragma unroll
        for (int wv = 0; wv < 8; ++wv) { s += red[wv * 64 + 2 * F.tid]; q += red[wv * 64 + 2 * F.tid + 1]; }
        const float mean = s * (1.0f / DCONV), var = q * (1.0f / DCONV) - mean * mean;
        stat[2 * F.tid] = mean; stat[2 * F.tid + 1] = 1.0f / sqrtf(var + EPS); }
    __syncthreads();
    const f32x2v gl = *(const f32x2v*)(F.in[I_GLN] + ch), bl = *(const f32x2v*)(F.in[I_BLN] + ch);
#pragma unroll
    for (int o = 0; o < 32; ++o) { const float mean = stat[2 * o], rstd = stat[2 * o + 1];
        const float z0 = (acc[o].x - mean) * rstd * gl.x + bl.x, z1 = (acc[o].y - mean) * rstd * gl.y + bl.y;
        *(unsigned*)(CACT + (size_t)(bb * SEQ + s0 + o) * DCONV + ch) = pg8::cvt_pk_bf16(z0 * sigmoidf_fast(z0), z1 * sigmoidf_fast(z1)); }
}

__device__ __forceinline__ void p3_indexer_unit(Frame& F, int p, float* scratch) {
    const bf16* PROJ = (const bf16*)(F.ws + WS_PROJ); unsigned long long* MASK = (unsigned long long*)(F.ws + WS_MASK);
    const int bb = p & 1, sp = p >> 1, q0 = bb * SEQ + 2 * sp, c = (2 * sp) >> 6, nj = c + 1, ntile = 2 * nj;
    const int lane = F.lane, rho = lane & 31, hh = lane >> 5, e = (rho >> 2) & 1, hd = (rho & 3) + 4 * (rho >> 3);
    bf16x8 A[4];
    { const bf16* qrow = PROJ + (size_t)(q0 + e) * NP + OFF_QI + hd * 64 + 8 * hh;
#pragma unroll
      for (int s = 0; s < 4; ++s) A[s] = *(const bf16x8*)(qrow + 16 * s); }
    float wv[16];
    { const v4u* wrow = (const v4u*)(PROJ + (size_t)(q0 + hh) * NP + OFF_WI); const v4u w0 = wrow[0], w1 = wrow[1];
      const float sc = 0.03125f;
      wv[0] = bf_lo(w0.x) * sc; wv[1] = bf_hi(w0.x) * sc; wv[2] = bf_lo(w0.y) * sc; wv[3] = bf_hi(w0.y) * sc; wv[4] = bf_lo(w0.z) * sc; wv[5] = bf_hi(w0.z) * sc; wv[6] = bf_lo(w0.w) * sc; wv[7] = bf_hi(w0.w) * sc;
      wv[8] = bf_lo(w1.x) * sc; wv[9] = bf_hi(w1.x) * sc; wv[10] = bf_lo(w1.y) * sc; wv[11] = bf_hi(w1.y) * sc; wv[12] = bf_lo(w1.z) * sc; wv[13] = bf_hi(w1.z) * sc; wv[14] = bf_lo(w1.w) * sc; wv[15] = bf_hi(w1.w) * sc; }
    const bf16* kbase = PROJ + (size_t)(bb * SEQ + rho) * NP + OFF_KI + 8 * hh;
    float* scp = scratch + hh * SEQ + rho;
#pragma unroll 2
    for (int kt = 0; kt < ntile; ++kt) {
        const bf16* kp = kbase + (size_t)kt * 32 * NP;
        bf16x8 B[4];
#pragma unroll
        for (int s = 0; s < 4; ++s) B[s] = *(const bf16x8*)(kp + 16 * s);
        f32x16 acc = {0.f, 0.f, 0.f, 0.f, 0.f, 0.f, 0.f, 0.f, 0.f, 0.f, 0.f, 0.f, 0.f, 0.f, 0.f, 0.f};
#pragma unroll
        for (int s = 0; s < 4; ++s) acc = __builtin_amdgcn_mfma_f32_32x32x16_bf16(A[s], B[s], acc, 0, 0, 0);
        float v = 0.f;
#pragma unroll
        for (int r = 0; r < 16; ++r) v += wv[r] * fmaxf(acc[r], 0.f);
        scp[32 * kt] = v;
    }
    asm volatile("s_waitcnt vmcnt(0)" ::: "memory");
    for (int eq = 0; eq < 2; ++eq) {
        unsigned key[64];
#pragma unroll
        for (int j = 0; j < 64; ++j) {
            key[j] = 0u;
            if (j < nj) { const unsigned u = __hip_atomic_load((unsigned*)(scratch + eq * SEQ + 64 * j + lane), __ATOMIC_RELAXED, __HIP_MEMORY_SCOPE_AGENT);
                key[j] = (u & 0x80000000u) ? ~u : (u | 0x80000000u); }
        }
        unsigned T = 0u;
        if (nj * 64 > TOPK) {
            for (int bit = 31; bit >= 0; --bit) {
                const unsigned cand = T | (1u << bit); int cnt = 0;
#pragma unroll
                for (int j = 0; j < 64; ++j) cnt += __popcll(__ballot(key[j] >= cand));
                if (cnt >= TOPK) T = cand;
                if (cnt == TOPK) break;
            }
        }
        unsigned long long myw = 0ull;
#pragma unroll
        for (int j = 0; j < 64; ++j) { const unsigned long long mk = __ballot(key[j] >= T); if (lane == j) myw = mk; }
        if (lane < nj) MASK[(size_t)(q0 + eq) * 64 + lane] = myw;
    }
    asm volatile("s_waitcnt vmcnt(0)" ::: "memory");
}

__device__ __forceinline__ void p3_vtranspose_item(Frame& F, int item) {
    const bf16* PROJ = (const bf16*)(F.ws + WS_PROJ); bf16* VT = (bf16*)(F.ws + WS_VT);
    const int bb = item >> 10, head = (item >> 6) & 15, tb = item & 63, lane = F.lane;
    const v4u* src = (const v4u*)(PROJ + (size_t)(bb * SEQ + 64 * tb + lane) * NP + OFF_V + head * 64);
    v4u r[8];
#pragma unroll
    for (int i = 0; i < 8; ++i) r[i] = src[i];
    bf16* dst = VT + (size_t)((bb * 16 + head) * 64) * SEQ + 64 * tb + lane;
#pragma unroll
    for (int d = 0; d < 64; ++d) { const unsigned wv = r[d >> 3][(d & 7) >> 1]; dst[(size_t)d * SEQ] = (bf16)((d & 1) ? (wv >> 16) : (wv & 0xffffu)); }
}

__device__ __forceinline__ void p4_attn_unit(Frame& F, int u) {
    const bf16* PROJ = (const bf16*)(F.ws + WS_PROJ); const bf16* VT = (const bf16*)(F.ws + WS_VT); const unsigned* MASK32 = (const unsigned*)(F.ws + WS_MASK); bf16* AOUT = (bf16*)(F.ws + WS_AOUT);
    const int head = u & 15, qq = u >> 4, bb = qq & 1, sblk = qq >> 1, qrow0 = bb * SEQ + 32 * sblk, ntile = 2 * ((sblk >> 1) + 1);
    const int lane = F.lane, r = lane & 31, hh = lane >> 5;
    bf16x8 Qf[4];
    { const bf16* qp = PROJ + (size_t)(qrow0 + r) * NP + OFF_Q + head * 64 + 8 * hh;
#pragma unroll
      for (int s = 0; s < 4; ++s) Qf[s] = *(const bf16x8*)(qp + 16 * s); }
    const bf16* kb = PROJ + (size_t)(bb * SEQ + r) * NP + OFF_K + head * 64 + 8 * hh;
    const unsigned* mrow = MASK32 + (size_t)(qrow0 + r) * 128;
    const bf16* vt0 = VT + (size_t)((bb * 16 + head) * 64 + r) * SEQ + 4 * hh;
    const float C = 0.125f * LOG2E;
    float m = -1e30f, l = 0.f;
    f32x16 O0 = {0.f, 0.f, 0.f, 0.f, 0.f, 0.f, 0.f, 0.f, 0.f, 0.f, 0.f, 0.f, 0.f, 0.f, 0.f, 0.f}, O1 = O0;
    for (int kt = 0; kt < ntile; ++kt) {
        const bf16* kp = kb + (size_t)kt * 32 * NP;
        bf16x8 Kf[4];
#pragma unroll
        for (int s = 0; s < 4; ++s) Kf[s] = *(const bf16x8*)(kp + 16 * s);
        const unsigned mw = mrow[kt] >> (4 * hh);
        typedef unsigned long long u64;
        u64 vlo[4], vhi[4];
#pragma unroll
        for (int db = 0; db < 2; ++db)
#pragma unroll
            for (int s2 = 0; s2 < 2; ++s2) { const bf16* vp = vt0 + (size_t)db * 32 * SEQ + 32 * kt + 16 * s2; vlo[db * 2 + s2] = *(const u64*)vp; vhi[db * 2 + s2] = *(const u64*)(vp + 8); }
        f32x16 X = {0.f, 0.f, 0.f, 0.f, 0.f, 0.f, 0.f, 0.f, 0.f, 0.f, 0.f, 0.f, 0.f, 0.f, 0.f, 0.f};
#pragma unroll
        for (int s = 0; s < 4; ++s) X = __builtin_amdgcn_mfma_f32_32x32x16_bf16(Kf[s], Qf[s], X, 0, 0, 0);
        float x[16]; float mx = -INFINITY;
#pragma unroll
        for (int g = 0; g < 16; ++g) { const int cb = (g & 3) + 8 * (g >> 2); x[g] = ((mw >> cb) & 1u) ? X[g] * C : -INFINITY; mx = fmaxf(mx, x[g]); }
        mx = fmaxf(mx, __shfl_xor(mx, 32));
        const float mn = fmaxf(m, mx), alpha = __builtin_amdgcn_exp2f(m - mn); m = mn;
        float ls = 0.f;
#pragma unroll
        for (int g = 0; g < 16; ++g) { x[g] = __builtin_amdgcn_exp2f(x[g] - mn); ls += x[g]; }
        l = l * alpha + ls;
#pragma unroll
        for (int g = 0; g < 16; ++g) { O0[g] *= alpha; O1[g] *= alpha; }
        v4u p0, p1;
        p0.x = pg8::cvt_pk_bf16(x[0], x[1]); p0.y = pg8::cvt_pk_bf16(x[2], x[3]); p0.z = pg8::cvt_pk_bf16(x[4], x[5]); p0.w = pg8::cvt_pk_bf16(x[6], x[7]);
        p1.x = pg8::cvt_pk_bf16(x[8], x[9]); p1.y = pg8::cvt_pk_bf16(x[10], x[11]); p1.z = pg8::cvt_pk_bf16(x[12], x[13]); p1.w = pg8::cvt_pk_bf16(x[14], x[15]);
        const bf16x8 P0 = __builtin_bit_cast(bf16x8, p0), P1 = __builtin_bit_cast(bf16x8, p1);
#define VFRAG(i) __builtin_bit_cast(bf16x8, (v4u){(unsigned)vlo[i], (unsigned)(vlo[i] >> 32), (unsigned)vhi[i], (unsigned)(vhi[i] >> 32)})
        O0 = __builtin_amdgcn_mfma_f32_32x32x16_bf16(VFRAG(0), P0, O0, 0, 0, 0);
        O0 = __builtin_amdgcn_mfma_f32_32x32x16_bf16(VFRAG(1), P1, O0, 0, 0, 0);
        O1 = __builtin_amdgcn_mfma_f32_32x32x16_bf16(VFRAG(2), P0, O1, 0, 0, 0);
        O1 = __builtin_amdgcn_mfma_f32_32x32x16_bf16(VFRAG(3), P1, O1, 0, 0, 0);
#undef VFRAG
    }
    l += __shfl_xor(l, 32);
    const float inv = 1.0f / l;
    bf16* op = AOUT + (size_t)(qrow0 + r) * (NHEAD * HDIM) + head * 64 + 4 * hh;
#pragma unroll
    for (int g = 0; g < 4; ++g) {
        u32x2v w0, w1;
        w0.x = pg8::cvt_pk_bf16(O0[4 * g] * inv, O0[4 * g + 1] * inv); w0.y = pg8::cvt_pk_bf16(O0[4 * g + 2] * inv, O0[4 * g + 3] * inv);
        w1.x = pg8::cvt_pk_bf16(O1[4 * g] * inv, O1[4 * g + 1] * inv); w1.y = pg8::cvt_pk_bf16(O1[4 * g + 2] * inv, O1[4 * g + 3] * inv);
        *(u32x2v*)(op + 8 * g) = w0; *(u32x2v*)(op + 32 + 8 * g) = w1;
    }
}

__device__ __forceinline__ void p7_rows(Frame& F) {
    const float* modf = (const float*)(F.ws + WS_MODF); bf16* H = (bf16*)(F.ws + WS_H);
    LAS float* A1 = (LAS float*)(F.lds + RING_OFF); LAS float* S2 = A1 + DM; LAS float* T2 = S2 + DM;
    for (int tile = F.bid; tile < MTOK / 32; tile += F.G) {
        const int bb = tile / (SEQ / 32);
        __syncthreads();
        for (int j = 0; j < 4; ++j) { const int col = F.tid + 512 * j;
            A1[col] = modf[bb * NMOD + 2 * DM + col] * F.in[I_GPOSTMIX][col];
            S2[col] = F.in[I_GPREFFN][col] * (1.0f + modf[bb * NMOD + 4 * DM + col]);
            T2[col] = modf[bb * NMOD + 3 * DM + col]; }
        __syncthreads();
        for (int i = 0; i < 4; ++i) {
            const int row = tile * 32 + F.wave * 4 + i;
            const f32x4* xr = (const f32x4*)(F.in[I_X] + (size_t)row * DM) + F.lane;
            f32x4* mr = (f32x4*)(F.out + (size_t)row * DM) + F.lane;
            f32x4 mv[8], xv[8]; float ss = 0.f;
#pragma unroll
            for (int j = 0; j < 8; ++j) { mv[j] = mr[64 * j]; xv[j] = xr[64 * j]; ss += (mv[j][0] * mv[j][0] + mv[j][1] * mv[j][1]) + (mv[j][2] * mv[j][2] + mv[j][3] * mv[j][3]); }
            const float rstd = 1.0f / sqrtf(wave_sum(ss) * (1.0f / DM) + EPS);
            float s1 = 0.f;
#pragma unroll
            for (int j = 0; j < 8; ++j) { const f32x4 a = *(const LAS f32x4*)(A1 + 4 * F.lane + 256 * j); xv[j] = xv[j] + mv[j] * rstd * a;
                s1 += (xv[j][0] * xv[j][0] + xv[j][1] * xv[j][1]) + (xv[j][2] * xv[j][2] + xv[j][3] * xv[j][3]); mr[64 * j] = xv[j]; }
            const float rstd1 = 1.0f / sqrtf(wave_sum(s1) * (1.0f / DM) + EPS);
            unsigned long long* o8 = (unsigned long long*)(H + (size_t)row * DM) + F.lane;
#pragma unroll
            for (int j = 0; j < 8; ++j) { const f32x4 sc = *(const LAS f32x4*)(S2 + 4 * F.lane + 256 * j), sh = *(const LAS f32x4*)(T2 + 4 * F.lane + 256 * j);
                const f32x4 h = xv[j] * rstd1 * sc + sh;
                o8[64 * j] = (unsigned long long)pk2(h[0], h[1]) | ((unsigned long long)pk2(h[2], h[3]) << 32); }
        }
    }
    __syncthreads();
}
__device__ __forceinline__ void p10_rows(Frame& F) {
    const float* modf = (const float*)(F.ws + WS_MODF); const float* Fb = (const float*)(F.ws + WS_F);
    LAS float* A2 = (LAS float*)(F.lds + RING_OFF);
    for (int tile = F.bid; tile < MTOK / 32; tile += F.G) {
        const int bb = tile / (SEQ / 32);
        __syncthreads();
        for (int j = 0; j < 4; ++j) { const int col = F.tid + 512 * j; A2[col] = modf[bb * NMOD + 5 * DM + col] * F.in[I_GPOSTFFN][col]; }
        __syncthreads();
        for (int i = 0; i < 4; ++i) {
            const int row = tile * 32 + F.wave * 4 + i;
            const f32x4* fr = (const f32x4*)(Fb + (size_t)row * DM) + F.lane;
            f32x4* orow = (f32x4*)(F.out + (size_t)row * DM) + F.lane;
            f32x4 fv[8], xv[8]; float ss = 0.f;
#pragma unroll
            for (int j = 0; j < 8; ++j) { fv[j] = fr[64 * j]; xv[j] = orow[64 * j]; ss += (fv[j][0] * fv[j][0] + fv[j][1] * fv[j][1]) + (fv[j][2] * fv[j][2] + fv[j][3] * fv[j][3]); }
            const float rstd = 1.0f / sqrtf(wave_sum(ss) * (1.0f / DM) + EPS);
#pragma unroll
            for (int j = 0; j < 8; ++j) { const f32x4 a = *(const LAS f32x4*)(A2 + 4 * F.lane + 256 * j); orow[64 * j] = xv[j] + fv[j] * rstd * a; }
        }
    }
}

#ifndef MK_N_LAUNCHES
#define MK_N_LAUNCHES 1
#endif
constexpr int N_PHASES = 11;
struct Args { const float* in[19]; float* out; unsigned char* ws; int ph_lo, ph_hi; };
__global__ void __launch_bounds__(NWAVES * 64, 2) mk_fwd(Args args) {
    extern __shared__ __attribute__((aligned(16))) unsigned char lds[];
    Frame F;
    F.lds = (LAS unsigned char*)lds;
    F.MISC = (volatile LAS unsigned*)(F.lds + MISC_OFF);
    F.tid = threadIdx.x; F.lane = F.tid & 63; F.wave = __builtin_amdgcn_readfirstlane(F.tid >> 6);
    F.G = gridDim.x; F.bid = blockIdx.x;
    F.ws = args.ws; F.out = args.out; F.ctl = (gu32*)(args.ws + WS_CTL);
#pragma unroll
    for (int i = 0; i < 19; ++i) F.in[i] = args.in[i];
    for (int u = F.tid; u < (LDS_BYTES - LDSCTL_OFF) / 4; u += NWAVES * 64) ((LAS unsigned*)(F.lds + LDSCTL_OFF))[u] = 0u;
    __syncthreads();
    XcdBarrier bar; bar.bar = (unsigned*)(F.ctl + CW_BAR); bar.x = 0; bar.st = nullptr;
    if (MK_N_LAUNCHES == 1) bar = xcd_barrier_post((unsigned*)(F.ctl + CW_BAR), F.MISC + 8);
    const int lo = args.ph_lo, hi = args.ph_hi;
#define IN(k) (lo <= (k) && (k) < hi)
#define SEAM(k) do { if (IN(k) && IN((k) + 1)) xcd_barrier(bar); } while (0)
    bf16* H = (bf16*)(F.ws + WS_H); bf16* PROJ = (bf16*)(F.ws + WS_PROJ);
    const int gw = F.bid * NWAVES + F.wave, NGW = F.G * NWAVES;

    if (IN(0)) { p0_prologue(F); } SEAM(0);
    if (IN(1)) { p1_h1(F); } SEAM(1);
    if (IN(2)) {
        pg8::Gemm g{H, (const bf16*)(F.ws + WS_BT_IN), MTOK, NP, DM}; pg8::StaticOrder S; S.init(MTOK, NP, F.G, F.bid);
        EpiStoreBf16 E{PROJ, NP};
        pg8::gemm_phase<EpiStoreBf16, pg8::StaticOrder, true, true>(F.lds + RING_OFF, g, S, E);
    } SEAM(2);
    if (IN(3)) {
        for (int tile = F.bid; tile < MTOK / 32; tile += F.G) p3_conv_tile(F, tile);
        float* scratch = (float*)(F.ws + WS_SCORES) + (size_t)gw * (2 * SEQ);
        for (int p = gw; p < MTOK / 4; p += NGW) { p3_indexer_unit(F, p, scratch); p3_indexer_unit(F, MTOK / 2 - 1 - p, scratch); }
        for (int it = gw; it < 2048; it += NGW) p3_vtranspose_item(F, it);
    } SEAM(3);
    if (IN(4)) {
        for (int u = gw; u < 2048; u += NGW) { p4_attn_unit(F, u); p4_attn_unit(F, 4095 - u); }
    } SEAM(4);
    if (IN(5)) {
        { pg8::Gemm g{(const bf16*)(F.ws + WS_CACT), (const bf16*)(F.ws + WS_BT_CO), MTOK, DM, DCONV}; pg8::StaticOrder S; S.init(MTOK, DM, F.G, F.bid);
          EpiGateConv E{F.out, PROJ + OFF_G, NP};
          pg8::gemm_phase<EpiGateConv, pg8::StaticOrder, true, true>(F.lds + RING_OFF, g, S, E); }
        { pg8::Gemm g{(const bf16*)(F.ws + WS_AOUT), (const bf16*)(F.ws + WS_BT_AO), MTOK, DM, DCONV}; pg8::StaticOrder S; S.init(MTOK, DM, F.G, F.bid);
          EpiGateAttn E{F.out, PROJ + OFF_G + DM, NP, (bf16*)(F.ws + WS_MERGED)};
          pg8::gemm_phase<EpiGateAttn, pg8::StaticOrder, true, true>(F.lds + RING_OFF, g, S, E); }
    } SEAM(5);
    if (IN(6)) {
        pg8::Gemm g{(const bf16*)(F.ws + WS_MERGED), (const bf16*)(F.ws + WS_BT_O), MTOK, DM, DM}; pg8::StaticOrder S; S.init(MTOK, DM, F.G, F.bid);
        EpiStoreF32 E{F.out, DM};
        pg8::gemm_phase<EpiStoreF32, pg8::StaticOrder, true, true>(F.lds + RING_OFF, g, S, E);
    } SEAM(6);
    if (IN(7)) { p7_rows(F); } SEAM(7);
    if (IN(8)) {
        pg8::Gemm g{H, (const bf16*)(F.ws + WS_BT_GU), MTOK, NGU, DM}; pg8::StaticOrder S; S.init(MTOK, NGU, F.G, F.bid);
        EpiSwiGLU E{(bf16*)(F.ws + WS_GU)};
        pg8::gemm_phase<EpiSwiGLU, pg8::StaticOrder, true, true>(F.lds + RING_OFF, g, S, E);
    } SEAM(8);
    if (IN(9)) {
        pg8::Gemm g{(const bf16*)(F.ws + WS_GU), (const bf16*)(F.ws + WS_BT_DN), MTOK, DM, DFF}; pg8::StaticOrder S; S.init(MTOK, DM, F.G, F.bid);
        EpiStoreF32 E{(float*)(F.ws + WS_F), DM};
        pg8::gemm_phase<EpiStoreF32, pg8::StaticOrder, true, true>(F.lds + RING_OFF, g, S, E);
    } SEAM(9);
    if (IN(10)) { p10_rows(F); }
#undef IN
#undef SEAM
}

extern "C" void kernel_launch(void* const* d_in, const int* in_sizes, int n_in, void* d_out, int out_size, void* d_ws, size_t ws_size, hipStream_t stream) {
    static int grid = 0;
    if (grid == 0) {
        if (n_in != 19 || in_sizes[0] != MTOK * DM || out_size != MTOK * DM || ws_size < WS_END) { fprintf(stderr, "kernel_launch: unexpected shapes / workspace (n_in %d, in0 %d, out %d, ws %zu < %zu)\n", n_in, n_in > 0 ? in_sizes[0] : -1, out_size, ws_size, (size_t)WS_END); grid = -1; return; }
        int dev = 0, cus = 0, per_cu = 0;
        if (hipGetDevice(&dev) != hipSuccess || hipDeviceGetAttribute(&cus, hipDeviceAttributeMultiprocessorCount, dev) != hipSuccess) { grid = -1; return; }
        if (hipFuncSetAttribute((const void*)mk_fwd, hipFuncAttributeMaxDynamicSharedMemorySize, LDS_BYTES) != hipSuccess) { fprintf(stderr, "kernel_launch: hipFuncSetAttribute failed\n"); grid = -1; return; }
        if (hipOccupancyMaxActiveBlocksPerMultiprocessor(&per_cu, (const void*)mk_fwd, NWAVES * 64, LDS_BYTES) != hipSuccess || per_cu < 1) { fprintf(stderr, "kernel_launch: occupancy query says %d blocks per CU\n", per_cu); (void)hipGetLastError(); grid = -1; return; }
        grid = cus;
    }
    if (grid < 0) return;
    if (hipMemsetAsync((char*)d_ws + WS_CTL, 0, CTL_ZERO_BYTES, stream) != hipSuccess) return;
    Args a{};
    for (int i = 0; i < 19; ++i) a.in[i] = (const float*)d_in[i];
    a.out = (float*)d_out; a.ws = (unsigned char*)d_ws;
#if MK_N_LAUNCHES == 1
    a.ph_lo = 0; a.ph_hi = N_PHASES;
    hipLaunchKernelGGL(mk_fwd, dim3(grid), dim3(NWAVES * 64), LDS_BYTES, stream, a);
#else
    for (int p = 0; p < N_PHASES; ++p) { a.ph_lo = p; a.ph_hi = p + 1; hipLaunchKernelGGL(mk_fwd, dim3(grid), dim3(NWAVES * 64), LDS_BYTES, stream, a); }
#endif
}
```

```cpp
#include <hip/hip_runtime.h>
#include <cstdio>
#include <cstdint>
namespace pg8 {
#define PG8_LAS __attribute__((address_space(3)))
typedef unsigned short bf16_t;
typedef short bf16x8 __attribute__((ext_vector_type(8)));
typedef float f32x4 __attribute__((ext_vector_type(4)));
typedef unsigned u32x4 __attribute__((ext_vector_type(4)));
constexpr int BM = 256, BK = 64, HALF = 128, HTB = HALF * BK * 2  , STAGE_BYTES = 8 * HTB, NXCD = 8, WGM = 8;

__host__ __device__ __forceinline__ int lds_byte(int r, int c) { const int st = (r >> 4) * 2 + (c >> 5), rr = r & 15, cc = c & 31, ob = rr * 64 + cc * 2; return st * 1024 + (ob ^ (((ob >> 9) & 1) << 5)); }
__host__ __device__ __forceinline__ void stage_rc(int b, int& R, int& C) { const int st = b / 1024, sb = b % 1024, swz = sb ^ (((sb >> 9) & 1) << 5); R = (st >> 1) * 16 + swz / 64; C = (st & 1) * 32 + (swz % 64) / 2; }
__host__ __device__ __forceinline__ int perm32(int rho) { const int n = rho >> 4, i = rho & 15; return 8 * (i >> 2) + 4 * n + (i & 3); }

struct Unit { int pm, pn; };
struct Gemm { const bf16_t* A; const bf16_t* Bt; int M, N, K; };

struct StaticOrder {
    int nM, nN, nwg, G, c;
    __host__ __device__ void init(int M, int N, int G_, int c_) { nM = M / BM; nN = N / BM; nwg = nM * nN; G = G_; c = c_; }
    __host__ __device__ bool next(int i, Unit& u) const {
        const long L = (long)i * G + c; if (L >= nwg) return false;
        int wgid = (int)L; { const int q = nwg / NXCD, r = nwg % NXCD, xcd = wgid % NXCD, off = wgid / NXCD; wgid = (xcd < r ? xcd * (q + 1) : r * (q + 1) + (xcd - r) * q) + off; }
        const int nig = WGM * nN, gid = wgid / nig, fm = gid * WGM, gsz = (nM - fm) < WGM ? (nM - fm) : WGM;
        u.pm = fm + ((wgid % nig) % gsz); u.pn = (wgid % nig) / gsz; return true;
    }
    __device__ __forceinline__ void a_ready(const Unit&) const {}
    __device__ __forceinline__ void done(const Unit&) const {}
};

__device__ __forceinline__ unsigned cvt_pk_bf16(float lo, float hi) { unsigned r; asm volatile("v_cvt_pk_bf16_f32 %0, %1, %2" : "=v"(r) : "v"(lo), "v"(hi)); return r; }
typedef float f32x2 __attribute__((ext_vector_type(2)));
template <class Epi, class Sched, bool ALIGN_EPI = false, bool SP2 = false>
__device__ __forceinline__ void gemm_phase(PG8_LAS unsigned char* lds, const Gemm g, const Sched& S, const Epi& E) {
    const int tid = threadIdx.x, wid = __builtin_amdgcn_readfirstlane(tid >> 6), lane = tid & 63, wr = wid >> 2, wc = wid & 3, fr = lane & 15, fq = lane >> 4;
    const int K = g.K, nt = K / BK;
    unsigned voffA[2], voffB[2];
#pragma unroll
    for (int i = 0; i < 2; ++i) { int R, C; stage_rc(tid * 16 + i * 8192, R, C); const int Rb = Epi::PERM ? ((R & ~31) + perm32(R & 31)) : R;
        voffA[i] = (unsigned)(R * K + C) * 2u; voffB[i] = (unsigned)(Rb * K + C) * 2u; }
    const size_t kstep = (size_t)(BK * 2);
    const size_t hstep = (size_t)HALF * K * 2;
    const size_t tstep = 2 * hstep;
    const unsigned ldsw = (unsigned)wid * 1024u;
    const int aoff = lds_byte(wr * 64 + fr, fq * 8), boff = lds_byte(wc * 32 + fr, fq * 8);
#define PG8_SA(b, h) (((b) * 2 + (h)) * HTB)
#define PG8_SB(b, h) ((4 + (b) * 2 + (h)) * HTB)
#define PG8_STAGE(bufoff, gbase, voff) do { _Pragma("unroll") for (int _i = 0; _i < 2; ++_i) \
        __builtin_amdgcn_global_load_lds((const unsigned*)((const char*)(gbase) + (voff)[_i]), (PG8_LAS unsigned*)(lds + (bufoff) + ldsw + _i * 8192), 16, 0, 0); } while (0)
#define PG8_LDA(dst, b, h) do { _Pragma("unroll") for (int m = 0; m < 4; ++m) _Pragma("unroll") for (int k = 0; k < 2; ++k) dst[m][k] = *(const PG8_LAS bf16x8*)(lds + PG8_SA(b, h) + aoff + m * 2048 + k * 1024); } while (0)
#define PG8_LDB(dst, b, h) do { _Pragma("unroll") for (int n = 0; n < 2; ++n) _Pragma("unroll") for (int k = 0; k < 2; ++k) dst[n][k] = *(const PG8_LAS bf16x8*)(lds + PG8_SB(b, h) + boff + n * 2048 + k * 1024); } while (0)
#define PG8_MMA(ai, bj, At, Bt) do { __builtin_amdgcn_s_setprio(1); _Pragma("unroll") for (int m = 0; m < 4; ++m) _Pragma("unroll") for (int n = 0; n < 2; ++n) _Pragma("unroll") for (int k = 0; k < 2; ++k) \
        acc[ai][bj][m][n] = __builtin_amdgcn_mfma_f32_16x16x32_bf16(Bt[n][k], At[m][k], acc[ai][bj][m][n], 0, 0, 0); __builtin_amdgcn_s_setprio(0); } while (0)
#define PG8_WAIT_V(n) asm volatile("s_waitcnt vmcnt(" #n ")" ::: "memory")
#define PG8_WAIT_L(n) asm volatile("s_waitcnt lgkmcnt(" #n ")" ::: "memory")
#define PG8_BAR __builtin_amdgcn_s_barrier()
#define PG8_SCHED __builtin_amdgcn_sched_barrier(0)
    Unit cur, nxt; int ui = 0;
    if (!S.next(0, cur)) return;
    f32x4 acc[2][2][4][2];
#pragma unroll
    for (int a = 0; a < 2; ++a)
#pragma unroll
        for (int b = 0; b < 2; ++b)
#pragma unroll
            for (int m = 0; m < 4; ++m)
#pragma unroll
                for (int n = 0; n < 2; ++n) acc[a][b][m][n] = (f32x4){0.f, 0.f, 0.f, 0.f};
    bf16x8 At[4][2], B0[2][2], B1[2][2];
    const char* cA = (const char*)g.A + (size_t)cur.pm * tstep; const char* cB = (const char*)g.Bt + (size_t)cur.pn * tstep;
    S.a_ready(cur);
    if constexpr (SP2) {
        PG8_STAGE(PG8_SB(0, 0), cB, voffB); PG8_STAGE(PG8_SB(0, 1), cB + hstep, voffB); PG8_STAGE(PG8_SA(0, 0), cA, voffA); PG8_STAGE(PG8_SA(0, 1), cA + hstep, voffA);
        if (wr == 1) PG8_BAR;
        PG8_WAIT_V(2); PG8_BAR;
        PG8_STAGE(PG8_SB(1, 0), cB + kstep, voffB); PG8_STAGE(PG8_SA(1, 0), cA + kstep, voffA); PG8_STAGE(PG8_SB(1, 1), cB + hstep + kstep, voffB);
        PG8_WAIT_V(6); PG8_BAR;
    } else {
        PG8_STAGE(PG8_SB(0, 0), cB, voffB); PG8_STAGE(PG8_SA(0, 0), cA, voffA); PG8_STAGE(PG8_SB(0, 1), cB + hstep, voffB); PG8_STAGE(PG8_SA(0, 1), cA + hstep, voffA);
        if (wr == 1) PG8_BAR;
        PG8_WAIT_V(4); PG8_BAR;
        PG8_STAGE(PG8_SB(1, 0), cB + kstep, voffB); PG8_STAGE(PG8_SA(1, 0), cA + kstep, voffA); PG8_STAGE(PG8_SB(1, 1), cB + hstep + kstep, voffB);
        PG8_WAIT_V(6); PG8_BAR;
    }
    for (;;) {
        const bool has_next = S.next(ui + 1, nxt);
        const char* nA = has_next ? (const char*)g.A + (size_t)nxt.pm * tstep : cA; const char* nB = has_next ? (const char*)g.Bt + (size_t)nxt.pn * tstep : cB;
        for (int t = 0; t < nt; t += 2) {
            const bool last = (t == nt - 2);
            const char* a1 = cA + (size_t)(t + 1) * kstep;
            const char* a2 = last ? nA : cA + (size_t)(t + 2) * kstep; const char* b2 = last ? nB : cB + (size_t)(t + 2) * kstep;
            const char* a3 = a2 + kstep; const char* b3 = b2 + kstep;
            if (last && has_next) S.a_ready(nxt);
            if constexpr (SP2) {
            PG8_LDB(B0, 0, 0); PG8_LDB(B1, 0, 1); PG8_SCHED; PG8_LDA(At, 0, 0); PG8_STAGE(PG8_SA(1, 1), a1 + hstep, voffA);
            PG8_WAIT_V(8); PG8_WAIT_L(0); PG8_BAR; PG8_MMA(0, 0, At, B0); PG8_MMA(0, 1, At, B1); PG8_BAR; PG8_SCHED;
            PG8_LDA(At, 0, 1); PG8_STAGE(PG8_SB(0, 0), b2, voffB); PG8_STAGE(PG8_SB(0, 1), b2 + hstep, voffB); PG8_STAGE(PG8_SA(0, 0), a2, voffA);
            PG8_WAIT_V(8); PG8_WAIT_L(0); PG8_BAR; PG8_MMA(1, 0, At, B0); PG8_MMA(1, 1, At, B1); PG8_BAR; PG8_SCHED;
            PG8_LDB(B0, 1, 0); PG8_LDB(B1, 1, 1); PG8_SCHED; PG8_LDA(At, 1, 0); PG8_STAGE(PG8_SA(0, 1), a2 + hstep, voffA);
            PG8_WAIT_V(8); PG8_WAIT_L(0); PG8_BAR; PG8_MMA(0, 0, At, B0); PG8_MMA(0, 1, At, B1); PG8_BAR; PG8_SCHED;
            PG8_LDA(At, 1, 1); PG8_STAGE(PG8_SB(1, 0), b3, voffB); PG8_STAGE(PG8_SB(1, 1), b3 + hstep, voffB); PG8_STAGE(PG8_SA(1, 0), a3, voffA);
            PG8_WAIT_V(8); PG8_WAIT_L(0); PG8_BAR; PG8_MMA(1, 0, At, B0); PG8_MMA(1, 1, At, B1); PG8_BAR; PG8_SCHED;
            } else {
            PG8_LDB(B0, 0, 0); PG8_SCHED; PG8_LDA(At, 0, 0); PG8_STAGE(PG8_SA(1, 1), a1 + hstep, voffA);
            PG8_WAIT_L(8); PG8_BAR; PG8_WAIT_L(0); PG8_MMA(0, 0, At, B0); PG8_BAR; PG8_SCHED;
            PG8_LDB(B1, 0, 1); PG8_STAGE(PG8_SB(0, 0), b2, voffB);
            PG8_BAR; PG8_WAIT_L(0); PG8_MMA(0, 1, At, B1); PG8_BAR;
            PG8_LDA(At, 0, 1); PG8_STAGE(PG8_SA(0, 0), a2, voffA);
            PG8_BAR; PG8_WAIT_L(0); PG8_MMA(1, 0, At, B0); PG8_BAR; PG8_SCHED;
            PG8_STAGE(PG8_SB(0, 1), b2 + hstep, voffB);
            PG8_WAIT_V(6); PG8_BAR; PG8_MMA(1, 1, At, B1); PG8_BAR;
            PG8_LDB(B0, 1, 0); PG8_SCHED; PG8_LDA(At, 1, 0); PG8_STAGE(PG8_SA(0, 1), a2 + hstep, voffA);
            PG8_WAIT_L(8); PG8_BAR; PG8_WAIT_L(0); PG8_MMA(0, 0, At, B0); PG8_BAR; PG8_SCHED;
            PG8_LDB(B1, 1, 1); PG8_STAGE(PG8_SB(1, 0), b3, voffB);
            PG8_BAR; PG8_WAIT_L(0); PG8_MMA(0, 1, At, B1); PG8_BAR;
            PG8_LDA(At, 1, 1); PG8_STAGE(PG8_SA(1, 0), a3, voffA);
            PG8_BAR; PG8_WAIT_L(0); PG8_MMA(1, 0, At, B0); PG8_BAR; PG8_SCHED;
            PG8_STAGE(PG8_SB(1, 1), b3 + hstep, voffB);
            PG8_WAIT_V(6); PG8_BAR; PG8_MMA(1, 1, At, B1); PG8_BAR;
            }
        }
        if constexpr (ALIGN_EPI) { if (wr == 0) PG8_BAR; }
        if constexpr (!Epi::AFTER_DRAIN) { E(acc, cur, wr, wc, fr, fq); S.done(cur); }
        if (!has_next) break;
#pragma unroll
        for (int a = 0; a < 2; ++a)
#pragma unroll
            for (int b = 0; b < 2; ++b)
#pragma unroll
                for (int m = 0; m < 4; ++m)
#pragma unroll
                    for (int n = 0; n < 2; ++n) acc[a][b][m][n] = (f32x4){0.f, 0.f, 0.f, 0.f};
        cur = nxt; cA = nA; cB = nB; ++ui;
        if constexpr (ALIGN_EPI) { if (wr == 1) PG8_BAR; }
    }
    PG8_WAIT_V(0);
    if constexpr (!ALIGN_EPI) { if (wr == 0) PG8_BAR; }
    PG8_BAR;
    if constexpr (Epi::AFTER_DRAIN) { E.fused(acc, cur, wr, wc, fr, fq, lds, wid, lane); S.done(cur); }
#undef PG8_SA
#undef PG8_SB
#undef PG8_STAGE
#undef PG8_LDA
#undef PG8_LDB
#undef PG8_MMA
#undef PG8_WAIT_V
#undef PG8_WAIT_L
#undef PG8_BAR
#undef PG8_SCHED
}
}
#include <hip/hip_bf16.h>
#include <cmath>
namespace attn_body {
using bf16=__hip_bfloat16;
using bf16x8=__attribute__((ext_vector_type(8)))short;
using s16x4=__attribute__((ext_vector_type(4)))short;
using f32x16=__attribute__((ext_vector_type(16)))float;
using u32x4=__attribute__((ext_vector_type(4)))unsigned;
constexpr int BATCH=2,NHEAD=16,SEQ=4096,D=64,DM=10496,OPITCH=1024;
constexpr int NW=8,QBLK=32,QB=QBLK*NW,KVBLK=64,NQB=SEQ/QB;
constexpr int ATTN_PITCH=DM, ATTN_UNIT_ROWS=QB;
__device__ __forceinline__ int crow(int r,int hi){return (r&3)+8*(r>>2)+4*hi;}
#define SBAR() __builtin_amdgcn_sched_barrier(0)
__device__ __forceinline__ void cmask(f32x16&p0,f32x16&p1,int jb,int qrel,int hi){
  const float NEG=-INFINITY; int kb=64*jb+4*hi;
  #pragma unroll
  for(int r=0;r<16;++r){int kv=kb+(r&3)+8*(r>>2); if(kv>qrel)p0[r]=NEG; if(kv+32>qrel)p1[r]=NEG;}
}

constexpr int NSLOT=3, SLOTB=8192;
constexpr int LDS_K=0, LDS_V=NSLOT*SLOTB, LDS_WS=2*NSLOT*SLOTB, LDS_OST=LDS_WS+NW*64*4, LDS_MSK=LDS_OST+NW*4096, LDS_BYTES=LDS_MSK+NW*768;
constexpr float C2=0.125f*1.4426950408889634f;
__device__ __forceinline__ void glds16(const void*gsrc,unsigned lds_dst){unsigned keep;
  asm volatile("s_mov_b32 %0, m0\n\ts_mov_b32 m0, %2\n\ts_nop 0\n\tglobal_load_lds_dwordx4 %1, off\n\ts_mov_b32 m0, %0":"=&s"(keep):"v"(gsrc),"s"(lds_dst):"memory");}
__device__ __forceinline__ void glds4(const void*sbase,unsigned voff,unsigned lds_dst){unsigned keep;
  asm volatile("s_mov_b32 %0, m0\n\ts_mov_b32 m0, %3\n\ts_nop 4\n\tglobal_load_lds_dword %1, %2\n\ts_mov_b32 m0, %0":"=&s"(keep):"v"(voff),"s"(sbase),"s"(lds_dst):"memory");}
__device__ __forceinline__ float max3f(float a,float b,float c){float r;asm("v_max3_f32 %0, %1, %2, %3":"=v"(r):"v"(a),"v"(b),"v"(c));return r;}
__device__ __forceinline__ float max2f(float a,float b){float r;asm("v_max_f32_e32 %0, %1, %2":"=v"(r):"v"(a),"v"(b));return r;}
__device__ __forceinline__ float fadd_s(float a,float b){float r;asm("v_add_f32_e32 %0, %1, %2":"=v"(r):"v"(a),"v"(b));return r;}
__device__ __forceinline__ float fsub_s(float a,float b){float r;asm("v_sub_f32_e32 %0, %1, %2":"=v"(r):"v"(a),"v"(b));return r;}
typedef float f32x2_t __attribute__((ext_vector_type(2))); typedef __bf16 bf16x2_t __attribute__((ext_vector_type(2)));
__device__ __forceinline__ unsigned cvtpk_s(float lo,float hi){f32x2_t v={lo,hi};bf16x2_t b=__builtin_convertvector(v,bf16x2_t);return __builtin_bit_cast(unsigned,b);}
#define WAIT_BAR(N) asm volatile("s_waitcnt vmcnt(" #N ") lgkmcnt(0)\n\ts_barrier":::"memory")

__device__ __forceinline__ void qkt(f32x16&p0,f32x16&p1,const char*Kslot,const bf16x8*qr,const f32x16&negm,int r32,int hi){
  const char*kb=Kslot+hi*1024+r32*16;
  #pragma unroll
  for(int d0=0;d0<4;++d0){
    const bf16x8 b0=*reinterpret_cast<const bf16x8*>(kb+d0*2048);
    const bf16x8 b1=*reinterpret_cast<const bf16x8*>(kb+d0*2048+512);
    if(d0==0){p0=__builtin_amdgcn_mfma_f32_32x32x16_bf16(b0,qr[0],negm,0,0,0);p1=__builtin_amdgcn_mfma_f32_32x32x16_bf16(b1,qr[0],negm,0,0,0);}
    else{p0=__builtin_amdgcn_mfma_f32_32x32x16_bf16(b0,qr[d0],p0,0,0,0);p1=__builtin_amdgcn_mfma_f32_32x32x16_bf16(b1,qr[d0],p1,0,0,0);}}
}
typedef __attribute__((address_space(3))) const char* lds_cptr;
typedef short v4i16_t __attribute__((ext_vector_type(4)));
__device__ __forceinline__ void kload8(bf16x8*kf,lds_cptr kp){
  kf[0]=*(const __attribute__((address_space(3))) bf16x8*)(kp);      kf[1]=*(const __attribute__((address_space(3))) bf16x8*)(kp+512);
  kf[2]=*(const __attribute__((address_space(3))) bf16x8*)(kp+2048); kf[3]=*(const __attribute__((address_space(3))) bf16x8*)(kp+2560);
  kf[4]=*(const __attribute__((address_space(3))) bf16x8*)(kp+4096); kf[5]=*(const __attribute__((address_space(3))) bf16x8*)(kp+4608);
  kf[6]=*(const __attribute__((address_space(3))) bf16x8*)(kp+6144); kf[7]=*(const __attribute__((address_space(3))) bf16x8*)(kp+6656);
}
__device__ __forceinline__ void kload2(bf16x8*kf,lds_cptr kp,int j){ kf[2*j]=*(const __attribute__((address_space(3))) bf16x8*)(kp+j*2048); kf[2*j+1]=*(const __attribute__((address_space(3))) bf16x8*)(kp+j*2048+512); }
__device__ __forceinline__ s16x4 vtr(lds_cptr p){ return __builtin_bit_cast(s16x4,__builtin_amdgcn_ds_read_tr16_b64_v4i16((__attribute__((address_space(3))) v4i16_t*)p)); }
__device__ __forceinline__ float rowmax(const f32x16&p0,const f32x16&p1){
  float a=max3f(p0[0],p0[1],p1[0]),b=max3f(p0[2],p0[3],p1[1]);a=max3f(a,p1[2],p1[3]);
  #pragma unroll
  for(int r=4;r<16;r+=4){a=max3f(a,p0[r],p0[r+1]);b=max3f(b,p0[r+2],p0[r+3]);a=max3f(a,p1[r],p1[r+1]);b=max3f(b,p1[r+2],p1[r+3]);}
  const float m=max2f(a,b);
  auto rr=__builtin_amdgcn_permlane32_swap(__float_as_uint(m),__float_as_uint(m),false,false);
  return max2f(__uint_as_float(rr[0]),__uint_as_float(rr[1]));
}
__device__ __forceinline__ void pv(f32x16*o,int vb,bf16x8 pa0,bf16x8 pa1,bf16x8 pa2,bf16x8 pa3){
  #pragma unroll
  for(int d0=0;d0<2;++d0){s16x4 lo[4],hi[4];
    #pragma unroll
    for(int ks=0;ks<4;++ks){
      asm volatile("ds_read_b64_tr_b16 %0,%1 offset:%c2":"=&v"(lo[ks]):"v"(vb),"i"(d0*4096+ks*1024):"memory");
      asm volatile("ds_read_b64_tr_b16 %0,%1 offset:%c2":"=&v"(hi[ks]):"v"(vb),"i"(d0*4096+ks*1024+512):"memory");}
    asm volatile("s_waitcnt lgkmcnt(0)":::"memory");SBAR();
    #define PK(k) (bf16x8){lo[k][0],lo[k][1],lo[k][2],lo[k][3],hi[k][0],hi[k][1],hi[k][2],hi[k][3]}
    o[d0]=__builtin_amdgcn_mfma_f32_32x32x16_bf16(pa0,PK(0),o[d0],0,0,0);
    o[d0]=__builtin_amdgcn_mfma_f32_32x32x16_bf16(pa1,PK(1),o[d0],0,0,0);
    o[d0]=__builtin_amdgcn_mfma_f32_32x32x16_bf16(pa2,PK(2),o[d0],0,0,0);
    o[d0]=__builtin_amdgcn_mfma_f32_32x32x16_bf16(pa3,PK(3),o[d0],0,0,0);
    #undef PK
  }
}

#ifndef ATTN_STORE16
#define ATTN_STORE16(p,v) (*(u32x4*)(p)=(v))
#endif
template<int THRL> __device__ __forceinline__ void attn_unit(int b,int h,int qb,const bf16*Q,const bf16*K,const bf16*V,bf16*O,const unsigned*MASK32,char*shm){
  const int tid=threadIdx.x,lane=tid&63,r32=lane&31,hi=lane>>5; const int wid=__builtin_amdgcn_readfirstlane(tid>>6);
  const long rowbase=(long)b*SEQ; const int q0=qb*QB;
  const bf16*Qw=Q+(rowbase+q0+wid*QBLK)*DM+h*D;
  const bf16*Kh=K+rowbase*DM+h*D,*Vh=V+rowbase*DM+h*D;
  const unsigned lds0=(unsigned)(uintptr_t)shm;
  float*wsf=(float*)(shm+LDS_WS)+wid*64;
  const bf16*ksrc=Kh+(long)lane*DM+wid*8;
  const bf16*vsrc=Vh+(long)(16*(wid&3)+(lane>>2))*DM+(wid>>2)*32+(lane&3)*8;
  const unsigned kdst=lds0+LDS_K+wid*1024, vdst=lds0+LDS_V+wid*1024, mdst=lds0+LDS_MSK+wid*768;
  const unsigned*msrc=MASK32+(rowbase+q0+wid*QBLK)*128;
  #define DMA_M(t,slot) glds4(msrc+2*(t),(unsigned)((lane>>1)*512+(lane&1)*4),(unsigned)__builtin_amdgcn_readfirstlane(mdst+(slot)))
  #define MSK(v,w,bit) __uint_as_float(__float_as_uint(v)&(unsigned)__builtin_amdgcn_sbfe((int)(w),(bit),1))
  #define DMA_K(t,slot) glds16(ksrc+(long)(t)*KVBLK*DM,(unsigned)__builtin_amdgcn_readfirstlane(kdst+(slot)))
  #define DMA_V(t,slot) glds16(vsrc+(long)(t)*KVBLK*DM,(unsigned)__builtin_amdgcn_readfirstlane(vdst+(slot)))
  const int vb0=(int)(lds0+LDS_V)+((lane>>4)&1)*32+(lane&3)*8+(4*hi+((lane&15)>>2))*64;
  const char*Kbase=shm+LDS_K; bf16x8 kf[8];
  const lds_cptr shm3=(lds_cptr)shm; const lds_cptr kp0=shm3+LDS_K+hi*1024+r32*16; const lds_cptr vp0=shm3+LDS_V+((lane>>4)&1)*32+(lane&3)*8+(4*hi+((lane&15)>>2))*64;
  const lds_cptr mp0=shm3+LDS_MSK+wid*768+r32*8;
  const int NT=(q0+QB)/KVBLK;
  DMA_M(0,0);DMA_M(1,256);DMA_K(0,0);DMA_V(0,0);DMA_K(1,SLOTB);
  bf16x8 qr[4];
  #pragma unroll
  for(int d0=0;d0<4;++d0)qr[d0]=*reinterpret_cast<const bf16x8*>(&Qw[(long)r32*DM+d0*16+hi*8]);
  float mhat=0.f,l_reg=0.f;f32x16 o[2];o[0]=f32x16{};o[1]=f32x16{};f32x16 negm=f32x16{};asm volatile("":"+v"(negm));
  #define CMASK(P0,P1,t) do{}while(0)
  bool resc=false;
  #define START(P0,P1) do{ const float rm=rowmax(P0,P1); resc=false; \
    { const float dl=rm; mhat=fadd_s(mhat,dl); \
      _Pragma("unroll") for(int r=0;r<16;++r){P0[r]=fsub_s(P0[r],dl);P1[r]=fsub_s(P1[r],dl);} \
      _Pragma("unroll") for(int r=0;r<16;++r)negm[r]=-mhat; asm volatile("":"+v"(negm)); } \
    _Pragma("unroll") for(int r=0;r<16;++r)P0[r]=__builtin_amdgcn_exp2f(P0[r]); }while(0)
  #define RESC() do{ if(resc){ asm volatile("s_waitcnt lgkmcnt(0)":::"memory"); \
      _Pragma("unroll") for(int d_=0;d_<2;++d_) _Pragma("unroll") for(int r=0;r<16;++r)o[d_][r]*=wsf[crow(r,hi)]; } }while(0)
  f32x16 pA0,pA1,pB0,pB1;
  int sl_prev=0,sl_cur=0,sl_next=SLOTB;
  #define ROT() do{sl_prev=sl_cur;sl_cur=sl_next;sl_next=(sl_next==(NSLOT-1)*SLOTB)?0:sl_next+SLOTB;}while(0)
  DMA_K(2,2*SLOTB);
  WAIT_BAR(3);
  qkt(pA0,pA1,Kbase,qr,negm,r32,hi);asm volatile("s_nop 15\n\ts_nop 7":"+v"(pA0),"+v"(pA1));CMASK(pA0,pA1,0);
  START(pA0,pA1);
  _Pragma("unroll") for(int r=0;r<16;++r)pA1[r]=__builtin_amdgcn_exp2f(pA1[r]);
  { const unsigned long long mw_=*(const __attribute__((address_space(3))) unsigned long long*)(mp0); const unsigned mlo_=(unsigned)mw_>>(4*hi), mhi_=(unsigned)(mw_>>32)>>(4*hi);
    _Pragma("unroll") for(int r=0;r<16;++r){ pA0[r]=MSK(pA0[r],mlo_,(r&3)+8*(r>>2)); pA1[r]=MSK(pA1[r],mhi_,(r&3)+8*(r>>2)); } }
  WAIT_BAR(0);
  DMA_K(3,0);DMA_V(1,SLOTB);DMA_M(2,512);
  ROT();
  kload8(kf,kp0+sl_cur);
  WAIT_BAR(3);
  s16x4 vlo[8],vhi[8]; u32x4 pw0,pw1,pw2,pw3;
  #define PKW(P,B) cvtpk_s(P[B],P[B+1])
  #define PAF(k) __builtin_bit_cast(bf16x8,pw##k)
  #define VFR(i) (bf16x8){vlo[i][0],vlo[i][1],vlo[i][2],vlo[i][3],vhi[i][0],vhi[i][1],vhi[i][2],vhi[i][3]}
  #define PIN(x) asm volatile("":"+v"(x))
  #define MX3(a,b,c) __builtin_fmaxf(__builtin_fmaxf((a),(b)),(c))
  #define GAPA(MF,A0,A1,A2,A3,W0,W1,PW) do{ MF; sacc+=A0; sacc+=A1; sacc+=A2; sacc+=A3; PIN(sacc); W0; W1; PIN(PW); SBAR(); }while(0)
  #define EX(v) __builtin_amdgcn_exp2f(v)
  #define GAPB(MF,X,B,MW) do{ MF; X[B]=MSK(EX(X[B]),MW,2*(B)); X[B+1]=MSK(EX(X[B+1]),MW,2*(B)+1); X[B+2]=MSK(EX(X[B+2]),MW,2*(B)+2); X[B+3]=MSK(EX(X[B+3]),MW,2*(B)+3); PIN(X); SBAR(); }while(0)
  #define VRD(i) do{ vlo[i]=vtr(vp_+(((i)>>2)*4096+((i)&3)*1024)); vhi[i]=vtr(vp_+(((i)>>2)*4096+((i)&3)*1024+512)); }while(0)
  #define KRD(G,j) do{ if(G){ kload2(kf,kp0+sl_next,j); SBAR(); } }while(0)
  #define STEP(C0,C1,P0,P1,t,GK,GV,GL,GM) do{ SBAR(); \
    const lds_cptr vp_=vp0+sl_prev; \
    VRD(0); SBAR(); float sacc=(P0[0]+P0[1]); \
    GAPA(C0=__builtin_amdgcn_mfma_f32_32x32x16_bf16(kf[0],qr[0],negm,0,0,0), P0[2],P0[3],P0[4],P0[5],     pw0[0]=PKW(P0,0), pw0[1]=PKW(P0,2), pw0); \
    VRD(4); SBAR(); GAPA(C1=__builtin_amdgcn_mfma_f32_32x32x16_bf16(kf[1],qr[0],negm,0,0,0), P0[6],P0[7],P0[8],P0[9],     pw0[2]=PKW(P0,4), pw0[3]=PKW(P0,6), pw0); \
    VRD(1); SBAR(); GAPA(C0=__builtin_amdgcn_mfma_f32_32x32x16_bf16(kf[2],qr[1],C0,0,0,0),   P0[10],P0[11],P0[12],P0[13], pw1[0]=PKW(P0,8), pw1[1]=PKW(P0,10), pw1); \
    VRD(5); SBAR(); GAPA(C1=__builtin_amdgcn_mfma_f32_32x32x16_bf16(kf[3],qr[1],C1,0,0,0),   P0[14],P0[15],P1[0],P1[1],   pw1[2]=PKW(P0,12),pw1[3]=PKW(P0,14), pw1); \
    VRD(2); SBAR(); GAPA(C0=__builtin_amdgcn_mfma_f32_32x32x16_bf16(kf[4],qr[2],C0,0,0,0),   P1[2],P1[3],P1[4],P1[5],     pw2[0]=PKW(P1,0), pw2[1]=PKW(P1,2), pw2); \
    VRD(6); SBAR(); GAPA(C1=__builtin_amdgcn_mfma_f32_32x32x16_bf16(kf[5],qr[2],C1,0,0,0),   P1[6],P1[7],P1[8],P1[9],     pw2[2]=PKW(P1,4), pw2[3]=PKW(P1,6), pw2); \
    VRD(3); SBAR(); GAPA(C0=__builtin_amdgcn_mfma_f32_32x32x16_bf16(kf[6],qr[3],C0,0,0,0),   P1[10],P1[11],P1[12],P1[13], pw3[0]=PKW(P1,8), pw3[1]=PKW(P1,10), pw3); \
    VRD(7); SBAR(); GAPA(C1=__builtin_amdgcn_mfma_f32_32x32x16_bf16(kf[7],qr[3],C1,0,0,0),   P1[14],P1[15],0.f,0.f,       pw3[2]=PKW(P1,12),pw3[3]=PKW(P1,14), pw3); \
    l_reg+=sacc; \
    const unsigned long long mw_=*(const __attribute__((address_space(3))) unsigned long long*)(mp0+(sl_cur>>5)); \
    if(GK){DMA_K((t)+3,sl_cur);} if(GV){DMA_V((t)+1,sl_next);} if(GM){DMA_M((t)+2,sl_prev>>5);} \
    const unsigned mlo_=(unsigned)mw_>>(4*hi), mhi_=(unsigned)(mw_>>32)>>(4*hi); \
    { float a=MX3(C0[0],C0[1],C1[0]),b=MX3(C0[2],C0[3],C1[1]); a=MX3(a,C1[2],C1[3]); \
      _Pragma("unroll") for(int r=4;r<16;r+=4){a=MX3(a,C0[r],C0[r+1]);b=MX3(b,C0[r+2],C0[r+3]);a=MX3(a,C1[r],C1[r+1]);b=MX3(b,C1[r+2],C1[r+3]);} \
      float rm=__builtin_fmaxf(a,b); { auto rr=__builtin_amdgcn_permlane32_swap(__float_as_uint(rm),__float_as_uint(rm),false,false); rm=__builtin_fmaxf(__uint_as_float(rr[0]),__uint_as_float(rr[1])); } \
      resc=false; \
      if(__builtin_expect(__any(rm>(float)THRL),0)){ const float dl=__builtin_fmaxf(rm,0.f); mhat+=dl; \
        _Pragma("unroll") for(int r=0;r<16;++r){C0[r]-=dl;C1[r]-=dl;} \
        _Pragma("unroll") for(int r=0;r<16;++r)negm[r]=-mhat; asm volatile("":"+v"(negm)); \
        const float f=__builtin_amdgcn_exp2f(-dl); l_reg*=f; if(hi==0)wsf[r32]=f; resc=true; } } \
    SBAR(); \
    GAPB(o[0]=__builtin_amdgcn_mfma_f32_32x32x16_bf16(PAF(0),VFR(0),o[0],0,0,0), C0,0,mlo_); \
    GAPB(o[1]=__builtin_amdgcn_mfma_f32_32x32x16_bf16(PAF(0),VFR(4),o[1],0,0,0), C0,4,mlo_); \
    KRD(GL,0); GAPB(o[0]=__builtin_amdgcn_mfma_f32_32x32x16_bf16(PAF(1),VFR(1),o[0],0,0,0), C0,8,mlo_); \
    KRD(GL,1); GAPB(o[1]=__builtin_amdgcn_mfma_f32_32x32x16_bf16(PAF(1),VFR(5),o[1],0,0,0), C0,12,mlo_); \
    KRD(GL,2); GAPB(o[0]=__builtin_amdgcn_mfma_f32_32x32x16_bf16(PAF(2),VFR(2),o[0],0,0,0), C1,0,mhi_); \
    KRD(GL,3); GAPB(o[1]=__builtin_amdgcn_mfma_f32_32x32x16_bf16(PAF(2),VFR(6),o[1],0,0,0), C1,4,mhi_); \
    GAPB(o[0]=__builtin_amdgcn_mfma_f32_32x32x16_bf16(PAF(3),VFR(3),o[0],0,0,0), C1,8,mhi_); \
    GAPB(o[1]=__builtin_amdgcn_mfma_f32_32x32x16_bf16(PAF(3),VFR(7),o[1],0,0,0), C1,12,mhi_); \
    }while(0)
  int t=1;
  for(;t+5<NT;t+=2){
    STEP(pB0,pB1,pA0,pA1,t,true,true,true,true);     WAIT_BAR(3); RESC(); ROT();
    STEP(pA0,pA1,pB0,pB1,t+1,true,true,true,true);   WAIT_BAR(3); RESC(); ROT();
  }
  #define ENDW(tt) do{ if((tt)+3<NT){WAIT_BAR(3);} else if((tt)+2<NT){WAIT_BAR(2);} else {WAIT_BAR(0);} }while(0)
  for(;t+1<NT;t+=2){
    STEP(pB0,pB1,pA0,pA1,t,(t+3<NT),(t+1<NT),(t+1<NT),(t+2<NT));       ENDW(t);   RESC(); ROT();
    STEP(pA0,pA1,pB0,pB1,t+1,(t+4<NT),(t+2<NT),(t+2<NT),(t+3<NT));     ENDW(t+1); RESC(); ROT();
  }
  STEP(pB0,pB1,pA0,pA1,NT-1,false,false,false,false); RESC();
  { float sacc=pB0[0]+pB0[1]; _Pragma("unroll") for(int r=2;r<16;++r)sacc+=pB0[r]; _Pragma("unroll") for(int r=0;r<16;++r)sacc+=pB1[r]; l_reg+=sacc;
    pw0=(u32x4){PKW(pB0,0),PKW(pB0,2),PKW(pB0,4),PKW(pB0,6)};pw1=(u32x4){PKW(pB0,8),PKW(pB0,10),PKW(pB0,12),PKW(pB0,14)};pw2=(u32x4){PKW(pB1,0),PKW(pB1,2),PKW(pB1,4),PKW(pB1,6)};pw3=(u32x4){PKW(pB1,8),PKW(pB1,10),PKW(pB1,12),PKW(pB1,14)};
    SBAR(); pv(o,vb0+sl_cur,PAF(0),PAF(1),PAF(2),PAF(3)); }
  #undef PKW
  #undef PAF
  #undef VFR
  #undef PIN
  #undef MX3
  #undef GAPA
  #undef GAPB
  #undef EX
  #undef VRD
  #undef KRD
  #undef STEP
  #undef ENDW
  {auto rr=__builtin_amdgcn_permlane32_swap(__float_as_uint(l_reg),__float_as_uint(l_reg),false,false);l_reg=__uint_as_float(rr[0])+__uint_as_float(rr[1]);}
  if(hi==0)wsf[32+r32]=l_reg;asm volatile("s_waitcnt lgkmcnt(0)":::"memory");
  float rli[16];
  #pragma unroll
  for(int r=0;r<16;++r)rli[r]=__builtin_amdgcn_rcpf(wsf[32+crow(r,hi)]);
  bf16*Ow=O+(rowbase+q0+wid*QBLK)*OPITCH+h*D;
  { bf16*stg=(bf16*)(shm+LDS_OST)+wid*2048;
    #pragma unroll
    for(int r=0;r<16;++r){const int orow=crow(r,hi);
      #pragma unroll
      for(int d0=0;d0<2;++d0)stg[orow*64+d0*32+r32]=__float2bfloat16(o[d0][r]*rli[r]);}
    asm volatile("s_waitcnt lgkmcnt(0)":::"memory");
    #pragma unroll
    for(int i=0;i<4;++i){const int row=i*8+(lane>>3),ch=lane&7; const u32x4 v=*(const u32x4*)(stg+row*64+ch*8); ATTN_STORE16(Ow+(long)row*OPITCH+ch*8,v);} }
  asm volatile("s_waitcnt lgkmcnt(0)\n\ts_barrier":::"memory");
  #undef DMA_K
  #undef DMA_V
  #undef DMA_M
  #undef MSK
  #undef CMASK
  #undef START
  #undef RESC
  #undef ROT
}
constexpr int ATTN_LDS_BYTES=LDS_BYTES;
struct AttnTensors { const bf16* Q; const bf16* K; const bf16* V; bf16* O; const unsigned* MASK32; };
struct AttnUnit { int bh; int qb; };
struct StaticOrder {
  int vcu, G;
  __device__ __forceinline__ explicit StaticOrder(int grid,int block):vcu((grid%8==0)?(block%8)*(grid/8)+block/8:block),G(grid){}
  __device__ __forceinline__ bool next(int i,AttnUnit&u)const{ const int p=vcu+(i>>1)*G; if(p>=256)return false; const int s=p&7; u.bh=p>>3; u.qb=(i&1)?15-s:s; return true; }
  __device__ __forceinline__ void a_ready(const AttnUnit&)const{}
  __device__ __forceinline__ void done(const AttnUnit&)const{}
};
template<class Sched,int THRL=8> __device__ __forceinline__ void attn_phase(char*lds,const AttnTensors&T,const Sched&S){
  AttnUnit u;
  for(int i=0;S.next(i,u);++i){ S.a_ready(u); attn_unit<THRL>(u.bh/NHEAD,u.bh%NHEAD,u.qb,T.Q,T.K,T.V,T.O,T.MASK32,lds); S.done(u); }
}
#undef SBAR
#undef WAIT_BAR
}
#define GAS __attribute__((address_space(1)))
#define LAS __attribute__((address_space(3)))
typedef unsigned short bf16;
typedef unsigned v4u __attribute__((ext_vector_type(4)));
typedef float f32x4 __attribute__((ext_vector_type(4)));
typedef short bf16x8 __attribute__((ext_vector_type(8)));
typedef GAS unsigned gu32;
typedef GAS unsigned long long gu64;
#define RLX_AGENT __ATOMIC_RELAXED, __HIP_MEMORY_SCOPE_AGENT
#define LDS_WAIT() asm volatile("s_waitcnt lgkmcnt(0)" ::: "memory")
#define VM_WAIT() asm volatile("s_waitcnt vmcnt(0)" ::: "memory")
__device__ __forceinline__ unsigned long long rt() { return __builtin_amdgcn_s_memrealtime(); }
__device__ __forceinline__ unsigned f2bf(float f) { unsigned u = __builtin_bit_cast(unsigned, f); return (u + 0x7fffu + ((u >> 16) & 1u)) >> 16; }
__device__ __forceinline__ unsigned pk2(float lo, float hi) { return f2bf(lo) | (f2bf(hi) << 16); }
#define XB_TMO      128
#define XB_XCNT(j)  (256  + 64 * (j))
#define XB_XSUB(j)  (1280 + 64 * (j))
#define XB_XGEN(j)  (2304 + 64 * (j))
#define XB_TOP      3328
#define XB_TOPGEN   3392
#define XCD_BAR_WORDS 3456
#define XB_SPIN_CAP (1u << 18)

__device__ __forceinline__ unsigned xb_ld(unsigned* p)              { return __hip_atomic_load(p, __ATOMIC_RELAXED, __HIP_MEMORY_SCOPE_AGENT); }
__device__ __forceinline__ unsigned xb_add(unsigned* p, unsigned v) { return __hip_atomic_fetch_add(p, v, __ATOMIC_RELAXED, __HIP_MEMORY_SCOPE_AGENT); }
__device__ __forceinline__ unsigned xb_xcc_id() { return (unsigned)__builtin_amdgcn_s_getreg((3 << 11) | 20) & 0xFu; }
#define XB_SPIN(cond, bar) do { unsigned _sp = 0; while (cond) { __builtin_amdgcn_s_sleep(1); \
    if ((++_sp & 255u) == 0u) { if (xb_ld(&(bar)[XB_TMO])) break; if (_sp > XB_SPIN_CAP) { atomicAdd(&(bar)[XB_TMO], 1u); break; } } } } while (0)

struct XcdBarrier {
    unsigned* bar; unsigned x;
    volatile LAS unsigned* st;
};

__device__ __forceinline__ XcdBarrier xcd_barrier_post(unsigned* bar, volatile LAS unsigned* st) {
    XcdBarrier b; b.bar = bar; b.x = xb_xcc_id(); b.st = st;
    if (threadIdx.x == 0) (void)xb_add(&bar[XB_XCNT(b.x)], 1u);
    return b;
}
__device__ __forceinline__ void xcd_barrier_complete(unsigned* bar, unsigned x, unsigned& nloc, unsigned& nx) {
    const unsigned G = gridDim.x * gridDim.y * gridDim.z;
    unsigned sum, cnt, mine, sp = 0u;
    for (;;) {
        sum = 0u; cnt = 0u; mine = 0u;
#pragma unroll
        for (unsigned j = 0; j < 16; ++j) { const unsigned c = xb_ld(&bar[XB_XCNT(j)]); sum += c; cnt += (c > 0u) ? 1u : 0u; mine = (j == x) ? c : mine; }
        if (sum == G) break;
        __builtin_amdgcn_s_sleep(1);
        if ((++sp & 255u) == 0u) { if (xb_ld(&bar[XB_TMO])) break; if (sp > XB_SPIN_CAP) { atomicAdd(&bar[XB_TMO], 1u); break; } }
    }
    nloc = mine > 0u ? mine : 1u; nx = cnt > 0u ? cnt : 1u;
}

__device__ __forceinline__ void xcd_barrier(const XcdBarrier& b) {
    asm volatile("s_waitcnt vmcnt(0)" ::: "memory");
    __syncthreads();
    if (threadIdx.x == 0) {
        unsigned* bar = b.bar;
        __builtin_amdgcn_s_waitcnt(0);
        unsigned nloc = b.st[0], nx = b.st[1];
        if (nloc == 0u) { xcd_barrier_complete(bar, b.x, nloc, nx); b.st[0] = nloc; b.st[1] = nx; }
        const unsigned old = xb_add(&bar[XB_XSUB(b.x)], 1u);
        const unsigned gen = old / nloc;
        if (old + 1u == (gen + 1u) * nloc) {
            __builtin_amdgcn_fence(__ATOMIC_RELEASE, "agent");
            asm volatile("s_waitcnt vmcnt(0)" ::: "memory");
            const unsigned og = xb_add(&bar[XB_TOP], 1u);
            const unsigned tg = og / nx;
            if (og + 1u == (tg + 1u) * nx) xb_add(&bar[XB_TOPGEN], 1u);
            else XB_SPIN(xb_ld(&bar[XB_TOPGEN]) == tg, bar);
            __builtin_amdgcn_fence(__ATOMIC_ACQUIRE, "agent");
            xb_add(&bar[XB_XGEN(b.x)], 1u);
            asm volatile("s_waitcnt vmcnt(0)" ::: "memory");
        } else {
            XB_SPIN(xb_ld(&bar[XB_XGEN(b.x)]) == gen, bar);
            __builtin_amdgcn_fence(__ATOMIC_ACQUIRE, "agent");
            asm volatile("s_waitcnt vmcnt(0)" ::: "memory");
        }
    }
    __syncthreads();
}
constexpr int NWAVES = 8;
constexpr int DM = 2048, NBATCH = 2, SEQ = 4096, MTOK = NBATCH * SEQ;
constexpr int DCONV = 1024, CONVW = 31, NHEAD = 16, HDIM = 64, TOPK = 256, DFF = 5632;
constexpr int OFF_GLU = 0, OFF_Q = 2048, OFF_K = 3072, OFF_V = 4096, OFF_QI = 5120, OFF_KI = 6144, OFF_WI = 6208, OFF_G = 6224, D_IN = 10320;
constexpr int NP = 10496;
constexpr int NGU = 2 * DFF;
constexpr int KSPLIT = 32, NMOD = 6 * DM;
constexpr float EPS = 1e-6f;
constexpr float LOG2E = 1.4426950408889634f;

constexpr size_t MiB = 1u << 20;
constexpr size_t WS_CTL = 0, CTL_ZERO_BYTES = 1 * MiB;
constexpr size_t WS_MODP = 1 * MiB;
constexpr size_t WS_MODF = 4 * MiB;
constexpr size_t WS_BT_GU = 5 * MiB;
constexpr size_t WS_BT_DN = 49 * MiB;
constexpr size_t WS_BT_O = 71 * MiB;
constexpr size_t WS_BT_CO = 79 * MiB;
constexpr size_t WS_BT_AO = 83 * MiB;
constexpr size_t WS_BT_IN = 87 * MiB;
constexpr size_t WS_H = 128 * MiB;
constexpr size_t WS_PROJ = 160 * MiB;
constexpr size_t WS_CACT = 324 * MiB;
constexpr size_t WS_AOUT = 340 * MiB;
constexpr size_t WS_VT = 356 * MiB;
constexpr size_t WS_MASK = 372 * MiB;
constexpr size_t WS_END = 376 * MiB;
constexpr size_t WS_SCORES = 87 * MiB;
constexpr size_t WS_MERGED = 96 * MiB;
constexpr size_t WS_GU = 160 * MiB;
constexpr size_t WS_F = 248 * MiB;
constexpr int CW_BAR = 4096;

constexpr int RING_OFF = 0, RING_BYTES = 131072;
constexpr int LDSCTL_OFF = RING_BYTES, MISC_OFF = LDSCTL_OFF + 320;
constexpr int LDS_BYTES = 147456;

typedef float f32x16 __attribute__((ext_vector_type(16)));
typedef float f32x2v __attribute__((ext_vector_type(2)));
typedef unsigned u32x2v __attribute__((ext_vector_type(2)));

__device__ __forceinline__ float bf_lo(unsigned u) { return __builtin_bit_cast(float, u << 16); }
__device__ __forceinline__ float bf_hi(unsigned u) { return __builtin_bit_cast(float, u & 0xffff0000u); }
__device__ __forceinline__ float sigmoidf_fast(float v) { return __builtin_amdgcn_rcpf(1.0f + __builtin_amdgcn_exp2f(-v * LOG2E)); }
__device__ __forceinline__ float wave_sum(float v) {
#pragma unroll
    for (int o = 1; o < 64; o <<= 1) v += __shfl_xor(v, o);
    return v;
}

struct EpiStoreBf16 {
    static constexpr bool PERM = true, AFTER_DRAIN = false;
    bf16* O; int ldc; int q_lo, q_hi; float qscale;
    __device__ __forceinline__ void operator()(const f32x4 (&acc)[2][2][4][2], const pg8::Unit& u, int wr, int wc, int fr, int fq) const {
        const int row0 = u.pm * pg8::BM + wr * 64 + fr, colt = u.pn * pg8::BM, col0 = colt + wc * 32 + 8 * fq;
        const float sc = (colt >= q_lo && colt < q_hi) ? qscale : 1.0f;
#pragma unroll
        for (int ai = 0; ai < 2; ++ai)
#pragma unroll
            for (int m = 0; m < 4; ++m) { bf16* rowp = O + (size_t)(row0 + ai * pg8::HALF + m * 16) * ldc + col0;
#pragma unroll
                for (int bj = 0; bj < 2; ++bj) { const f32x4 v0 = acc[ai][bj][m][0] * sc, v1 = acc[ai][bj][m][1] * sc;
                    v4u w; w.x = pg8::cvt_pk_bf16(v0[0], v0[1]); w.y = pg8::cvt_pk_bf16(v0[2], v0[3]); w.z = pg8::cvt_pk_bf16(v1[0], v1[1]); w.w = pg8::cvt_pk_bf16(v1[2], v1[3]);
                    *(v4u*)(rowp + bj * pg8::HALF) = w; } }
    }
};
struct EpiStoreF32 {
    static constexpr bool PERM = false, AFTER_DRAIN = false;
    float* C; int ldc;
    __device__ __forceinline__ void operator()(const f32x4 (&acc)[2][2][4][2], const pg8::Unit& u, int wr, int wc, int fr, int fq) const {
        const int row0 = u.pm * pg8::BM + wr * 64 + fr, col0 = u.pn * pg8::BM + wc * 32 + 4 * fq;
#pragma unroll
        for (int ai = 0; ai < 2; ++ai)
#pragma unroll
            for (int m = 0; m < 4; ++m) { float* rowp = C + (size_t)(row0 + ai * pg8::HALF + m * 16) * ldc + col0;
#pragma unroll
                for (int bj = 0; bj < 2; ++bj)
#pragma unroll
                    for (int n = 0; n < 2; ++n) *(f32x4*)(rowp + bj * pg8::HALF + n * 16) = acc[ai][bj][m][n]; }
    }
};
struct EpiGateConv {
    static constexpr bool PERM = true, AFTER_DRAIN = false;
    float* C; const bf16* G; int ldg;
    __device__ __forceinline__ void operator()(const f32x4 (&acc)[2][2][4][2], const pg8::Unit& u, int wr, int wc, int fr, int fq) const {
        const int row0 = u.pm * pg8::BM + wr * 64 + fr, col0 = u.pn * pg8::BM + wc * 32 + 8 * fq;
#pragma unroll
        for (int ai = 0; ai < 2; ++ai)
#pragma unroll
            for (int m = 0; m < 4; ++m) { const int row = row0 + ai * pg8::HALF + m * 16; float* rowp = C + (size_t)row * DM + col0; const bf16* gp = G + (size_t)row * ldg + col0;
#pragma unroll
                for (int bj = 0; bj < 2; ++bj) { const v4u g = *(const v4u*)(gp + bj * pg8::HALF); const f32x4 a0 = acc[ai][bj][m][0], a1 = acc[ai][bj][m][1];
                    f32x4 o0, o1;
                    o0[0] = a0[0] * sigmoidf_fast(bf_lo(g.x)); o0[1] = a0[1] * sigmoidf_fast(bf_hi(g.x)); o0[2] = a0[2] * sigmoidf_fast(bf_lo(g.y)); o0[3] = a0[3] * sigmoidf_fast(bf_hi(g.y));
                    o1[0] = a1[0] * sigmoidf_fast(bf_lo(g.z)); o1[1] = a1[1] * sigmoidf_fast(bf_hi(g.z)); o1[2] = a1[2] * sigmoidf_fast(bf_lo(g.w)); o1[3] = a1[3] * sigmoidf_fast(bf_hi(g.w));
                    *(f32x4*)(rowp + bj * pg8::HALF) = o0; *(f32x4*)(rowp + bj * pg8::HALF + 4) = o1; } }
    }
};
struct EpiGateAttn {
    static constexpr bool PERM = true, AFTER_DRAIN = false;
    const float* T; const bf16* G; int ldg; bf16* O;
    __device__ __forceinline__ void operator()(const f32x4 (&acc)[2][2][4][2], const pg8::Unit& u, int wr, int wc, int fr, int fq) const {
        const int row0 = u.pm * pg8::BM + wr * 64 + fr, col0 = u.pn * pg8::BM + wc * 32 + 8 * fq;
#pragma unroll
        for (int ai = 0; ai < 2; ++ai)
#pragma unroll
            for (int m = 0; m < 4; ++m) { const int row = row0 + ai * pg8::HALF + m * 16; const float* tp = T + (size_t)row * DM + col0; const bf16* gp = G + (size_t)row * ldg + col0; bf16* op = O + (size_t)row * DM + col0;
#pragma unroll
                for (int bj = 0; bj < 2; ++bj) { const v4u g = *(const v4u*)(gp + bj * pg8::HALF); const f32x4 t0 = *(const f32x4*)(tp + bj * pg8::HALF), t1 = *(const f32x4*)(tp + bj * pg8::HALF + 4);
                    const f32x4 a0 = acc[ai][bj][m][0], a1 = acc[ai][bj][m][1];
                    const float o0 = t0[0] + a0[0] * sigmoidf_fast(bf_lo(g.x)), o1 = t0[1] + a0[1] * sigmoidf_fast(bf_hi(g.x)), o2 = t0[2] + a0[2] * sigmoidf_fast(bf_lo(g.y)), o3 = t0[3] + a0[3] * sigmoidf_fast(bf_hi(g.y));
                    const float o4 = t1[0] + a1[0] * sigmoidf_fast(bf_lo(g.z)), o5 = t1[1] + a1[1] * sigmoidf_fast(bf_hi(g.z)), o6 = t1[2] + a1[2] * sigmoidf_fast(bf_lo(g.w)), o7 = t1[3] + a1[3] * sigmoidf_fast(bf_hi(g.w));
                    v4u w; w.x = pg8::cvt_pk_bf16(o0, o1); w.y = pg8::cvt_pk_bf16(o2, o3); w.z = pg8::cvt_pk_bf16(o4, o5); w.w = pg8::cvt_pk_bf16(o6, o7);
                    *(v4u*)(op + bj * pg8::HALF) = w; } }
    }
};
struct EpiSwiGLU {
    static constexpr bool PERM = true, AFTER_DRAIN = false;
    bf16* O;
    __device__ __forceinline__ void operator()(const f32x4 (&acc)[2][2][4][2], const pg8::Unit& u, int wr, int wc, int fr, int fq) const {
        const int row0 = u.pm * pg8::BM + wr * 64 + fr, col0 = (u.pn * pg8::BM + wc * 32 + 8 * fq) >> 1;
#pragma unroll
        for (int ai = 0; ai < 2; ++ai)
#pragma unroll
            for (int m = 0; m < 4; ++m) { bf16* rowp = O + (size_t)(row0 + ai * pg8::HALF + m * 16) * DFF + col0;
#pragma unroll
                for (int bj = 0; bj < 2; ++bj) { const f32x4 g = acc[ai][bj][m][0], up = acc[ai][bj][m][1];
                    const float h0 = g[0] * sigmoidf_fast(g[0]) * up[0], h1 = g[1] * sigmoidf_fast(g[1]) * up[1], h2 = g[2] * sigmoidf_fast(g[2]) * up[2], h3 = g[3] * sigmoidf_fast(g[3]) * up[3];
                    u32x2v w; w.x = pg8::cvt_pk_bf16(h0, h1); w.y = pg8::cvt_pk_bf16(h2, h3);
                    *(u32x2v*)(rowp + bj * (pg8::HALF / 2)) = w; } }
    }
};

struct Frame {
    LAS unsigned char* lds;
    volatile LAS unsigned* MISC;
    gu32* ctl;
    int tid, lane, wave, G, bid;
    float* out; unsigned char* ws;
};
template <int K> __device__ __forceinline__ const float* kin() {
    unsigned long long v;
    asm volatile("s_load_dwordx2 %0, %1, %2\n\ts_waitcnt lgkmcnt(0)" : "=s"(v) : "s"(__builtin_amdgcn_kernarg_segment_ptr()), "i"(8 * K));
    return (const float*)(const GAS float*)v;
}
enum { I_X = 0, I_C, I_WADA, I_BADA, I_GPREMIX, I_WIN, I_WDW, I_BDW, I_GLN, I_BLN, I_WCO, I_WAO, I_WO, I_GPOSTMIX, I_GPREFFN, I_WGATE, I_WUP, I_WDOWN, I_GPOSTFFN };

template <int MODE>
__device__ __forceinline__ void p0_transpose_item(const float* W, int K, int N, bf16* WT, int row_off, LAS float* scr, int item, int lane) {
    const int nblk = (N + 31) / 32, kb = item / nblk, nb = item % nblk, k0 = 64 * kb, n0 = 32 * nb;
    const int nn = n0 + (lane & 31); const bool nok = nn < N;
#pragma unroll 8
    for (int i = 0; i < 32; ++i) { const int kk = 2 * i + (lane >> 5); scr[kk * 33 + (lane & 31)] = nok ? W[(size_t)(k0 + kk) * N + nn] : 0.f; }
    LDS_WAIT(); asm volatile("" ::: "memory");
    const int c = lane & 7;
#pragma unroll
    for (int j = 0; j < 4; ++j) { const int n = (lane >> 3) + 8 * j; const LAS float* s = scr + (8 * c) * 33 + n;
        v4u o; o.x = pk2(s[0 * 33], s[1 * 33]); o.y = pk2(s[2 * 33], s[3 * 33]); o.z = pk2(s[4 * 33], s[5 * 33]); o.w = pk2(s[6 * 33], s[7 * 33]);
        const int gn = n0 + n;
        if (gn < N) { const int dr = (MODE == 0) ? (row_off + gn) : (8 * (gn >> 2) + (gn & 3) + row_off);
            *(GAS v4u*)(WT + (size_t)dr * K + k0 + 8 * c) = o; } }
    LDS_WAIT(); asm volatile("" ::: "memory");
}

__device__ __forceinline__ void p0_prologue(Frame& F) {
    const int gw = F.bid * NWAVES + F.wave, NGW = F.G * NWAVES;
    {
        const float* c = kin<I_C>(); const float* wada = kin<I_WADA>(); float* modp = (float*)(F.ws + WS_MODP);
        for (int unit = gw; unit < KSPLIT * (NMOD / 256); unit += NGW) {
            const int ks = unit / (NMOD / 256), nt = unit % (NMOD / 256), k0 = 64 * ks, col0 = 256 * nt + 4 * F.lane;
            const float c0 = c[k0 + F.lane], c1 = c[DM + k0 + F.lane];
            const float s0 = c0 / (1.0f + __expf(-c0)), s1 = c1 / (1.0f + __expf(-c1));
            f32x4 a0 = {0.f, 0.f, 0.f, 0.f}, a1 = {0.f, 0.f, 0.f, 0.f};
            const float* wp = wada + (size_t)k0 * NMOD + col0;
            for (int kk0 = 0; kk0 < 64; kk0 += 16) {
                f32x4 w[16];
#pragma unroll
                for (int q = 0; q < 16; ++q) w[q] = __builtin_nontemporal_load((const f32x4*)(wp + (size_t)(kk0 + q) * NMOD));
#pragma unroll
                for (int q = 0; q < 16; ++q) { const float t0 = __builtin_bit_cast(float, __builtin_amdgcn_readlane(__builtin_bit_cast(int, s0), kk0 + q)), t1 = __builtin_bit_cast(float, __builtin_amdgcn_readlane(__builtin_bit_cast(int, s1), kk0 + q)); a0 += t0 * w[q]; a1 += t1 * w[q]; }
            }
            *(f32x4*)(modp + (size_t)(ks * 2 + 0) * NMOD + col0) = a0;
            *(f32x4*)(modp + (size_t)(ks * 2 + 1) * NMOD + col0) = a1;
        }
    }
    LAS float* scr = (LAS float*)(F.lds + RING_OFF + F.wave * 16384);
    bf16* bt_in = (bf16*)(F.ws + WS_BT_IN); bf16* bt_gu = (bf16*)(F.ws + WS_BT_GU); bf16* bt_dn = (bf16*)(F.ws + WS_BT_DN);
    bf16* bt_o = (bf16*)(F.ws + WS_BT_O); bf16* bt_co = (bf16*)(F.ws + WS_BT_CO); bf16* bt_ao = (bf16*)(F.ws + WS_BT_AO);
    constexpr int I_IN = (DM / 64) * ((D_IN + 31) / 32), I_GT = (DM / 64) * (DFF / 32), I_DN = (DFF / 64) * (DM / 32), I_O = (DM / 64) * (DM / 32), I_CO = (DCONV / 64) * (DM / 32);
    constexpr int NITEMS = I_IN + 2 * I_GT + I_DN + I_O + 2 * I_CO;
    for (int it = gw; it < NITEMS; it += NGW) {
        int r = it;
        if (r < I_IN) { p0_transpose_item<0>(kin<I_WIN>(), DM, D_IN, bt_in, 0, scr, r, F.lane); continue; } r -= I_IN;
        if (r < I_GT) { p0_transpose_item<1>(kin<I_WGATE>(), DM, DFF, bt_gu, 0, scr, r, F.lane); continue; } r -= I_GT;
        if (r < I_GT) { p0_transpose_item<1>(kin<I_WUP>(), DM, DFF, bt_gu, 4, scr, r, F.lane); continue; } r -= I_GT;
        if (r < I_DN) { p0_transpose_item<0>(kin<I_WDOWN>(), DFF, DM, bt_dn, 0, scr, r, F.lane); continue; } r -= I_DN;
        if (r < I_O) { p0_transpose_item<0>(kin<I_WO>(), DM, DM, bt_o, 0, scr, r, F.lane); continue; } r -= I_O;
        if (r < I_CO) { p0_transpose_item<0>(kin<I_WCO>(), DCONV, DM, bt_co, 0, scr, r, F.lane); continue; } r -= I_CO;
        p0_transpose_item<0>(kin<I_WAO>(), DCONV, DM, bt_ao, 0, scr, r, F.lane);
    }
    {
        GAS v4u* z = (GAS v4u*)(bt_in + (size_t)D_IN * DM); const int nz = (NP - D_IN) * DM * 2 / 16;
        for (int i = F.bid * (NWAVES * 64) + F.tid; i < nz; i += F.G * NWAVES * 64) z[i] = (v4u){0u, 0u, 0u, 0u};
    }
}

__device__ __forceinline__ float mod_sum(const float* modp, const float* bada, int bb, int col) {
    float s = bada[col];
#pragma unroll 8
    for (int ks = 0; ks < KSPLIT; ++ks) s += modp[(size_t)(ks * 2 + bb) * NMOD + col];
    return s;
}
__device__ __forceinline__ void p1_h1(Frame& F) {
    const float* modp = (const float*)(F.ws + WS_MODP); float* modf = (float*)(F.ws + WS_MODF); const float* bada = kin<I_BADA>();
    LAS float* scaleL = (LAS float*)(F.lds + RING_OFF); LAS float* shiftL = scaleL + DM;
    bf16* H = (bf16*)(F.ws + WS_H);
    for (int idx = F.bid * (NWAVES * 64) + F.tid; idx < 2 * NMOD; idx += F.G * NWAVES * 64) { const int bb = idx / NMOD, col = idx % NMOD; modf[idx] = mod_sum(modp, bada, bb, col); }
    for (int tile = F.bid; tile < MTOK / 32; tile += F.G) {
        const int bb = tile / (SEQ / 32);
        __syncthreads();
        for (int j = 0; j < 8; ++j) { const int col = F.tid + 512 * j; const float s = mod_sum(modp, bada, bb, col);
            if (col < DM) shiftL[col] = s; else scaleL[col - DM] = kin<I_GPREMIX>()[col - DM] * (1.0f + s); }
        __syncthreads();
        for (int i = 0; i < 4; ++i) {
            const int row = tile * 32 + F.wave * 4 + i;
            const f32x4* xr = (const f32x4*)(kin<I_X>() + (size_t)row * DM) + F.lane;
            f32x4 v[8]; float ss = 0.f;
#pragma unroll
            for (int j = 0; j < 8; ++j) { v[j] = xr[64 * j]; ss += (v[j][0] * v[j][0] + v[j][1] * v[j][1]) + (v[j][2] * v[j][2] + v[j][3] * v[j][3]); }
            const float rstd = 1.0f / sqrtf(wave_sum(ss) * (1.0f / DM) + EPS);
            unsigned long long* o8 = (unsigned long long*)(H + (size_t)row * DM) + F.lane;
#pragma unroll
            for (int j = 0; j < 8; ++j) { const f32x4 sc = *(const LAS f32x4*)(scaleL + 4 * F.lane + 256 * j), sh = *(const LAS f32x4*)(shiftL + 4 * F.lane + 256 * j);
                const f32x4 h = v[j] * rstd * sc + sh;
                o8[64 * j] = (unsigned long long)pk2(h[0], h[1]) | ((unsigned long long)pk2(h[2], h[3]) << 32); }
        }
    }
    __syncthreads();
}

template <int II> struct ConvLoop {
    static __device__ __forceinline__ void run(f32x2v (&acc)[32], const f32x2v (&w)[CONVW], const bf16* PROJ, int bb, int s0, int ch) {
        const int sin = s0 - 30 + II; const int sc = sin < 0 ? 0 : sin; const float ok = sin < 0 ? 0.f : 1.f;
        const bf16* rp = PROJ + (size_t)(bb * SEQ + sc) * NP + OFF_GLU + ch;
        const unsigned a2 = *(const unsigned*)rp, g2 = *(const unsigned*)(rp + DCONV);
        f32x2v u; u.x = ok * bf_lo(a2) * sigmoidf_fast(bf_lo(g2)); u.y = ok * bf_hi(a2) * sigmoidf_fast(bf_hi(g2));
        constexpr int lo = II > 30 ? II - 30 : 0, hi = II < 31 ? II : 31;
#pragma unroll
        for (int o = lo; o <= hi; ++o) acc[o] += w[II - o] * u;
        if ((II & 7) == 7) asm volatile("" ::: "memory");
        ConvLoop<II + 1>::run(acc, w, PROJ, bb, s0, ch);
    }
};
template <> struct ConvLoop<62> { static __device__ __forceinline__ void run(f32x2v (&)[32], const f32x2v (&)[CONVW], const bf16*, int, int, int) {} };

__device__ __forceinline__ void p3_conv_tile(Frame& F, int tile) {
    const bf16* PROJ = (const bf16*)(F.ws + WS_PROJ); bf16* CACT = (bf16*)(F.ws + WS_CACT);
    LAS float* red = (LAS float*)(F.lds + RING_OFF);
    LAS float* stat = red + 8 * 64;
    const int bb = tile / (SEQ / 32), s0 = (tile % (SEQ / 32)) * 32, ch = 2 * F.tid;
    f32x2v w[CONVW];
#pragma unroll
    for (int j = 0; j < CONVW; ++j) w[j] = *(const f32x2v*)(kin<I_WDW>() + j * DCONV + ch);
    f32x2v acc[32];
#pragma unroll
    for (int o = 0; o < 32; ++o) acc[o] = (f32x2v){0.f, 0.f};
    ConvLoop<0>::run(acc, w, PROJ, bb, s0, ch);
    const f32x2v bdw = *(const f32x2v*)(kin<I_BDW>() + ch);
    float vals[64];
#pragma unroll
    for (int o = 0; o < 32; ++o) { acc[o] += bdw; vals[2 * o] = acc[o].x + acc[o].y; vals[2 * o + 1] = acc[o].x * acc[o].x + acc[o].y * acc[o].y; }
#define BFLY(d, n) do { const bool up = (F.lane & (d)) != 0; _Pragma("unroll") for (int k = 0; k < (n); ++k) { const float send = up ? vals[k] : vals[k + (n)], keep = up ? vals[k + (n)] : vals[k]; vals[k] = keep + __shfl_xor(send, (d)); } } while (0)
    BFLY(32, 32); BFLY(16, 16); BFLY(8, 8); BFLY(4, 4); BFLY(2, 2); BFLY(1, 1);
#undef BFLY
    __syncthreads();
    red[F.wave * 64 + F.lane] = vals[0];
    __syncthreads();
    if (F.tid < 32) { float s = 0.f, q = 0.f;
#pragma unroll
        for (int wv = 0; wv < 8; ++wv) { s += red[wv * 64 + 2 * F.tid]; q += red[wv * 64 + 2 * F.tid + 1]; }
        const float mean = s * (1.0f / DCONV), var = q * (1.0f / DCONV) - mean * mean;
        stat[2 * F.tid] = mean; stat[2 * F.tid + 1] = 1.0f / sqrtf(var + EPS); }
    __syncthreads();
    const f32x2v gl = *(const f32x2v*)(kin<I_GLN>() + ch), bl = *(const f32x2v*)(kin<I_BLN>() + ch);
#pragma unroll
    for (int o = 0; o < 32; ++o) { const float mean = stat[2 * o], rstd = stat[2 * o + 1];
        const float z0 = (acc[o].x - mean) * rstd * gl.x + bl.x, z1 = (acc[o].y - mean) * rstd * gl.y + bl.y;
        *(unsigned*)(CACT + (size_t)(bb * SEQ + s0 + o) * DCONV + ch) = pg8::cvt_pk_bf16(z0 * sigmoidf_fast(z0), z1 * sigmoidf_fast(z1)); }
}

__device__ __forceinline__ void p3_indexer_unit(Frame& F, int p, float* scratch) {
    const bf16* PROJ = (const bf16*)(F.ws + WS_PROJ); unsigned long long* MASK = (unsigned long long*)(F.ws + WS_MASK);
    const int bb = p & 1, sp = p >> 1, q0 = bb * SEQ + 2 * sp, c = (2 * sp) >> 6, nj = c + 1, ntile = 2 * nj;
    const int lane = F.lane, rho = lane & 31, hh = lane >> 5, e = (rho >> 2) & 1, hd = (rho & 3) + 4 * (rho >> 3);
    bf16x8 A[4];
    { const bf16* qrow = PROJ + (size_t)(q0 + e) * NP + OFF_QI + hd * 64 + 8 * hh;
#pragma unroll
      for (int s = 0; s < 4; ++s) A[s] = *(const bf16x8*)(qrow + 16 * s); }
    float wv[16];
    { const v4u* wrow = (const v4u*)(PROJ + (size_t)(q0 + hh) * NP + OFF_WI); const v4u w0 = wrow[0], w1 = wrow[1];
      const float sc = 0.03125f;
      wv[0] = bf_lo(w0.x) * sc; wv[1] = bf_hi(w0.x) * sc; wv[2] = bf_lo(w0.y) * sc; wv[3] = bf_hi(w0.y) * sc; wv[4] = bf_lo(w0.z) * sc; wv[5] = bf_hi(w0.z) * sc; wv[6] = bf_lo(w0.w) * sc; wv[7] = bf_hi(w0.w) * sc;
      wv[8] = bf_lo(w1.x) * sc; wv[9] = bf_hi(w1.x) * sc; wv[10] = bf_lo(w1.y) * sc; wv[11] = bf_hi(w1.y) * sc; wv[12] = bf_lo(w1.z) * sc; wv[13] = bf_hi(w1.z) * sc; wv[14] = bf_lo(w1.w) * sc; wv[15] = bf_hi(w1.w) * sc; }
    const bf16* kbase = PROJ + (size_t)(bb * SEQ + rho) * NP + OFF_KI + 8 * hh;
    float* scp = scratch + hh * SEQ + rho;
#pragma unroll 2
    for (int kt = 0; kt < ntile; ++kt) {
        const bf16* kp = kbase + (size_t)kt * 32 * NP;
        bf16x8 B[4];
#pragma unroll
        for (int s = 0; s < 4; ++s) B[s] = *(const bf16x8*)(kp + 16 * s);
        f32x16 acc = {0.f, 0.f, 0.f, 0.f, 0.f, 0.f, 0.f, 0.f, 0.f, 0.f, 0.f, 0.f, 0.f, 0.f, 0.f, 0.f};
#pragma unroll
        for (int s = 0; s < 4; ++s) acc = __builtin_amdgcn_mfma_f32_32x32x16_bf16(A[s], B[s], acc, 0, 0, 0);
        float v = 0.f;
#pragma unroll
        for (int r = 0; r < 16; ++r) v += wv[r] * fmaxf(acc[r], 0.f);
        scp[32 * kt] = v;
    }
    asm volatile("s_waitcnt vmcnt(0)" ::: "memory");
    for (int eq = 0; eq < 2; ++eq) {
        unsigned key[64];
#pragma unroll
        for (int j = 0; j < 64; ++j) {
            key[j] = 0u;
            if (j < nj) { const unsigned u = __hip_atomic_load((unsigned*)(scratch + eq * SEQ + 64 * j + lane), __ATOMIC_RELAXED, __HIP_MEMORY_SCOPE_AGENT);
                key[j] = (u & 0x80000000u) ? ~u : (u | 0x80000000u); }
        }
        unsigned T = 0u;
        if (nj * 64 > TOPK) {
            for (int bit = 31; bit >= 0; --bit) {
                const unsigned cand = T | (1u << bit); int cnt = 0;
#pragma unroll
                for (int j = 0; j < 64; ++j) cnt += __popcll(__ballot(key[j] >= cand));
                if (cnt >= TOPK) T = cand;
                if (cnt == TOPK) break;
            }
        }
        unsigned long long myw = 0ull;
#pragma unroll
        for (int j = 0; j < 64; ++j) { const unsigned long long mk = __ballot(key[j] >= T); if (lane == j) myw = mk; }
        MASK[(size_t)(q0 + eq) * 64 + lane] = (lane < nj) ? myw : 0ull;
    }
    asm volatile("s_waitcnt vmcnt(0)" ::: "memory");
}

__device__ __forceinline__ void p7_rows(Frame& F) {
    const float* modf = (const float*)(F.ws + WS_MODF); bf16* H = (bf16*)(F.ws + WS_H);
    LAS float* A1 = (LAS float*)(F.lds + RING_OFF); LAS float* S2 = A1 + DM; LAS float* T2 = S2 + DM;
    for (int tile = F.bid; tile < MTOK / 32; tile += F.G) {
        const int bb = tile / (SEQ / 32);
        __syncthreads();
        for (int j = 0; j < 4; ++j) { const int col = F.tid + 512 * j;
            A1[col] = modf[bb * NMOD + 2 * DM + col] * kin<I_GPOSTMIX>()[col];
            S2[col] = kin<I_GPREFFN>()[col] * (1.0f + modf[bb * NMOD + 4 * DM + col]);
            T2[col] = modf[bb * NMOD + 3 * DM + col]; }
        __syncthreads();
        for (int i = 0; i < 4; ++i) {
            const int row = tile * 32 + F.wave * 4 + i;
            const f32x4* xr = (const f32x4*)(kin<I_X>() + (size_t)row * DM) + F.lane;
            f32x4* mr = (f32x4*)(F.out + (size_t)row * DM) + F.lane;
            f32x4 mv[8], xv[8]; float ss = 0.f;
#pragma unroll
            for (int j = 0; j < 8; ++j) { mv[j] = mr[64 * j]; xv[j] = xr[64 * j]; ss += (mv[j][0] * mv[j][0] + mv[j][1] * mv[j][1]) + (mv[j][2] * mv[j][2] + mv[j][3] * mv[j][3]); }
            const float rstd = 1.0f / sqrtf(wave_sum(ss) * (1.0f / DM) + EPS);
            float s1 = 0.f;
#pragma unroll
            for (int j = 0; j < 8; ++j) { const f32x4 a = *(const LAS f32x4*)(A1 + 4 * F.lane + 256 * j); xv[j] = xv[j] + mv[j] * rstd * a;
                s1 += (xv[j][0] * xv[j][0] + xv[j][1] * xv[j][1]) + (xv[j][2] * xv[j][2] + xv[j][3] * xv[j][3]); mr[64 * j] = xv[j]; }
            const float rstd1 = 1.0f / sqrtf(wave_sum(s1) * (1.0f / DM) + EPS);
            unsigned long long* o8 = (unsigned long long*)(H + (size_t)row * DM) + F.lane;
#pragma unroll
            for (int j = 0; j < 8; ++j) { const f32x4 sc = *(const LAS f32x4*)(S2 + 4 * F.lane + 256 * j), sh = *(const LAS f32x4*)(T2 + 4 * F.lane + 256 * j);
                const f32x4 h = xv[j] * rstd1 * sc + sh;
                o8[64 * j] = (unsigned long long)pk2(h[0], h[1]) | ((unsigned long long)pk2(h[2], h[3]) << 32); }
        }
    }
    __syncthreads();
}
__device__ __forceinline__ void p10_rows(Frame& F) {
    const float* modf = (const float*)(F.ws + WS_MODF); const float* Fb = (const float*)(F.ws + WS_F);
    LAS float* A2 = (LAS float*)(F.lds + RING_OFF);
    for (int tile = F.bid; tile < MTOK / 32; tile += F.G) {
        const int bb = tile / (SEQ / 32);
        __syncthreads();
        for (int j = 0; j < 4; ++j) { const int col = F.tid + 512 * j; A2[col] = modf[bb * NMOD + 5 * DM + col] * kin<I_GPOSTFFN>()[col]; }
        __syncthreads();
        for (int i = 0; i < 4; ++i) {
            const int row = tile * 32 + F.wave * 4 + i;
            const f32x4* fr = (const f32x4*)(Fb + (size_t)row * DM) + F.lane;
            f32x4* orow = (f32x4*)(F.out + (size_t)row * DM) + F.lane;
            f32x4 fv[8], xv[8]; float ss = 0.f;
#pragma unroll
            for (int j = 0; j < 8; ++j) { fv[j] = fr[64 * j]; xv[j] = orow[64 * j]; ss += (fv[j][0] * fv[j][0] + fv[j][1] * fv[j][1]) + (fv[j][2] * fv[j][2] + fv[j][3] * fv[j][3]); }
            const float rstd = 1.0f / sqrtf(wave_sum(ss) * (1.0f / DM) + EPS);
#pragma unroll
            for (int j = 0; j < 8; ++j) { const f32x4 a = *(const LAS f32x4*)(A2 + 4 * F.lane + 256 * j); orow[64 * j] = xv[j] + fv[j] * rstd * a; }
        }
    }
}

#ifndef MK_N_LAUNCHES
#define MK_N_LAUNCHES 1
#endif
constexpr int N_PHASES = 11;
struct Args { const float* in[19]; float* out; unsigned char* ws; int ph_lo, ph_hi; };
__global__ void __launch_bounds__(NWAVES * 64, 2) mk_fwd(Args args) {
    extern __shared__ __attribute__((aligned(16))) unsigned char lds[];
    Frame F;
    F.lds = (LAS unsigned char*)lds;
    F.MISC = (volatile LAS unsigned*)(F.lds + MISC_OFF);
    F.tid = threadIdx.x; F.lane = F.tid & 63; F.wave = __builtin_amdgcn_readfirstlane(F.tid >> 6);
    F.G = gridDim.x; F.bid = blockIdx.x;
    F.ws = args.ws; F.out = args.out; F.ctl = (gu32*)(args.ws + WS_CTL);
    for (int u = F.tid; u < (LDS_BYTES - LDSCTL_OFF) / 4; u += NWAVES * 64) ((LAS unsigned*)(F.lds + LDSCTL_OFF))[u] = 0u;
    __syncthreads();
    XcdBarrier bar; bar.bar = (unsigned*)(F.ctl + CW_BAR); bar.x = 0; bar.st = nullptr;
    if (MK_N_LAUNCHES == 1) bar = xcd_barrier_post((unsigned*)(F.ctl + CW_BAR), F.MISC + 8);
    const int lo = args.ph_lo, hi = args.ph_hi;
#define IN(k) (lo <= (k) && (k) < hi)
#define SEAM(k) do { if (IN(k) && IN((k) + 1)) xcd_barrier(bar); } while (0)
#ifndef DUP_PHASE
#define DUP_PHASE (-1)
#endif
#define PH(k) if (IN(k)) for (int rep_ = 0; rep_ < ((k) == DUP_PHASE ? 2 : 1); ++rep_)
#define REP_BAR() do { if (rep_) xcd_barrier(bar); } while (0)
    bf16* H = (bf16*)(F.ws + WS_H); bf16* PROJ = (bf16*)(F.ws + WS_PROJ);
    const int gw = F.bid * NWAVES + F.wave, NGW = F.G * NWAVES;

    PH(0) { REP_BAR(); p0_prologue(F); } SEAM(0);
    PH(1) { REP_BAR(); p1_h1(F); } SEAM(1);
    PH(2) { REP_BAR();
        pg8::Gemm g{H, (const bf16*)(F.ws + WS_BT_IN), MTOK, NP, DM}; pg8::StaticOrder S; S.init(MTOK, NP, F.G, F.bid);
        EpiStoreBf16 E{PROJ, NP, OFF_Q, OFF_K, attn_body::C2};
        pg8::gemm_phase<EpiStoreBf16, pg8::StaticOrder, true, true>(F.lds + RING_OFF, g, S, E);
    } SEAM(2);
    PH(3) { REP_BAR();
        for (int tile = F.bid; tile < MTOK / 32; tile += F.G) p3_conv_tile(F, tile);
        float* scratch = (float*)(F.ws + WS_SCORES) + (size_t)gw * (2 * SEQ);
        for (int p = gw; p < MTOK / 4; p += NGW) { p3_indexer_unit(F, p, scratch); p3_indexer_unit(F, MTOK / 2 - 1 - p, scratch); }
    } SEAM(3);
    PH(4) { REP_BAR();
        static_assert(attn_body::ATTN_LDS_BYTES <= RING_BYTES, "attention LDS");
        const attn_body::AttnTensors AT{(const attn_body::bf16*)(PROJ + OFF_Q), (const attn_body::bf16*)(PROJ + OFF_K), (const attn_body::bf16*)(PROJ + OFF_V), (attn_body::bf16*)(F.ws + WS_AOUT), (const unsigned*)(F.ws + WS_MASK)};
        const attn_body::StaticOrder S(F.G, F.bid);
        attn_body::attn_phase<attn_body::StaticOrder>((char*)lds + RING_OFF, AT, S);
    } SEAM(4);
    PH(5) { REP_BAR();
        { pg8::Gemm g{(const bf16*)(F.ws + WS_CACT), (const bf16*)(F.ws + WS_BT_CO), MTOK, DM, DCONV}; pg8::StaticOrder S; S.init(MTOK, DM, F.G, F.bid);
          EpiGateConv E{F.out, PROJ + OFF_G, NP};
          pg8::gemm_phase<EpiGateConv, pg8::StaticOrder, true, true>(F.lds + RING_OFF, g, S, E); }
        { pg8::Gemm g{(const bf16*)(F.ws + WS_AOUT), (const bf16*)(F.ws + WS_BT_AO), MTOK, DM, DCONV}; pg8::StaticOrder S; S.init(MTOK, DM, F.G, F.bid);
          EpiGateAttn E{F.out, PROJ + OFF_G + DM, NP, (bf16*)(F.ws + WS_MERGED)};
          pg8::gemm_phase<EpiGateAttn, pg8::StaticOrder, true, true>(F.lds + RING_OFF, g, S, E); }
    } SEAM(5);
    PH(6) { REP_BAR();
        pg8::Gemm g{(const bf16*)(F.ws + WS_MERGED), (const bf16*)(F.ws + WS_BT_O), MTOK, DM, DM}; pg8::StaticOrder S; S.init(MTOK, DM, F.G, F.bid);
        EpiStoreF32 E{F.out, DM};
        pg8::gemm_phase<EpiStoreF32, pg8::StaticOrder, true, true>(F.lds + RING_OFF, g, S, E);
    } SEAM(6);
    PH(7) { REP_BAR(); p7_rows(F); } SEAM(7);
    PH(8) { REP_BAR();
        pg8::Gemm g{H, (const bf16*)(F.ws + WS_BT_GU), MTOK, NGU, DM}; pg8::StaticOrder S; S.init(MTOK, NGU, F.G, F.bid);
        EpiSwiGLU E{(bf16*)(F.ws + WS_GU)};
        pg8::gemm_phase<EpiSwiGLU, pg8::StaticOrder, true, true>(F.lds + RING_OFF, g, S, E);
    } SEAM(8);
    PH(9) { REP_BAR();
        pg8::Gemm g{(const bf16*)(F.ws + WS_GU), (const bf16*)(F.ws + WS_BT_DN), MTOK, DM, DFF}; pg8::StaticOrder S; S.init(MTOK, DM, F.G, F.bid);
        EpiStoreF32 E{(float*)(F.ws + WS_F), DM};
        pg8::gemm_phase<EpiStoreF32, pg8::StaticOrder, true, true>(F.lds + RING_OFF, g, S, E);
    } SEAM(9);
    PH(10) { REP_BAR(); p10_rows(F); }
#undef IN
#undef SEAM
}

extern "C" void kernel_launch(void* const* d_in, const int* in_sizes, int n_in, void* d_out, int out_size, void* d_ws, size_t ws_size, hipStream_t stream) {
    static int grid = 0;
    if (grid == 0) {
        if (n_in != 19 || in_sizes[0] != MTOK * DM || out_size != MTOK * DM || ws_size < WS_END) { fprintf(stderr, "kernel_launch: unexpected shapes / workspace (n_in %d, in0 %d, out %d, ws %zu < %zu)\n", n_in, n_in > 0 ? in_sizes[0] : -1, out_size, ws_size, (size_t)WS_END); grid = -1; return; }
        int dev = 0, cus = 0, per_cu = 0;
        if (hipGetDevice(&dev) != hipSuccess || hipDeviceGetAttribute(&cus, hipDeviceAttributeMultiprocessorCount, dev) != hipSuccess) { grid = -1; return; }
        if (hipFuncSetAttribute((const void*)mk_fwd, hipFuncAttributeMaxDynamicSharedMemorySize, LDS_BYTES) != hipSuccess) { fprintf(stderr, "kernel_launch: hipFuncSetAttribute failed\n"); grid = -1; return; }
        if (hipOccupancyMaxActiveBlocksPerMultiprocessor(&per_cu, (const void*)mk_fwd, NWAVES * 64, LDS_BYTES) != hipSuccess || per_cu < 1) { fprintf(stderr, "kernel_launch: occupancy query says %d blocks per CU\n", per_cu); (void)hipGetLastError(); grid = -1; return; }
        grid = cus;
    }
    if (grid < 0) return;
    if (hipMemsetAsync((char*)d_ws + WS_CTL, 0, CTL_ZERO_BYTES, stream) != hipSuccess) return;
    Args a{};
    for (int i = 0; i < 19; ++i) a.in[i] = (const float*)d_in[i];
    a.out = (float*)d_out; a.ws = (unsigned char*)d_ws;
#if MK_N_LAUNCHES == 1
    a.ph_lo = 0; a.ph_hi = N_PHASES;
    hipLaunchKernelGGL(mk_fwd, dim3(grid), dim3(NWAVES * 64), LDS_BYTES, stream, a);
#else
    for (int p = 0; p < N_PHASES; ++p) { a.ph_lo = p; a.ph_hi = p + 1; hipLaunchKernelGGL(mk_fwd, dim3(grid), dim3(NWAVES * 64), LDS_BYTES, stream, a); }
#endif
}
```

```cpp
#include <hip/hip_runtime.h>
#include <cstdio>
#include <cstdint>
namespace pg8 {
#define PG8_LAS __attribute__((address_space(3)))
typedef unsigned short bf16_t;
typedef short bf16x8 __attribute__((ext_vector_type(8)));
typedef float f32x4 __attribute__((ext_vector_type(4)));
typedef unsigned u32x4 __attribute__((ext_vector_type(4)));
constexpr int BM = 256, BK = 64, HALF = 128, HTB = HALF * BK * 2  , STAGE_BYTES = 8 * HTB, NXCD = 8, WGM = 8;

__host__ __device__ __forceinline__ int lds_byte(int r, int c) { const int st = (r >> 4) * 2 + (c >> 5), rr = r & 15, cc = c & 31, ob = rr * 64 + cc * 2; return st * 1024 + (ob ^ (((ob >> 9) & 1) << 5)); }
__host__ __device__ __forceinline__ void stage_rc(int b, int& R, int& C) { const int st = b / 1024, sb = b % 1024, swz = sb ^ (((sb >> 9) & 1) << 5); R = (st >> 1) * 16 + swz / 64; C = (st & 1) * 32 + (swz % 64) / 2; }
__host__ __device__ __forceinline__ int perm32(int rho) { const int n = rho >> 4, i = rho & 15; return 8 * (i >> 2) + 4 * n + (i & 3); }

struct Unit { int pm, pn; };
struct Gemm { const bf16_t* A; const bf16_t* Bt; int M, N, K; };

struct StaticOrder {
    int nM, nN, nwg, G, c;
    __host__ __device__ void init(int M, int N, int G_, int c_) { nM = M / BM; nN = N / BM; nwg = nM * nN; G = G_; c = c_; }
    __host__ __device__ bool next(int i, Unit& u) const {
        const long L = (long)i * G + c; if (L >= nwg) return false;
        int wgid = (int)L; { const int q = nwg / NXCD, r = nwg % NXCD, xcd = wgid % NXCD, off = wgid / NXCD; wgid = (xcd < r ? xcd * (q + 1) : r * (q + 1) + (xcd - r) * q) + off; }
        const int nig = WGM * nN, gid = wgid / nig, fm = gid * WGM, gsz = (nM - fm) < WGM ? (nM - fm) : WGM;
        u.pm = fm + ((wgid % nig) % gsz); u.pn = (wgid % nig) / gsz; return true;
    }
    __device__ __forceinline__ void a_ready(const Unit&) const {}
    __device__ __forceinline__ void done(const Unit&) const {}
};

__device__ __forceinline__ unsigned cvt_pk_bf16(float lo, float hi) { unsigned r; asm volatile("v_cvt_pk_bf16_f32 %0, %1, %2" : "=v"(r) : "v"(lo), "v"(hi)); return r; }
typedef float f32x2 __attribute__((ext_vector_type(2)));
template <class Epi, class Sched, bool ALIGN_EPI = false, bool SP2 = false>
__device__ __forceinline__ void gemm_phase(PG8_LAS unsigned char* lds, const Gemm g, const Sched& S, const Epi& E) {
    const int tid = threadIdx.x, wid = __builtin_amdgcn_readfirstlane(tid >> 6), lane = tid & 63, wr = wid >> 2, wc = wid & 3, fr = lane & 15, fq = lane >> 4;
    const int K = g.K, nt = K / BK;
    unsigned voffA[2], voffB[2];
#pragma unroll
    for (int i = 0; i < 2; ++i) { int R, C; stage_rc(tid * 16 + i * 8192, R, C); const int Rb = Epi::PERM ? ((R & ~31) + perm32(R & 31)) : R;
        voffA[i] = (unsigned)(R * K + C) * 2u; voffB[i] = (unsigned)(Rb * K + C) * 2u; }
    const size_t kstep = (size_t)(BK * 2);
    const size_t hstep = (size_t)HALF * K * 2;
    const size_t tstep = 2 * hstep;
    const unsigned ldsw = (unsigned)wid * 1024u;
    const int aoff = lds_byte(wr * 64 + fr, fq * 8), boff = lds_byte(wc * 32 + fr, fq * 8);
#define PG8_SA(b, h) (((b) * 2 + (h)) * HTB)
#define PG8_SB(b, h) ((4 + (b) * 2 + (h)) * HTB)
#define PG8_STAGE(bufoff, gbase, voff) do { _Pragma("unroll") for (int _i = 0; _i < 2; ++_i) \
        __builtin_amdgcn_global_load_lds((const unsigned*)((const char*)(gbase) + (voff)[_i]), (PG8_LAS unsigned*)(lds + (bufoff) + ldsw + _i * 8192), 16, 0, 0); } while (0)
#define PG8_LDA(dst, b, h) do { _Pragma("unroll") for (int m = 0; m < 4; ++m) _Pragma("unroll") for (int k = 0; k < 2; ++k) dst[m][k] = *(const PG8_LAS bf16x8*)(lds + PG8_SA(b, h) + aoff + m * 2048 + k * 1024); } while (0)
#define PG8_LDB(dst, b, h) do { _Pragma("unroll") for (int n = 0; n < 2; ++n) _Pragma("unroll") for (int k = 0; k < 2; ++k) dst[n][k] = *(const PG8_LAS bf16x8*)(lds + PG8_SB(b, h) + boff + n * 2048 + k * 1024); } while (0)
#define PG8_MMA(ai, bj, At, Bt) do { __builtin_amdgcn_s_setprio(1); _Pragma("unroll") for (int m = 0; m < 4; ++m) _Pragma("unroll") for (int n = 0; n < 2; ++n) _Pragma("unroll") for (int k = 0; k < 2; ++k) \
        acc[ai][bj][m][n] = __builtin_amdgcn_mfma_f32_16x16x32_bf16(Bt[n][k], At[m][k], acc[ai][bj][m][n], 0, 0, 0); __builtin_amdgcn_s_setprio(0); } while (0)
#define PG8_WAIT_V(n) asm volatile("s_waitcnt vmcnt(" #n ")" ::: "memory")
#define PG8_WAIT_L(n) asm volatile("s_waitcnt lgkmcnt(" #n ")" ::: "memory")
#define PG8_BAR __builtin_amdgcn_s_barrier()
#define PG8_SCHED __builtin_amdgcn_sched_barrier(0)
    Unit cur, nxt; int ui = 0;
    if (!S.next(0, cur)) return;
    f32x4 acc[2][2][4][2];
#pragma unroll
    for (int a = 0; a < 2; ++a)
#pragma unroll
        for (int b = 0; b < 2; ++b)
#pragma unroll
            for (int m = 0; m < 4; ++m)
#pragma unroll
                for (int n = 0; n < 2; ++n) acc[a][b][m][n] = (f32x4){0.f, 0.f, 0.f, 0.f};
    bf16x8 At[4][2], B0[2][2], B1[2][2];
    const char* cA = (const char*)g.A + (size_t)cur.pm * tstep; const char* cB = (const char*)g.Bt + (size_t)cur.pn * tstep;
    S.a_ready(cur);
    if constexpr (SP2) {
        PG8_STAGE(PG8_SB(0, 0), cB, voffB); PG8_STAGE(PG8_SB(0, 1), cB + hstep, voffB); PG8_STAGE(PG8_SA(0, 0), cA, voffA); PG8_STAGE(PG8_SA(0, 1), cA + hstep, voffA);
        if (wr == 1) PG8_BAR;
        PG8_WAIT_V(2); PG8_BAR;
        PG8_STAGE(PG8_SB(1, 0), cB + kstep, voffB); PG8_STAGE(PG8_SA(1, 0), cA + kstep, voffA); PG8_STAGE(PG8_SB(1, 1), cB + hstep + kstep, voffB);
        PG8_WAIT_V(6); PG8_BAR;
    } else {
        PG8_STAGE(PG8_SB(0, 0), cB, voffB); PG8_STAGE(PG8_SA(0, 0), cA, voffA); PG8_STAGE(PG8_SB(0, 1), cB + hstep, voffB); PG8_STAGE(PG8_SA(0, 1), cA + hstep, voffA);
        if (wr == 1) PG8_BAR;
        PG8_WAIT_V(4); PG8_BAR;
        PG8_STAGE(PG8_SB(1, 0), cB + kstep, voffB); PG8_STAGE(PG8_SA(1, 0), cA + kstep, voffA); PG8_STAGE(PG8_SB(1, 1), cB + hstep + kstep, voffB);
        PG8_WAIT_V(6); PG8_BAR;
    }
    for (;;) {
        const bool has_next = S.next(ui + 1, nxt);
        const char* nA = has_next ? (const char*)g.A + (size_t)nxt.pm * tstep : cA; const char* nB = has_next ? (const char*)g.Bt + (size_t)nxt.pn * tstep : cB;
        for (int t = 0; t < nt; t += 2) {
            const bool last = (t == nt - 2);
            const char* a1 = cA + (size_t)(t + 1) * kstep;
            const char* a2 = last ? nA : cA + (size_t)(t + 2) * kstep; const char* b2 = last ? nB : cB + (size_t)(t + 2) * kstep;
            const char* a3 = a2 + kstep; const char* b3 = b2 + kstep;
            if (last && has_next) S.a_ready(nxt);
            if constexpr (SP2) {
            PG8_LDB(B0, 0, 0); PG8_LDB(B1, 0, 1); PG8_SCHED; PG8_LDA(At, 0, 0); PG8_STAGE(PG8_SA(1, 1), a1 + hstep, voffA);
            PG8_WAIT_V(8); PG8_WAIT_L(0); PG8_BAR; PG8_MMA(0, 0, At, B0); PG8_MMA(0, 1, At, B1); PG8_BAR; PG8_SCHED;
            PG8_LDA(At, 0, 1); PG8_STAGE(PG8_SB(0, 0), b2, voffB); PG8_STAGE(PG8_SB(0, 1), b2 + hstep, voffB); PG8_STAGE(PG8_SA(0, 0), a2, voffA);
            PG8_WAIT_V(8); PG8_WAIT_L(0); PG8_BAR; PG8_MMA(1, 0, At, B0); PG8_MMA(1, 1, At, B1); PG8_BAR; PG8_SCHED;
            PG8_LDB(B0, 1, 0); PG8_LDB(B1, 1, 1); PG8_SCHED; PG8_LDA(At, 1, 0); PG8_STAGE(PG8_SA(0, 1), a2 + hstep, voffA);
            PG8_WAIT_V(8); PG8_WAIT_L(0); PG8_BAR; PG8_MMA(0, 0, At, B0); PG8_MMA(0, 1, At, B1); PG8_BAR; PG8_SCHED;
            PG8_LDA(At, 1, 1); PG8_STAGE(PG8_SB(1, 0), b3, voffB); PG8_STAGE(PG8_SB(1, 1), b3 + hstep, voffB); PG8_STAGE(PG8_SA(1, 0), a3, voffA);
            PG8_WAIT_V(8); PG8_WAIT_L(0); PG8_BAR; PG8_MMA(1, 0, At, B0); PG8_MMA(1, 1, At, B1); PG8_BAR; PG8_SCHED;
            } else {
            PG8_LDB(B0, 0, 0); PG8_SCHED; PG8_LDA(At, 0, 0); PG8_STAGE(PG8_SA(1, 1), a1 + hstep, voffA);
            PG8_WAIT_L(8); PG8_BAR; PG8_WAIT_L(0); PG8_MMA(0, 0, At, B0); PG8_BAR; PG8_SCHED;
            PG8_LDB(B1, 0, 1); PG8_STAGE(PG8_SB(0, 0), b2, voffB);
            PG8_BAR; PG8_WAIT_L(0); PG8_MMA(0, 1, At, B1); PG8_BAR;
            PG8_LDA(At, 0, 1); PG8_STAGE(PG8_SA(0, 0), a2, voffA);
            PG8_BAR; PG8_WAIT_L(0); PG8_MMA(1, 0, At, B0); PG8_BAR; PG8_SCHED;
            PG8_STAGE(PG8_SB(0, 1), b2 + hstep, voffB);
            PG8_WAIT_V(6); PG8_BAR; PG8_MMA(1, 1, At, B1); PG8_BAR;
            PG8_LDB(B0, 1, 0); PG8_SCHED; PG8_LDA(At, 1, 0); PG8_STAGE(PG8_SA(0, 1), a2 + hstep, voffA);
            PG8_WAIT_L(8); PG8_BAR; PG8_WAIT_L(0); PG8_MMA(0, 0, At, B0); PG8_BAR; PG8_SCHED;
            PG8_LDB(B1, 1, 1); PG8_STAGE(PG8_SB(1, 0), b3, voffB);
            PG8_BAR; PG8_WAIT_L(0); PG8_MMA(0, 1, At, B1); PG8_BAR;
            PG8_LDA(At, 1, 1); PG8_STAGE(PG8_SA(1, 0), a3, voffA);
            PG8_BAR; PG8_WAIT_L(0); PG8_MMA(1, 0, At, B0); PG8_BAR; PG8_SCHED;
            PG8_STAGE(PG8_SB(1, 1), b3 + hstep, voffB);
            PG8_WAIT_V(6); PG8_BAR; PG8_MMA(1, 1, At, B1); PG8_BAR;
            }
        }
        if constexpr (ALIGN_EPI) { if (wr == 0) PG8_BAR; }
        if constexpr (!Epi::AFTER_DRAIN) { E(acc, cur, wr, wc, fr, fq); S.done(cur); }
        if (!has_next) break;
#pragma unroll
        for (int a = 0; a < 2; ++a)
#pragma unroll
            for (int b = 0; b < 2; ++b)
#pragma unroll
                for (int m = 0; m < 4; ++m)
#pragma unroll
                    for (int n = 0; n < 2; ++n) acc[a][b][m][n] = (f32x4){0.f, 0.f, 0.f, 0.f};
        cur = nxt; cA = nA; cB = nB; ++ui;
        if constexpr (ALIGN_EPI) { if (wr == 1) PG8_BAR; }
    }
    PG8_WAIT_V(0);
    if constexpr (!ALIGN_EPI) { if (wr == 0) PG8_BAR; }
    PG8_BAR;
    if constexpr (Epi::AFTER_DRAIN) { E.fused(acc, cur, wr, wc, fr, fq, lds, wid, lane); S.done(cur); }
#undef PG8_SA
#undef PG8_SB
#undef PG8_STAGE
#undef PG8_LDA
#undef PG8_LDB
#undef PG8_MMA
#undef PG8_WAIT_V
#undef PG8_WAIT_L
#undef PG8_BAR
#undef PG8_SCHED
}
}
#include <hip/hip_bf16.h>
#include <cmath>
namespace attn_body {
using bf16=__hip_bfloat16;
using bf16x8=__attribute__((ext_vector_type(8)))short;
using s16x4=__attribute__((ext_vector_type(4)))short;
using f32x16=__attribute__((ext_vector_type(16)))float;
using u32x4=__attribute__((ext_vector_type(4)))unsigned;
constexpr int BATCH=2,NHEAD=16,SEQ=4096,D=64,DM=10496,OPITCH=1024;
constexpr int NW=8,QBLK=32,QB=QBLK*NW,KVBLK=64,NQB=SEQ/QB;
constexpr int ATTN_PITCH=DM, ATTN_UNIT_ROWS=QB;
__device__ __forceinline__ int crow(int r,int hi){return (r&3)+8*(r>>2)+4*hi;}
#define SBAR() __builtin_amdgcn_sched_barrier(0)
__device__ __forceinline__ void cmask(f32x16&p0,f32x16&p1,int jb,int qrel,int hi){
  const float NEG=-INFINITY; int kb=64*jb+4*hi;
  #pragma unroll
  for(int r=0;r<16;++r){int kv=kb+(r&3)+8*(r>>2); if(kv>qrel)p0[r]=NEG; if(kv+32>qrel)p1[r]=NEG;}
}

constexpr int NSLOT=3, SLOTB=8192;
constexpr int LDS_K=0, LDS_V=NSLOT*SLOTB, LDS_WS=2*NSLOT*SLOTB, LDS_OST=LDS_WS+NW*64*4, LDS_MSK=LDS_OST+NW*4096, LDS_BYTES=LDS_MSK+NW*768;
constexpr float C2=0.125f*1.4426950408889634f;
__device__ __forceinline__ void glds16(const void*gsrc,unsigned lds_dst){unsigned keep;
  asm volatile("s_mov_b32 %0, m0\n\ts_mov_b32 m0, %2\n\ts_nop 0\n\tglobal_load_lds_dwordx4 %1, off\n\ts_mov_b32 m0, %0":"=&s"(keep):"v"(gsrc),"s"(lds_dst):"memory");}
__device__ __forceinline__ void glds4(const void*sbase,unsigned voff,unsigned lds_dst){unsigned keep;
  asm volatile("s_mov_b32 %0, m0\n\ts_mov_b32 m0, %3\n\ts_nop 4\n\tglobal_load_lds_dword %1, %2\n\ts_mov_b32 m0, %0":"=&s"(keep):"v"(voff),"s"(sbase),"s"(lds_dst):"memory");}
__device__ __forceinline__ float max3f(float a,float b,float c){float r;asm("v_max3_f32 %0, %1, %2, %3":"=v"(r):"v"(a),"v"(b),"v"(c));return r;}
__device__ __forceinline__ float max2f(float a,float b){float r;asm("v_max_f32_e32 %0, %1, %2":"=v"(r):"v"(a),"v"(b));return r;}
__device__ __forceinline__ float fadd_s(float a,float b){float r;asm("v_add_f32_e32 %0, %1, %2":"=v"(r):"v"(a),"v"(b));return r;}
__device__ __forceinline__ float fsub_s(float a,float b){float r;asm("v_sub_f32_e32 %0, %1, %2":"=v"(r):"v"(a),"v"(b));return r;}
typedef float f32x2_t __attribute__((ext_vector_type(2))); typedef __bf16 bf16x2_t __attribute__((ext_vector_type(2)));
__device__ __forceinline__ unsigned cvtpk_s(float lo,float hi){f32x2_t v={lo,hi};bf16x2_t b=__builtin_convertvector(v,bf16x2_t);return __builtin_bit_cast(unsigned,b);}
#define WAIT_BAR(N) asm volatile("s_waitcnt vmcnt(" #N ") lgkmcnt(0)\n\ts_barrier":::"memory")

__device__ __forceinline__ void qkt(f32x16&p0,f32x16&p1,const char*Kslot,const bf16x8*qr,const f32x16&negm,int r32,int hi){
  const char*kb=Kslot+hi*1024+r32*16;
  #pragma unroll
  for(int d0=0;d0<4;++d0){
    const bf16x8 b0=*reinterpret_cast<const bf16x8*>(kb+d0*2048);
    const bf16x8 b1=*reinterpret_cast<const bf16x8*>(kb+d0*2048+512);
    if(d0==0){p0=__builtin_amdgcn_mfma_f32_32x32x16_bf16(b0,qr[0],negm,0,0,0);p1=__builtin_amdgcn_mfma_f32_32x32x16_bf16(b1,qr[0],negm,0,0,0);}
    else{p0=__builtin_amdgcn_mfma_f32_32x32x16_bf16(b0,qr[d0],p0,0,0,0);p1=__builtin_amdgcn_mfma_f32_32x32x16_bf16(b1,qr[d0],p1,0,0,0);}}
}
typedef __attribute__((address_space(3))) const char* lds_cptr;
typedef short v4i16_t __attribute__((ext_vector_type(4)));
__device__ __forceinline__ void kload8(bf16x8*kf,lds_cptr kp){
  kf[0]=*(const __attribute__((address_space(3))) bf16x8*)(kp);      kf[1]=*(const __attribute__((address_space(3))) bf16x8*)(kp+512);
  kf[2]=*(const __attribute__((address_space(3))) bf16x8*)(kp+2048); kf[3]=*(const __attribute__((address_space(3))) bf16x8*)(kp+2560);
  kf[4]=*(const __attribute__((address_space(3))) bf16x8*)(kp+4096); kf[5]=*(const __attribute__((address_space(3))) bf16x8*)(kp+4608);
  kf[6]=*(const __attribute__((address_space(3))) bf16x8*)(kp+6144); kf[7]=*(const __attribute__((address_space(3))) bf16x8*)(kp+6656);
}
__device__ __forceinline__ void kload2(bf16x8*kf,lds_cptr kp,int j){ kf[2*j]=*(const __attribute__((address_space(3))) bf16x8*)(kp+j*2048); kf[2*j+1]=*(const __attribute__((address_space(3))) bf16x8*)(kp+j*2048+512); }
__device__ __forceinline__ s16x4 vtr(lds_cptr p){ return __builtin_bit_cast(s16x4,__builtin_amdgcn_ds_read_tr16_b64_v4i16((__attribute__((address_space(3))) v4i16_t*)p)); }
__device__ __forceinline__ float rowmax(const f32x16&p0,const f32x16&p1){
  float a=max3f(p0[0],p0[1],p1[0]),b=max3f(p0[2],p0[3],p1[1]);a=max3f(a,p1[2],p1[3]);
  #pragma unroll
  for(int r=4;r<16;r+=4){a=max3f(a,p0[r],p0[r+1]);b=max3f(b,p0[r+2],p0[r+3]);a=max3f(a,p1[r],p1[r+1]);b=max3f(b,p1[r+2],p1[r+3]);}
  const float m=max2f(a,b);
  auto rr=__builtin_amdgcn_permlane32_swap(__float_as_uint(m),__float_as_uint(m),false,false);
  return max2f(__uint_as_float(rr[0]),__uint_as_float(rr[1]));
}
__device__ __forceinline__ void pv(f32x16*o,int vb,bf16x8 pa0,bf16x8 pa1,bf16x8 pa2,bf16x8 pa3){
  #pragma unroll
  for(int d0=0;d0<2;++d0){s16x4 lo[4],hi[4];
    #pragma unroll
    for(int ks=0;ks<4;++ks){
      asm volatile("ds_read_b64_tr_b16 %0,%1 offset:%c2":"=&v"(lo[ks]):"v"(vb),"i"(d0*4096+ks*1024):"memory");
      asm volatile("ds_read_b64_tr_b16 %0,%1 offset:%c2":"=&v"(hi[ks]):"v"(vb),"i"(d0*4096+ks*1024+512):"memory");}
    asm volatile("s_waitcnt lgkmcnt(0)":::"memory");SBAR();
    #define PK(k) (bf16x8){lo[k][0],lo[k][1],lo[k][2],lo[k][3],hi[k][0],hi[k][1],hi[k][2],hi[k][3]}
    o[d0]=__builtin_amdgcn_mfma_f32_32x32x16_bf16(pa0,PK(0),o[d0],0,0,0);
    o[d0]=__builtin_amdgcn_mfma_f32_32x32x16_bf16(pa1,PK(1),o[d0],0,0,0);
    o[d0]=__builtin_amdgcn_mfma_f32_32x32x16_bf16(pa2,PK(2),o[d0],0,0,0);
    o[d0]=__builtin_amdgcn_mfma_f32_32x32x16_bf16(pa3,PK(3),o[d0],0,0,0);
    #undef PK
  }
}

#ifndef ATTN_STORE16
#define ATTN_STORE16(p,v) (*(u32x4*)(p)=(v))
#endif
template<int THRL> __device__ __forceinline__ void attn_unit(int b,int h,int qb,const bf16*Q,const bf16*K,const bf16*V,bf16*O,const unsigned*MASK32,char*shm){
  const int tid=threadIdx.x,lane=tid&63,r32=lane&31,hi=lane>>5; const int wid=__builtin_amdgcn_readfirstlane(tid>>6);
  const long rowbase=(long)b*SEQ; const int q0=qb*QB;
  const bf16*Qw=Q+(rowbase+q0+wid*QBLK)*DM+h*D;
  const bf16*Kh=K+rowbase*DM+h*D,*Vh=V+rowbase*DM+h*D;
  const unsigned lds0=(unsigned)(uintptr_t)shm;
  float*wsf=(float*)(shm+LDS_WS)+wid*64;
  const bf16*ksrc=Kh+(long)lane*DM+wid*8;
  const bf16*vsrc=Vh+(long)(16*(wid&3)+(lane>>2))*DM+(wid>>2)*32+(lane&3)*8;
  const unsigned kdst=lds0+LDS_K+wid*1024, vdst=lds0+LDS_V+wid*1024, mdst=lds0+LDS_MSK+wid*768;
  const unsigned*msrc=MASK32+(rowbase+q0+wid*QBLK)*128;
  #define DMA_M(t,slot) glds4(msrc+2*(t),(unsigned)((lane>>1)*512+(lane&1)*4),(unsigned)__builtin_amdgcn_readfirstlane(mdst+(slot)))
  #define MSK(v,w,bit) __uint_as_float(__float_as_uint(v)&(unsigned)__builtin_amdgcn_sbfe((int)(w),(bit),1))
  #define DMA_K(t,slot) glds16(ksrc+(long)(t)*KVBLK*DM,(unsigned)__builtin_amdgcn_readfirstlane(kdst+(slot)))
  #define DMA_V(t,slot) glds16(vsrc+(long)(t)*KVBLK*DM,(unsigned)__builtin_amdgcn_readfirstlane(vdst+(slot)))
  const int vb0=(int)(lds0+LDS_V)+((lane>>4)&1)*32+(lane&3)*8+(4*hi+((lane&15)>>2))*64;
  const char*Kbase=shm+LDS_K; bf16x8 kf[8];
  const lds_cptr shm3=(lds_cptr)shm; const lds_cptr kp0=shm3+LDS_K+hi*1024+r32*16; const lds_cptr vp0=shm3+LDS_V+((lane>>4)&1)*32+(lane&3)*8+(4*hi+((lane&15)>>2))*64;
  const lds_cptr mp0=shm3+LDS_MSK+wid*768+r32*8;
  const int NT=(q0+QB)/KVBLK;
  DMA_M(0,0);DMA_M(1,256);DMA_K(0,0);DMA_V(0,0);DMA_K(1,SLOTB);
  bf16x8 qr[4];
  #pragma unroll
  for(int d0=0;d0<4;++d0)qr[d0]=*reinterpret_cast<const bf16x8*>(&Qw[(long)r32*DM+d0*16+hi*8]);
  float mhat=0.f,l_reg=0.f;f32x16 o[2];o[0]=f32x16{};o[1]=f32x16{};f32x16 negm=f32x16{};asm volatile("":"+v"(negm));
  #define CMASK(P0,P1,t) do{}while(0)
  bool resc=false;
  #define START(P0,P1) do{ const float rm=rowmax(P0,P1); resc=false; \
    { const float dl=rm; mhat=fadd_s(mhat,dl); \
      _Pragma("unroll") for(int r=0;r<16;++r){P0[r]=fsub_s(P0[r],dl);P1[r]=fsub_s(P1[r],dl);} \
      _Pragma("unroll") for(int r=0;r<16;++r)negm[r]=-mhat; asm volatile("":"+v"(negm)); } \
    _Pragma("unroll") for(int r=0;r<16;++r)P0[r]=__builtin_amdgcn_exp2f(P0[r]); }while(0)
  #define RESC() do{ if(resc){ asm volatile("s_waitcnt lgkmcnt(0)":::"memory"); \
      _Pragma("unroll") for(int d_=0;d_<2;++d_) _Pragma("unroll") for(int r=0;r<16;++r)o[d_][r]*=wsf[crow(r,hi)]; } }while(0)
  f32x16 pA0,pA1,pB0,pB1;
  int sl_prev=0,sl_cur=0,sl_next=SLOTB;
  #define ROT() do{sl_prev=sl_cur;sl_cur=sl_next;sl_next=(sl_next==(NSLOT-1)*SLOTB)?0:sl_next+SLOTB;}while(0)
  DMA_K(2,2*SLOTB);
  WAIT_BAR(3);
  qkt(pA0,pA1,Kbase,qr,negm,r32,hi);asm volatile("s_nop 15\n\ts_nop 7":"+v"(pA0),"+v"(pA1));CMASK(pA0,pA1,0);
  START(pA0,pA1);
  _Pragma("unroll") for(int r=0;r<16;++r)pA1[r]=__builtin_amdgcn_exp2f(pA1[r]);
  { const unsigned long long mw_=*(const __attribute__((address_space(3))) unsigned long long*)(mp0); const unsigned mlo_=(unsigned)mw_>>(4*hi), mhi_=(unsigned)(mw_>>32)>>(4*hi);
    _Pragma("unroll") for(int r=0;r<16;++r){ pA0[r]=MSK(pA0[r],mlo_,(r&3)+8*(r>>2)); pA1[r]=MSK(pA1[r],mhi_,(r&3)+8*(r>>2)); } }
  WAIT_BAR(0);
  DMA_K(3,0);DMA_V(1,SLOTB);DMA_M(2,512);
  ROT();
  kload8(kf,kp0+sl_cur);
  WAIT_BAR(3);
  s16x4 vlo[8],vhi[8]; u32x4 pw0,pw1,pw2,pw3;
  #define PKW(P,B) cvtpk_s(P[B],P[B+1])
  #define PAF(k) __builtin_bit_cast(bf16x8,pw##k)
  #define VFR(i) (bf16x8){vlo[i][0],vlo[i][1],vlo[i][2],vlo[i][3],vhi[i][0],vhi[i][1],vhi[i][2],vhi[i][3]}
  #define PIN(x) asm volatile("":"+v"(x))
  #define MX3(a,b,c) __builtin_fmaxf(__builtin_fmaxf((a),(b)),(c))
  #define GAPA(MF,A0,A1,A2,A3,W0,W1,PW) do{ MF; sacc+=A0; sacc+=A1; sacc+=A2; sacc+=A3; PIN(sacc); W0; W1; PIN(PW); SBAR(); }while(0)
  #define EX(v) __builtin_amdgcn_exp2f(v)
  #define GAPB(MF,X,B,MW) do{ MF; X[B]=MSK(EX(X[B]),MW,2*(B)); X[B+1]=MSK(EX(X[B+1]),MW,2*(B)+1); X[B+2]=MSK(EX(X[B+2]),MW,2*(B)+2); X[B+3]=MSK(EX(X[B+3]),MW,2*(B)+3); PIN(X); SBAR(); }while(0)
  #define VRD(i) do{ vlo[i]=vtr(vp_+(((i)>>2)*4096+((i)&3)*1024)); vhi[i]=vtr(vp_+(((i)>>2)*4096+((i)&3)*1024+512)); }while(0)
  #define KRD(G,j) do{ if(G){ kload2(kf,kp0+sl_next,j); SBAR(); } }while(0)
  #define STEP(C0,C1,P0,P1,t,GK,GV,GL,GM) do{ SBAR(); \
    const lds_cptr vp_=vp0+sl_prev; \
    VRD(0); SBAR(); float sacc=(P0[0]+P0[1]); \
    GAPA(C0=__builtin_amdgcn_mfma_f32_32x32x16_bf16(kf[0],qr[0],negm,0,0,0), P0[2],P0[3],P0[4],P0[5],     pw0[0]=PKW(P0,0), pw0[1]=PKW(P0,2), pw0); \
    VRD(4); SBAR(); GAPA(C1=__builtin_amdgcn_mfma_f32_32x32x16_bf16(kf[1],qr[0],negm,0,0,0), P0[6],P0[7],P0[8],P0[9],     pw0[2]=PKW(P0,4), pw0[3]=PKW(P0,6), pw0); \
    VRD(1); SBAR(); GAPA(C0=__builtin_amdgcn_mfma_f32_32x32x16_bf16(kf[2],qr[1],C0,0,0,0),   P0[10],P0[11],P0[12],P0[13], pw1[0]=PKW(P0,8), pw1[1]=PKW(P0,10), pw1); \
    VRD(5); SBAR(); GAPA(C1=__builtin_amdgcn_mfma_f32_32x32x16_bf16(kf[3],qr[1],C1,0,0,0),   P0[14],P0[15],P1[0],P1[1],   pw1[2]=PKW(P0,12),pw1[3]=PKW(P0,14), pw1); \
    VRD(2); SBAR(); GAPA(C0=__builtin_amdgcn_mfma_f32_32x32x16_bf16(kf[4],qr[2],C0,0,0,0),   P1[2],P1[3],P1[4],P1[5],     pw2[0]=PKW(P1,0), pw2[1]=PKW(P1,2), pw2); \
    VRD(6); SBAR(); GAPA(C1=__builtin_amdgcn_mfma_f32_32x32x16_bf16(kf[5],qr[2],C1,0,0,0),   P1[6],P1[7],P1[8],P1[9],     pw2[2]=PKW(P1,4), pw2[3]=PKW(P1,6), pw2); \
    VRD(3); SBAR(); GAPA(C0=__builtin_amdgcn_mfma_f32_32x32x16_bf16(kf[6],qr[3],C0,0,0,0),   P1[10],P1[11],P1[12],P1[13], pw3[0]=PKW(P1,8), pw3[1]=PKW(P1,10), pw3); \
    VRD(7); SBAR(); GAPA(C1=__builtin_amdgcn_mfma_f32_32x32x16_bf16(kf[7],qr[3],C1,0,0,0),   P1[14],P1[15],0.f,0.f,       pw3[2]=PKW(P1,12),pw3[3]=PKW(P1,14), pw3); \
    l_reg+=sacc; \
    const unsigned long long mw_=*(const __attribute__((address_space(3))) unsigned long long*)(mp0+(sl_cur>>5)); \
    if(GK){DMA_K((t)+3,sl_cur);} if(GV){DMA_V((t)+1,sl_next);} if(GM){DMA_M((t)+2,sl_prev>>5);} \
    const unsigned mlo_=(unsigned)mw_>>(4*hi), mhi_=(unsigned)(mw_>>32)>>(4*hi); \
    { float a=MX3(C0[0],C0[1],C1[0]),b=MX3(C0[2],C0[3],C1[1]); a=MX3(a,C1[2],C1[3]); \
      _Pragma("unroll") for(int r=4;r<16;r+=4){a=MX3(a,C0[r],C0[r+1]);b=MX3(b,C0[r+2],C0[r+3]);a=MX3(a,C1[r],C1[r+1]);b=MX3(b,C1[r+2],C1[r+3]);} \
      float rm=__builtin_fmaxf(a,b); { auto rr=__builtin_amdgcn_permlane32_swap(__float_as_uint(rm),__float_as_uint(rm),false,false); rm=__builtin_fmaxf(__uint_as_float(rr[0]),__uint_as_float(rr[1])); } \
      resc=false; \
      if(__builtin_expect(__any(rm>(float)THRL),0)){ const float dl=__builtin_fmaxf(rm,0.f); mhat+=dl; \
        _Pragma("unroll") for(int r=0;r<16;++r){C0[r]-=dl;C1[r]-=dl;} \
        _Pragma("unroll") for(int r=0;r<16;++r)negm[r]=-mhat; asm volatile("":"+v"(negm)); \
        const float f=__builtin_amdgcn_exp2f(-dl); l_reg*=f; if(hi==0)wsf[r32]=f; resc=true; } } \
    SBAR(); \
    GAPB(o[0]=__builtin_amdgcn_mfma_f32_32x32x16_bf16(PAF(0),VFR(0),o[0],0,0,0), C0,0,mlo_); \
    GAPB(o[1]=__builtin_amdgcn_mfma_f32_32x32x16_bf16(PAF(0),VFR(4),o[1],0,0,0), C0,4,mlo_); \
    KRD(GL,0); GAPB(o[0]=__builtin_amdgcn_mfma_f32_32x32x16_bf16(PAF(1),VFR(1),o[0],0,0,0), C0,8,mlo_); \
    KRD(GL,1); GAPB(o[1]=__builtin_amdgcn_mfma_f32_32x32x16_bf16(PAF(1),VFR(5),o[1],0,0,0), C0,12,mlo_); \
    KRD(GL,2); GAPB(o[0]=__builtin_amdgcn_mfma_f32_32x32x16_bf16(PAF(2),VFR(2),o[0],0,0,0), C1,0,mhi_); \
    KRD(GL,3); GAPB(o[1]=__builtin_amdgcn_mfma_f32_32x32x16_bf16(PAF(2),VFR(6),o[1],0,0,0), C1,4,mhi_); \
    GAPB(o[0]=__builtin_amdgcn_mfma_f32_32x32x16_bf16(PAF(3),VFR(3),o[0],0,0,0), C1,8,mhi_); \
    GAPB(o[1]=__builtin_amdgcn_mfma_f32_32x32x16_bf16(PAF(3),VFR(7),o[1],0,0,0), C1,12,mhi_); \
    }while(0)
  int t=1;
  for(;t+5<NT;t+=2){
    STEP(pB0,pB1,pA0,pA1,t,true,true,true,true);     WAIT_BAR(3); RESC(); ROT();
    STEP(pA0,pA1,pB0,pB1,t+1,true,true,true,true);   WAIT_BAR(3); RESC(); ROT();
  }
  #define ENDW(tt) do{ if((tt)+3<NT){WAIT_BAR(3);} else if((tt)+2<NT){WAIT_BAR(2);} else {WAIT_BAR(0);} }while(0)
  for(;t+1<NT;t+=2){
    STEP(pB0,pB1,pA0,pA1,t,(t+3<NT),(t+1<NT),(t+1<NT),(t+2<NT));       ENDW(t);   RESC(); ROT();
    STEP(pA0,pA1,pB0,pB1,t+1,(t+4<NT),(t+2<NT),(t+2<NT),(t+3<NT));     ENDW(t+1); RESC(); ROT();
  }
  STEP(pB0,pB1,pA0,pA1,NT-1,false,false,false,false); RESC();
  { float sacc=pB0[0]+pB0[1]; _Pragma("unroll") for(int r=2;r<16;++r)sacc+=pB0[r]; _Pragma("unroll") for(int r=0;r<16;++r)sacc+=pB1[r]; l_reg+=sacc;
    pw0=(u32x4){PKW(pB0,0),PKW(pB0,2),PKW(pB0,4),PKW(pB0,6)};pw1=(u32x4){PKW(pB0,8),PKW(pB0,10),PKW(pB0,12),PKW(pB0,14)};pw2=(u32x4){PKW(pB1,0),PKW(pB1,2),PKW(pB1,4),PKW(pB1,6)};pw3=(u32x4){PKW(pB1,8),PKW(pB1,10),PKW(pB1,12),PKW(pB1,14)};
    SBAR(); pv(o,vb0+sl_cur,PAF(0),PAF(1),PAF(2),PAF(3)); }
  #undef PKW
  #undef PAF
  #undef VFR
  #undef PIN
  #undef MX3
  #undef GAPA
  #undef GAPB
  #undef EX
  #undef VRD
  #undef KRD
  #undef STEP
  #undef ENDW
  {auto rr=__builtin_amdgcn_permlane32_swap(__float_as_uint(l_reg),__float_as_uint(l_reg),false,false);l_reg=__uint_as_float(rr[0])+__uint_as_float(rr[1]);}
  if(hi==0)wsf[32+r32]=l_reg;asm volatile("s_waitcnt lgkmcnt(0)":::"memory");
  float rli[16];
  #pragma unroll
  for(int r=0;r<16;++r)rli[r]=__builtin_amdgcn_rcpf(wsf[32+crow(r,hi)]);
  bf16*Ow=O+(rowbase+q0+wid*QBLK)*OPITCH+h*D;
  { bf16*stg=(bf16*)(shm+LDS_OST)+wid*2048;
    #pragma unroll
    for(int r=0;r<16;++r){const int orow=crow(r,hi);
      #pragma unroll
      for(int d0=0;d0<2;++d0)stg[orow*64+d0*32+r32]=__float2bfloat16(o[d0][r]*rli[r]);}
    asm volatile("s_waitcnt lgkmcnt(0)":::"memory");
    #pragma unroll
    for(int i=0;i<4;++i){const int row=i*8+(lane>>3),ch=lane&7; const u32x4 v=*(const u32x4*)(stg+row*64+ch*8); ATTN_STORE16(Ow+(long)row*OPITCH+ch*8,v);} }
  asm volatile("s_waitcnt lgkmcnt(0)\n\ts_barrier":::"memory");
  #undef DMA_K
  #undef DMA_V
  #undef DMA_M
  #undef MSK
  #undef CMASK
  #undef START
  #undef RESC
  #undef ROT
}
constexpr int ATTN_LDS_BYTES=LDS_BYTES;
struct AttnTensors { const bf16* Q; const bf16* K; const bf16* V; bf16* O; const unsigned* MASK32; };
struct AttnUnit { int bh; int qb; };
struct StaticOrder {
  int vcu, G;
  __device__ __forceinline__ explicit StaticOrder(int grid,int block):vcu((grid%8==0)?(block%8)*(grid/8)+block/8:block),G(grid){}
  __device__ __forceinline__ bool next(int i,AttnUnit&u)const{ const int p=vcu+(i>>1)*G; if(p>=256)return false; const int s=p&7; u.bh=p>>3; u.qb=(i&1)?15-s:s; return true; }
  __device__ __forceinline__ void a_ready(const AttnUnit&)const{}
  __device__ __forceinline__ void done(const AttnUnit&)const{}
};
template<class Sched,int THRL=8> __device__ __forceinline__ void attn_phase(char*lds,const AttnTensors&T,const Sched&S){
  AttnUnit u;
  for(int i=0;S.next(i,u);++i){ S.a_ready(u); attn_unit<THRL>(u.bh/NHEAD,u.bh%NHEAD,u.qb,T.Q,T.K,T.V,T.O,T.MASK32,lds); S.done(u); }
}
#undef SBAR
#undef WAIT_BAR
}
#define GAS __attribute__((address_space(1)))
#define LAS __attribute__((address_space(3)))
typedef unsigned short bf16;
typedef unsigned v4u __attribute__((ext_vector_type(4)));
typedef float f32x4 __attribute__((ext_vector_type(4)));
typedef short bf16x8 __attribute__((ext_vector_type(8)));
typedef GAS unsigned gu32;
typedef GAS unsigned long long gu64;
#define RLX_AGENT __ATOMIC_RELAXED, __HIP_MEMORY_SCOPE_AGENT
#define LDS_WAIT() asm volatile("s_waitcnt lgkmcnt(0)" ::: "memory")
#define VM_WAIT() asm volatile("s_waitcnt vmcnt(0)" ::: "memory")
__device__ __forceinline__ unsigned long long rt() { return __builtin_amdgcn_s_memrealtime(); }
__device__ __forceinline__ unsigned f2bf(float f) { unsigned u = __builtin_bit_cast(unsigned, f); return (u + 0x7fffu + ((u >> 16) & 1u)) >> 16; }
__device__ __forceinline__ unsigned pk2(float lo, float hi) { return f2bf(lo) | (f2bf(hi) << 16); }
#define XB_TMO      128
#define XB_XCNT(j)  (256  + 64 * (j))
#define XB_XSUB(j)  (1280 + 64 * (j))
#define XB_XGEN(j)  (2304 + 64 * (j))
#define XB_TOP      3328
#define XB_TOPGEN   3392
#define XCD_BAR_WORDS 3456
#define XB_SPIN_CAP (1u << 18)

__device__ __forceinline__ unsigned xb_ld(unsigned* p)              { return __hip_atomic_load(p, __ATOMIC_RELAXED, __HIP_MEMORY_SCOPE_AGENT); }
__device__ __forceinline__ unsigned xb_add(unsigned* p, unsigned v) { return __hip_atomic_fetch_add(p, v, __ATOMIC_RELAXED, __HIP_MEMORY_SCOPE_AGENT); }
__device__ __forceinline__ unsigned xb_xcc_id() { return (unsigned)__builtin_amdgcn_s_getreg((3 << 11) | 20) & 0xFu; }
#define XB_SPIN(cond, bar) do { unsigned _sp = 0; while (cond) { __builtin_amdgcn_s_sleep(1); \
    if ((++_sp & 255u) == 0u) { if (xb_ld(&(bar)[XB_TMO])) break; if (_sp > XB_SPIN_CAP) { atomicAdd(&(bar)[XB_TMO], 1u); break; } } } } while (0)

struct XcdBarrier {
    unsigned* bar; unsigned x;
    volatile LAS unsigned* st;
};

__device__ __forceinline__ XcdBarrier xcd_barrier_post(unsigned* bar, volatile LAS unsigned* st) {
    XcdBarrier b; b.bar = bar; b.x = xb_xcc_id(); b.st = st;
    if (threadIdx.x == 0) (void)xb_add(&bar[XB_XCNT(b.x)], 1u);
    return b;
}
__device__ __forceinline__ void xcd_barrier_complete(unsigned* bar, unsigned x, unsigned& nloc, unsigned& nx) {
    const unsigned G = gridDim.x * gridDim.y * gridDim.z;
    unsigned sum, cnt, mine, sp = 0u;
    for (;;) {
        sum = 0u; cnt = 0u; mine = 0u;
#pragma unroll
        for (unsigned j = 0; j < 16; ++j) { const unsigned c = xb_ld(&bar[XB_XCNT(j)]); sum += c; cnt += (c > 0u) ? 1u : 0u; mine = (j == x) ? c : mine; }
        if (sum == G) break;
        __builtin_amdgcn_s_sleep(1);
        if ((++sp & 255u) == 0u) { if (xb_ld(&bar[XB_TMO])) break; if (sp > XB_SPIN_CAP) { atomicAdd(&bar[XB_TMO], 1u); break; } }
    }
    nloc = mine > 0u ? mine : 1u; nx = cnt > 0u ? cnt : 1u;
}

__device__ __forceinline__ void xcd_barrier(const XcdBarrier& b) {
    asm volatile("s_waitcnt vmcnt(0)" ::: "memory");
    __syncthreads();
    if (threadIdx.x == 0) {
        unsigned* bar = b.bar;
        __builtin_amdgcn_s_waitcnt(0);
        unsigned nloc = b.st[0], nx = b.st[1];
        if (nloc == 0u) { xcd_barrier_complete(bar, b.x, nloc, nx); b.st[0] = nloc; b.st[1] = nx; }
        const unsigned old = xb_add(&bar[XB_XSUB(b.x)], 1u);
        const unsigned gen = old / nloc;
        if (old + 1u == (gen + 1u) * nloc) {
            __builtin_amdgcn_fence(__ATOMIC_RELEASE, "agent");
            asm volatile("s_waitcnt vmcnt(0)" ::: "memory");
            const unsigned og = xb_add(&bar[XB_TOP], 1u);
            const unsigned tg = og / nx;
            if (og + 1u == (tg + 1u) * nx) xb_add(&bar[XB_TOPGEN], 1u);
            else XB_SPIN(xb_ld(&bar[XB_TOPGEN]) == tg, bar);
            __builtin_amdgcn_fence(__ATOMIC_ACQUIRE, "agent");
            xb_add(&bar[XB_XGEN(b.x)], 1u);
            asm volatile("s_waitcnt vmcnt(0)" ::: "memory");
        } else {
            XB_SPIN(xb_ld(&bar[XB_XGEN(b.x)]) == gen, bar);
            __builtin_amdgcn_fence(__ATOMIC_ACQUIRE, "agent");
            asm volatile("s_waitcnt vmcnt(0)" ::: "memory");
        }
    }
    __syncthreads();
}
constexpr int NWAVES = 8;
constexpr int DM = 2048, NBATCH = 2, SEQ = 4096, MTOK = NBATCH * SEQ;
constexpr int DCONV = 1024, CONVW = 31, NHEAD = 16, HDIM = 64, TOPK = 256, DFF = 5632;
constexpr int OFF_GLU = 0, OFF_Q = 2048, OFF_K = 3072, OFF_V = 4096, OFF_QI = 5120, OFF_KI = 6144, OFF_WI = 6208, OFF_G = 6224, D_IN = 10320;
constexpr int NP = 10496;
constexpr int NGU = 2 * DFF;
constexpr int KSPLIT = 32, NMOD = 6 * DM;
constexpr float EPS = 1e-6f;
constexpr float LOG2E = 1.4426950408889634f;

constexpr size_t MiB = 1u << 20;
constexpr size_t WS_CTL = 0, CTL_ZERO_BYTES = 1 * MiB;
constexpr size_t WS_MODP = 1 * MiB;
constexpr size_t WS_MODF = 4 * MiB;
constexpr size_t WS_BT_GU = 5 * MiB;
constexpr size_t WS_BT_DN = 49 * MiB;
constexpr size_t WS_BT_O = 71 * MiB;
constexpr size_t WS_BT_CO = 79 * MiB;
constexpr size_t WS_BT_AO = 83 * MiB;
constexpr size_t WS_BT_IN = 87 * MiB;
constexpr size_t WS_H = 128 * MiB;
constexpr size_t WS_PROJ = 160 * MiB;
constexpr size_t WS_CACT = 324 * MiB;
constexpr size_t WS_AOUT = 340 * MiB;
constexpr size_t WS_VT = 356 * MiB;
constexpr size_t WS_MASK = 372 * MiB;
constexpr size_t WS_END = 376 * MiB;
constexpr size_t WS_SCORES = 87 * MiB;
constexpr size_t WS_MERGED = 96 * MiB;
constexpr size_t WS_GU = 160 * MiB;
constexpr size_t WS_F = 248 * MiB;
constexpr int CW_BAR = 4096;

constexpr int RING_OFF = 0, RING_BYTES = 131072;
constexpr int LDSCTL_OFF = RING_BYTES, MISC_OFF = LDSCTL_OFF + 320;
constexpr int LDS_BYTES = 147456;

typedef float f32x16 __attribute__((ext_vector_type(16)));
typedef float f32x2v __attribute__((ext_vector_type(2)));
typedef unsigned u32x2v __attribute__((ext_vector_type(2)));

__device__ __forceinline__ float bf_lo(unsigned u) { return __builtin_bit_cast(float, u << 16); }
__device__ __forceinline__ float bf_hi(unsigned u) { return __builtin_bit_cast(float, u & 0xffff0000u); }
__device__ __forceinline__ float sigmoidf_fast(float v) { return __builtin_amdgcn_rcpf(1.0f + __builtin_amdgcn_exp2f(-v * LOG2E)); }
__device__ __forceinline__ float wave_sum(float v) {
#pragma unroll
    for (int o = 1; o < 64; o <<= 1) v += __shfl_xor(v, o);
    return v;
}

struct EpiStoreBf16 {
    static constexpr bool PERM = true, AFTER_DRAIN = false;
    bf16* O; int ldc; int q_lo, q_hi; float qscale;
    __device__ __forceinline__ void operator()(const f32x4 (&acc)[2][2][4][2], const pg8::Unit& u, int wr, int wc, int fr, int fq) const {
        const int row0 = u.pm * pg8::BM + wr * 64 + fr, colt = u.pn * pg8::BM, col0 = colt + wc * 32 + 8 * fq;
        const float sc = (colt >= q_lo && colt < q_hi) ? qscale : 1.0f;
#pragma unroll
        for (int ai = 0; ai < 2; ++ai)
#pragma unroll
            for (int m = 0; m < 4; ++m) { bf16* rowp = O + (size_t)(row0 + ai * pg8::HALF + m * 16) * ldc + col0;
#pragma unroll
                for (int bj = 0; bj < 2; ++bj) { const f32x4 v0 = acc[ai][bj][m][0] * sc, v1 = acc[ai][bj][m][1] * sc;
                    v4u w; w.x = pg8::cvt_pk_bf16(v0[0], v0[1]); w.y = pg8::cvt_pk_bf16(v0[2], v0[3]); w.z = pg8::cvt_pk_bf16(v1[0], v1[1]); w.w = pg8::cvt_pk_bf16(v1[2], v1[3]);
                    *(v4u*)(rowp + bj * pg8::HALF) = w; } }
    }
};
struct EpiStoreF32 {
    static constexpr bool PERM = false, AFTER_DRAIN = false;
    float* C; int ldc;
    __device__ __forceinline__ void operator()(const f32x4 (&acc)[2][2][4][2], const pg8::Unit& u, int wr, int wc, int fr, int fq) const {
        const int row0 = u.pm * pg8::BM + wr * 64 + fr, col0 = u.pn * pg8::BM + wc * 32 + 4 * fq;
#pragma unroll
        for (int ai = 0; ai < 2; ++ai)
#pragma unroll
            for (int m = 0; m < 4; ++m) { float* rowp = C + (size_t)(row0 + ai * pg8::HALF + m * 16) * ldc + col0;
#pragma unroll
                for (int bj = 0; bj < 2; ++bj)
#pragma unroll
                    for (int n = 0; n < 2; ++n) *(f32x4*)(rowp + bj * pg8::HALF + n * 16) = acc[ai][bj][m][n]; }
    }
};
struct EpiGateConv {
    static constexpr bool PERM = true, AFTER_DRAIN = false;
    float* C; const bf16* G; int ldg;
    __device__ __forceinline__ void operator()(const f32x4 (&acc)[2][2][4][2], const pg8::Unit& u, int wr, int wc, int fr, int fq) const {
        const int row0 = u.pm * pg8::BM + wr * 64 + fr, col0 = u.pn * pg8::BM + wc * 32 + 8 * fq;
#pragma unroll
        for (int ai = 0; ai < 2; ++ai)
#pragma unroll
            for (int m = 0; m < 4; ++m) { const int row = row0 + ai * pg8::HALF + m * 16; float* rowp = C + (size_t)row * DM + col0; const bf16* gp = G + (size_t)row * ldg + col0;
#pragma unroll
                for (int bj = 0; bj < 2; ++bj) { const v4u g = *(const v4u*)(gp + bj * pg8::HALF); const f32x4 a0 = acc[ai][bj][m][0], a1 = acc[ai][bj][m][1];
                    f32x4 o0, o1;
                    o0[0] = a0[0] * sigmoidf_fast(bf_lo(g.x)); o0[1] = a0[1] * sigmoidf_fast(bf_hi(g.x)); o0[2] = a0[2] * sigmoidf_fast(bf_lo(g.y)); o0[3] = a0[3] * sigmoidf_fast(bf_hi(g.y));
                    o1[0] = a1[0] * sigmoidf_fast(bf_lo(g.z)); o1[1] = a1[1] * sigmoidf_fast(bf_hi(g.z)); o1[2] = a1[2] * sigmoidf_fast(bf_lo(g.w)); o1[3] = a1[3] * sigmoidf_fast(bf_hi(g.w));
                    *(f32x4*)(rowp + bj * pg8::HALF) = o0; *(f32x4*)(rowp + bj * pg8::HALF + 4) = o1; } }
    }
};
struct EpiGateAttn {
    static constexpr bool PERM = true, AFTER_DRAIN = false;
    const float* T; const bf16* G; int ldg; bf16* O;
    __device__ __forceinline__ void operator()(const f32x4 (&acc)[2][2][4][2], const pg8::Unit& u, int wr, int wc, int fr, int fq) const {
        const int row0 = u.pm * pg8::BM + wr * 64 + fr, col0 = u.pn * pg8::BM + wc * 32 + 8 * fq;
#pragma unroll
        for (int ai = 0; ai < 2; ++ai)
#pragma unroll
            for (int m = 0; m < 4; ++m) { const int row = row0 + ai * pg8::HALF + m * 16; const float* tp = T + (size_t)row * DM + col0; const bf16* gp = G + (size_t)row * ldg + col0; bf16* op = O + (size_t)row * DM + col0;
#pragma unroll
                for (int bj = 0; bj < 2; ++bj) { const v4u g = *(const v4u*)(gp + bj * pg8::HALF); const f32x4 t0 = *(const f32x4*)(tp + bj * pg8::HALF), t1 = *(const f32x4*)(tp + bj * pg8::HALF + 4);
                    const f32x4 a0 = acc[ai][bj][m][0], a1 = acc[ai][bj][m][1];
                    const float o0 = t0[0] + a0[0] * sigmoidf_fast(bf_lo(g.x)), o1 = t0[1] + a0[1] * sigmoidf_fast(bf_hi(g.x)), o2 = t0[2] + a0[2] * sigmoidf_fast(bf_lo(g.y)), o3 = t0[3] + a0[3] * sigmoidf_fast(bf_hi(g.y));
                    const float o4 = t1[0] + a1[0] * sigmoidf_fast(bf_lo(g.z)), o5 = t1[1] + a1[1] * sigmoidf_fast(bf_hi(g.z)), o6 = t1[2] + a1[2] * sigmoidf_fast(bf_lo(g.w)), o7 = t1[3] + a1[3] * sigmoidf_fast(bf_hi(g.w));
                    v4u w; w.x = pg8::cvt_pk_bf16(o0, o1); w.y = pg8::cvt_pk_bf16(o2, o3); w.z = pg8::cvt_pk_bf16(o4, o5); w.w = pg8::cvt_pk_bf16(o6, o7);
                    *(v4u*)(op + bj * pg8::HALF) = w; } }
    }
};
struct EpiSwiGLU {
    static constexpr bool PERM = true, AFTER_DRAIN = false;
    bf16* O;
    __device__ __forceinline__ void operator()(const f32x4 (&acc)[2][2][4][2], const pg8::Unit& u, int wr, int wc, int fr, int fq) const {
        const int row0 = u.pm * pg8::BM + wr * 64 + fr, col0 = (u.pn * pg8::BM + wc * 32 + 8 * fq) >> 1;
#pragma unroll
        for (int ai = 0; ai < 2; ++ai)
#pragma unroll
            for (int m = 0; m < 4; ++m) { bf16* rowp = O + (size_t)(row0 + ai * pg8::HALF + m * 16) * DFF + col0;
#pragma unroll
                for (int bj = 0; bj < 2; ++bj) { const f32x4 g = acc[ai][bj][m][0], up = acc[ai][bj][m][1];
                    const float h0 = g[0] * sigmoidf_fast(g[0]) * up[0], h1 = g[1] * sigmoidf_fast(g[1]) * up[1], h2 = g[2] * sigmoidf_fast(g[2]) * up[2], h3 = g[3] * sigmoidf_fast(g[3]) * up[3];
                    u32x2v w; w.x = pg8::cvt_pk_bf16(h0, h1); w.y = pg8::cvt_pk_bf16(h2, h3);
                    *(u32x2v*)(rowp + bj * (pg8::HALF / 2)) = w; } }
    }
};

struct Frame {
    LAS unsigned char* lds;
    volatile LAS unsigned* MISC;
    gu32* ctl;
    int tid, lane, wave, G, bid;
    float* out; unsigned char* ws;
};
template <int K> __device__ __forceinline__ const float* kin() {
    unsigned long long v;
    asm volatile("s_load_dwordx2 %0, %1, %2\n\ts_waitcnt lgkmcnt(0)" : "=s"(v) : "s"(__builtin_amdgcn_kernarg_segment_ptr()), "i"(8 * K));
    return (const float*)(const GAS float*)v;
}
enum { I_X = 0, I_C, I_WADA, I_BADA, I_GPREMIX, I_WIN, I_WDW, I_BDW, I_GLN, I_BLN, I_WCO, I_WAO, I_WO, I_GPOSTMIX, I_GPREFFN, I_WGATE, I_WUP, I_WDOWN, I_GPOSTFFN };

template <int MODE>
__device__ __forceinline__ void p0_transpose_item(const float* W, int K, int N, bf16* WT, int row_off, LAS float* scr, int item, int lane) {
    const int nblk = (N + 31) / 32, kb = item / nblk, nb = item % nblk, k0 = 64 * kb, n0 = 32 * nb;
    const int nn = n0 + (lane & 31); const bool nok = nn < N;
#pragma unroll 8
    for (int i = 0; i < 32; ++i) { const int kk = 2 * i + (lane >> 5); scr[kk * 33 + (lane & 31)] = nok ? W[(size_t)(k0 + kk) * N + nn] : 0.f; }
    LDS_WAIT(); asm volatile("" ::: "memory");
    const int c = lane & 7;
#pragma unroll
    for (int j = 0; j < 4; ++j) { const int n = (lane >> 3) + 8 * j; const LAS float* s = scr + (8 * c) * 33 + n;
        v4u o; o.x = pk2(s[0 * 33], s[1 * 33]); o.y = pk2(s[2 * 33], s[3 * 33]); o.z = pk2(s[4 * 33], s[5 * 33]); o.w = pk2(s[6 * 33], s[7 * 33]);
        const int gn = n0 + n;
        if (gn < N) { const int dr = (MODE == 0) ? (row_off + gn) : (8 * (gn >> 2) + (gn & 3) + row_off);
            *(GAS v4u*)(WT + (size_t)dr * K + k0 + 8 * c) = o; } }
    LDS_WAIT(); asm volatile("" ::: "memory");
}

__device__ __forceinline__ void p0_prologue(Frame& F) {
    const int gw = F.bid * NWAVES + F.wave, NGW = F.G * NWAVES;
    {
        const float* c = kin<I_C>(); const float* wada = kin<I_WADA>(); float* modp = (float*)(F.ws + WS_MODP);
        for (int unit = gw; unit < KSPLIT * (NMOD / 256); unit += NGW) {
            const int ks = unit / (NMOD / 256), nt = unit % (NMOD / 256), k0 = 64 * ks, col0 = 256 * nt + 4 * F.lane;
            const float c0 = c[k0 + F.lane], c1 = c[DM + k0 + F.lane];
            const float s0 = c0 / (1.0f + __expf(-c0)), s1 = c1 / (1.0f + __expf(-c1));
            f32x4 a0 = {0.f, 0.f, 0.f, 0.f}, a1 = {0.f, 0.f, 0.f, 0.f};
            const float* wp = wada + (size_t)k0 * NMOD + col0;
            for (int kk0 = 0; kk0 < 64; kk0 += 16) {
                f32x4 w[16];
#pragma unroll
                for (int q = 0; q < 16; ++q) w[q] = __builtin_nontemporal_load((const f32x4*)(wp + (size_t)(kk0 + q) * NMOD));
#pragma unroll
                for (int q = 0; q < 16; ++q) { const float t0 = __builtin_bit_cast(float, __builtin_amdgcn_readlane(__builtin_bit_cast(int, s0), kk0 + q)), t1 = __builtin_bit_cast(float, __builtin_amdgcn_readlane(__builtin_bit_cast(int, s1), kk0 + q)); a0 += t0 * w[q]; a1 += t1 * w[q]; }
            }
            *(f32x4*)(modp + (size_t)(ks * 2 + 0) * NMOD + col0) = a0;
            *(f32x4*)(modp + (size_t)(ks * 2 + 1) * NMOD + col0) = a1;
        }
    }
    LAS float* scr = (LAS float*)(F.lds + RING_OFF + F.wave * 16384);
    bf16* bt_in = (bf16*)(F.ws + WS_BT_IN); bf16* bt_gu = (bf16*)(F.ws + WS_BT_GU); bf16* bt_dn = (bf16*)(F.ws + WS_BT_DN);
    bf16* bt_o = (bf16*)(F.ws + WS_BT_O); bf16* bt_co = (bf16*)(F.ws + WS_BT_CO); bf16* bt_ao = (bf16*)(F.ws + WS_BT_AO);
    constexpr int I_IN = (DM / 64) * ((D_IN + 31) / 32), I_GT = (DM / 64) * (DFF / 32), I_DN = (DFF / 64) * (DM / 32), I_O = (DM / 64) * (DM / 32), I_CO = (DCONV / 64) * (DM / 32);
    constexpr int NITEMS = I_IN + 2 * I_GT + I_DN + I_O + 2 * I_CO;
    for (int it = gw; it < NITEMS; it += NGW) {
        int r = it;
        if (r < I_IN) { p0_transpose_item<0>(kin<I_WIN>(), DM, D_IN, bt_in, 0, scr, r, F.lane); continue; } r -= I_IN;
        if (r < I_GT) { p0_transpose_item<1>(kin<I_WGATE>(), DM, DFF, bt_gu, 0, scr, r, F.lane); continue; } r -= I_GT;
        if (r < I_GT) { p0_transpose_item<1>(kin<I_WUP>(), DM, DFF, bt_gu, 4, scr, r, F.lane); continue; } r -= I_GT;
        if (r < I_DN) { p0_transpose_item<0>(kin<I_WDOWN>(), DFF, DM, bt_dn, 0, scr, r, F.lane); continue; } r -= I_DN;
        if (r < I_O) { p0_transpose_item<0>(kin<I_WO>(), DM, DM, bt_o, 0, scr, r, F.lane); continue; } r -= I_O;
        if (r < I_CO) { p0_transpose_item<0>(kin<I_WCO>(), DCONV, DM, bt_co, 0, scr, r, F.lane); continue; } r -= I_CO;
        p0_transpose_item<0>(kin<I_WAO>(), DCONV, DM, bt_ao, 0, scr, r, F.lane);
    }
    {
        GAS v4u* z = (GAS v4u*)(bt_in + (size_t)D_IN * DM); const int nz = (NP - D_IN) * DM * 2 / 16;
        for (int i = F.bid * (NWAVES * 64) + F.tid; i < nz; i += F.G * NWAVES * 64) z[i] = (v4u){0u, 0u, 0u, 0u};
    }
}

__device__ __forceinline__ float mod_sum(const float* modp, const float* bada, int bb, int col) {
    float s = bada[col];
#pragma unroll 8
    for (int ks = 0; ks < KSPLIT; ++ks) s += modp[(size_t)(ks * 2 + bb) * NMOD + col];
    return s;
}
__device__ __forceinline__ void p1_h1(Frame& F) {
    const float* modp = (const float*)(F.ws + WS_MODP); float* modf = (float*)(F.ws + WS_MODF); const float* bada = kin<I_BADA>();
    LAS float* scaleL = (LAS float*)(F.lds + RING_OFF); LAS float* shiftL = scaleL + DM;
    bf16* H = (bf16*)(F.ws + WS_H);
    for (int idx = F.bid * (NWAVES * 64) + F.tid; idx < 2 * NMOD; idx += F.G * NWAVES * 64) { const int bb = idx / NMOD, col = idx % NMOD; modf[idx] = mod_sum(modp, bada, bb, col); }
    for (int tile = F.bid; tile < MTOK / 32; tile += F.G) {
        const int bb = tile / (SEQ / 32);
        __syncthreads();
        for (int j = 0; j < 8; ++j) { const int col = F.tid + 512 * j; const float s = mod_sum(modp, bada, bb, col);
            if (col < DM) shiftL[col] = s; else scaleL[col - DM] = kin<I_GPREMIX>()[col - DM] * (1.0f + s); }
        __syncthreads();
        for (int i = 0; i < 4; ++i) {
            const int row = tile * 32 + F.wave * 4 + i;
            const f32x4* xr = (const f32x4*)(kin<I_X>() + (size_t)row * DM) + F.lane;
            f32x4 v[8]; float ss = 0.f;
#pragma unroll
            for (int j = 0; j < 8; ++j) { v[j] = xr[64 * j]; ss += (v[j][0] * v[j][0] + v[j][1] * v[j][1]) + (v[j][2] * v[j][2] + v[j][3] * v[j][3]); }
            const float rstd = 1.0f / sqrtf(wave_sum(ss) * (1.0f / DM) + EPS);
            unsigned long long* o8 = (unsigned long long*)(H + (size_t)row * DM) + F.lane;
#pragma unroll
            for (int j = 0; j < 8; ++j) { const f32x4 sc = *(const LAS f32x4*)(scaleL + 4 * F.lane + 256 * j), sh = *(const LAS f32x4*)(shiftL + 4 * F.lane + 256 * j);
                const f32x4 h = v[j] * rstd * sc + sh;
                o8[64 * j] = (unsigned long long)pk2(h[0], h[1]) | ((unsigned long long)pk2(h[2], h[3]) << 32); }
        }
    }
    __syncthreads();
}

template <int II> struct ConvLoop {
    static __device__ __forceinline__ void run(f32x2v (&acc)[32], const f32x2v (&w)[CONVW], const bf16* PROJ, int bb, int s0, int ch) {
        const int sin = s0 - 30 + II; const int sc = sin < 0 ? 0 : sin; const float ok = sin < 0 ? 0.f : 1.f;
        const bf16* rp = PROJ + (size_t)(bb * SEQ + sc) * NP + OFF_GLU + ch;
        const unsigned a2 = *(const unsigned*)rp, g2 = *(const unsigned*)(rp + DCONV);
        f32x2v u; u.x = ok * bf_lo(a2) * sigmoidf_fast(bf_lo(g2)); u.y = ok * bf_hi(a2) * sigmoidf_fast(bf_hi(g2));
        constexpr int lo = II > 30 ? II - 30 : 0, hi = II < 31 ? II : 31;
#pragma unroll
        for (int o = lo; o <= hi; ++o) acc[o] += w[II - o] * u;
        if ((II & 7) == 7) asm volatile("" ::: "memory");
        ConvLoop<II + 1>::run(acc, w, PROJ, bb, s0, ch);
    }
};
template <> struct ConvLoop<62> { static __device__ __forceinline__ void run(f32x2v (&)[32], const f32x2v (&)[CONVW], const bf16*, int, int, int) {} };

__device__ __forceinline__ void p3_conv_tile(Frame& F, int tile) {
    const bf16* PROJ = (const bf16*)(F.ws + WS_PROJ); bf16* CACT = (bf16*)(F.ws + WS_CACT);
    LAS float* red = (LAS float*)(F.lds + RING_OFF);
    LAS float* stat = red + 8 * 64;
    const int bb = tile / (SEQ / 32), s0 = (tile % (SEQ / 32)) * 32, ch = 2 * F.tid;
    f32x2v w[CONVW];
#pragma unroll
    for (int j = 0; j < CONVW; ++j) w[j] = *(const f32x2v*)(kin<I_WDW>() + j * DCONV + ch);
    f32x2v acc[32];
#pragma unroll
    for (int o = 0; o < 32; ++o) acc[o] = (f32x2v){0.f, 0.f};
    ConvLoop<0>::run(acc, w, PROJ, bb, s0, ch);
    const f32x2v bdw = *(const f32x2v*)(kin<I_BDW>() + ch);
    float vals[64];
#pragma unroll
    for (int o = 0; o < 32; ++o) { acc[o] += bdw; vals[2 * o] = acc[o].x + acc[o].y; vals[2 * o + 1] = acc[o].x * acc[o].x + acc[o].y * acc[o].y; }
#define BFLY(d, n) do { const bool up = (F.lane & (d)) != 0; _Pragma("unroll") for (int k = 0; k < (n); ++k) { const float send = up ? vals[k] : vals[k + (n)], keep = up ? vals[k + (n)] : vals[k]; vals[k] = keep + __shfl_xor(send, (d)); } } while (0)
    BFLY(32, 32); BFLY(16, 16); BFLY(8, 8); BFLY(4, 4); BFLY(2, 2); BFLY(1, 1);
#undef BFLY
    __syncthreads();
    red[F.wave * 64 + F.lane] = vals[0];
    __syncthreads();
    if (F.tid < 32) { float s = 0.f, q = 0.f;
#pragma unroll
        for (int wv = 0; wv < 8; ++wv) { s += red[wv * 64 + 2 * F.tid]; q += red[wv * 64 + 2 * F.tid + 1]; }
        const float mean = s * (1.0f / DCONV), var = q * (1.0f / DCONV) - mean * mean;
        stat[2 * F.tid] = mean; stat[2 * F.tid + 1] = 1.0f / sqrtf(var + EPS); }
    __syncthreads();
    const f32x2v gl = *(const f32x2v*)(kin<I_GLN>() + ch), bl = *(const f32x2v*)(kin<I_BLN>() + ch);
#pragma unroll
    for (int o = 0; o < 32; ++o) { const float mean = stat[2 * o], rstd = stat[2 * o + 1];
        const float z0 = (acc[o].x - mean) * rstd * gl.x + bl.x, z1 = (acc[o].y - mean) * rstd * gl.y + bl.y;
        *(unsigned*)(CACT + (size_t)(bb * SEQ + s0 + o) * DCONV + ch) = pg8::cvt_pk_bf16(z0 * sigmoidf_fast(z0), z1 * sigmoidf_fast(z1)); }
}

__device__ __forceinline__ void p3_indexer_block(Frame& F, int bu) {
    const bf16* PROJ = (const bf16*)(F.ws + WS_PROJ); unsigned long long* MASK = (unsigned long long*)(F.ws + WS_MASK);
    const int bb = bu & 1, blk = bu >> 1, q0 = bb * SEQ + 16 * blk, nj = (blk >> 2) + 1, ntile = 2 * nj, nstage = (nj + 3) >> 2;
    const int lane = F.lane, rho = lane & 31, hh = lane >> 5, e = (rho >> 2) & 1, hd = (rho & 3) + 4 * (rho >> 3);
    const int qw = q0 + 2 * F.wave;
    bf16x8 A[4];
    { const bf16* qrow = PROJ + (size_t)(qw + e) * NP + OFF_QI + hd * 64 + 8 * hh;
#pragma unroll
      for (int s = 0; s < 4; ++s) A[s] = *(const bf16x8*)(qrow + 16 * s); }
    float wv[16];
    { const v4u* wrow = (const v4u*)(PROJ + (size_t)(qw + hh) * NP + OFF_WI); const v4u w0 = wrow[0], w1 = wrow[1];
      const float sc = 0.03125f;
      wv[0] = bf_lo(w0.x) * sc; wv[1] = bf_hi(w0.x) * sc; wv[2] = bf_lo(w0.y) * sc; wv[3] = bf_hi(w0.y) * sc; wv[4] = bf_lo(w0.z) * sc; wv[5] = bf_hi(w0.z) * sc; wv[6] = bf_lo(w0.w) * sc; wv[7] = bf_hi(w0.w) * sc;
      wv[8] = bf_lo(w1.x) * sc; wv[9] = bf_hi(w1.x) * sc; wv[10] = bf_lo(w1.y) * sc; wv[11] = bf_hi(w1.y) * sc; wv[12] = bf_lo(w1.z) * sc; wv[13] = bf_hi(w1.z) * sc; wv[14] = bf_lo(w1.w) * sc; wv[15] = bf_hi(w1.w) * sc; }
    const bf16* ksrc = PROJ + (size_t)(bb * SEQ + 32 * F.wave + (lane >> 3)) * NP + OFF_KI + ((lane & 7) ^ (lane >> 3)) * 8;
    const unsigned ldsb = (unsigned)(uintptr_t)(F.lds + RING_OFF) + (unsigned)F.wave * 4096u;
#define IDX_DMA(st) do { _Pragma("unroll") for (int i_ = 0; i_ < 4; ++i_) attn_body::glds16(ksrc + (size_t)(256 * (st) + 8 * i_) * NP, (unsigned)__builtin_amdgcn_readfirstlane(ldsb + (unsigned)(((st) % 3) * 32768 + i_ * 1024))); } while (0)
    IDX_DMA(0);
    if (nstage > 1) IDX_DMA(1);
    const LAS unsigned char* rdp = F.lds + RING_OFF + rho * 128;
    const int sw = rho & 7;
    unsigned key[128];
#pragma unroll
    for (int g = 0; g < 16; ++g) {
        if (g < nstage) {
            if (g + 1 < nstage) asm volatile("s_waitcnt vmcnt(4) lgkmcnt(0)\n\ts_barrier" ::: "memory"); else asm volatile("s_waitcnt vmcnt(0) lgkmcnt(0)\n\ts_barrier" ::: "memory");
            if (g + 2 < nstage) IDX_DMA(g + 2);
#pragma unroll
            for (int k = 0; k < 8; ++k) {
                const int kt = 8 * g + k;
                key[kt] = 0u;
                if (kt < ntile) {
                    const LAS unsigned char* tp = rdp + (g % 3) * 32768 + k * 4096;
                    f32x16 acc = {0.f, 0.f, 0.f, 0.f, 0.f, 0.f, 0.f, 0.f, 0.f, 0.f, 0.f, 0.f, 0.f, 0.f, 0.f, 0.f};
#pragma unroll
                    for (int s = 0; s < 4; ++s) { const bf16x8 B = *(const LAS bf16x8*)(tp + (((2 * s + hh) ^ sw) << 4)); acc = __builtin_amdgcn_mfma_f32_32x32x16_bf16(A[s], B, acc, 0, 0, 0); }
                    float v = 0.f;
#pragma unroll
                    for (int r = 0; r < 16; ++r) v += wv[r] * fmaxf(acc[r], 0.f);
                    const unsigned u = __builtin_bit_cast(unsigned, v);
                    key[kt] = (u & 0x80000000u) ? ~u : (u | 0x80000000u);
                    asm volatile("" : "+v"(key[kt]));
                }
                if (k & 1) { asm volatile("" ::: "memory"); __builtin_amdgcn_sched_barrier(0); }
            }
        } else {
#pragma unroll
            for (int k = 0; k < 8; ++k) key[8 * g + k] = 0u;
        }
    }
#undef IDX_DMA
    unsigned T = 1u;
    if (nj * 64 > TOPK) {
        T = 0u; bool done = false;
        for (int bit = 31; bit >= 0; --bit) {
            const unsigned cand = T | (1u << bit); int cnt = 0;
#pragma unroll
            for (int j = 0; j < 128; ++j) cnt += (key[j] >= cand) ? 1 : 0;
            cnt += __shfl_xor(cnt, 16); cnt += __shfl_xor(cnt, 8); cnt += __shfl_xor(cnt, 4); cnt += __shfl_xor(cnt, 2); cnt += __shfl_xor(cnt, 1);
            if (!done) { if (cnt >= TOPK) T = cand; if (cnt == TOPK) done = true; }
            if (__all(done)) break;
        }
    }
    unsigned a_lo = 0u, a_hi = 0u, b_lo = 0u, b_hi = 0u;
#pragma unroll
    for (int j = 0; j < 128; ++j) { const unsigned long long mk = __ballot(key[j] >= T);
        if (lane == (j >> 1)) { if (j & 1) { a_hi = (unsigned)mk; b_hi = (unsigned)(mk >> 32); } else { a_lo = (unsigned)mk; b_lo = (unsigned)(mk >> 32); } } }
    MASK[(size_t)qw * 64 + lane] = (unsigned long long)a_lo | ((unsigned long long)a_hi << 32);
    MASK[(size_t)(qw + 1) * 64 + lane] = (unsigned long long)b_lo | ((unsigned long long)b_hi << 32);
    asm volatile("s_waitcnt vmcnt(0) lgkmcnt(0)\n\ts_barrier" ::: "memory");
}

__device__ __forceinline__ void p7_rows(Frame& F) {
    const float* modf = (const float*)(F.ws + WS_MODF); bf16* H = (bf16*)(F.ws + WS_H);
    LAS float* A1 = (LAS float*)(F.lds + RING_OFF); LAS float* S2 = A1 + DM; LAS float* T2 = S2 + DM;
    for (int tile = F.bid; tile < MTOK / 32; tile += F.G) {
        const int bb = tile / (SEQ / 32);
        __syncthreads();
        for (int j = 0; j < 4; ++j) { const int col = F.tid + 512 * j;
            A1[col] = modf[bb * NMOD + 2 * DM + col] * kin<I_GPOSTMIX>()[col];
            S2[col] = kin<I_GPREFFN>()[col] * (1.0f + modf[bb * NMOD + 4 * DM + col]);
            T2[col] = modf[bb * NMOD + 3 * DM + col]; }
        __syncthreads();
        for (int i = 0; i < 4; ++i) {
            const int row = tile * 32 + F.wave * 4 + i;
            const f32x4* xr = (const f32x4*)(kin<I_X>() + (size_t)row * DM) + F.lane;
            f32x4* mr = (f32x4*)(F.out + (size_t)row * DM) + F.lane;
            f32x4 mv[8], xv[8]; float ss = 0.f;
#pragma unroll
            for (int j = 0; j < 8; ++j) { mv[j] = mr[64 * j]; xv[j] = xr[64 * j]; ss += (mv[j][0] * mv[j][0] + mv[j][1] * mv[j][1]) + (mv[j][2] * mv[j][2] + mv[j][3] * mv[j][3]); }
            const float rstd = 1.0f / sqrtf(wave_sum(ss) * (1.0f / DM) + EPS);
            float s1 = 0.f;
#pragma unroll
            for (int j = 0; j < 8; ++j) { const f32x4 a = *(const LAS f32x4*)(A1 + 4 * F.lane + 256 * j); xv[j] = xv[j] + mv[j] * rstd * a;
                s1 += (xv[j][0] * xv[j][0] + xv[j][1] * xv[j][1]) + (xv[j][2] * xv[j][2] + xv[j][3] * xv[j][3]); mr[64 * j] = xv[j]; }
            const float rstd1 = 1.0f / sqrtf(wave_sum(s1) * (1.0f / DM) + EPS);
            unsigned long long* o8 = (unsigned long long*)(H + (size_t)row * DM) + F.lane;
#pragma unroll
            for (int j = 0; j < 8; ++j) { const f32x4 sc = *(const LAS f32x4*)(S2 + 4 * F.lane + 256 * j), sh = *(const LAS f32x4*)(T2 + 4 * F.lane + 256 * j);
                const f32x4 h = xv[j] * rstd1 * sc + sh;
                o8[64 * j] = (unsigned long long)pk2(h[0], h[1]) | ((unsigned long long)pk2(h[2], h[3]) << 32); }
        }
    }
    __syncthreads();
}
__device__ __forceinline__ void p10_rows(Frame& F) {
    const float* modf = (const float*)(F.ws + WS_MODF); const float* Fb = (const float*)(F.ws + WS_F);
    LAS float* A2 = (LAS float*)(F.lds + RING_OFF);
    for (int tile = F.bid; tile < MTOK / 32; tile += F.G) {
        const int bb = tile / (SEQ / 32);
        __syncthreads();
        for (int j = 0; j < 4; ++j) { const int col = F.tid + 512 * j; A2[col] = modf[bb * NMOD + 5 * DM + col] * kin<I_GPOSTFFN>()[col]; }
        __syncthreads();
        for (int i = 0; i < 4; ++i) {
            const int row = tile * 32 + F.wave * 4 + i;
            const f32x4* fr = (const f32x4*)(Fb + (size_t)row * DM) + F.lane;
            f32x4* orow = (f32x4*)(F.out + (size_t)row * DM) + F.lane;
            f32x4 fv[8], xv[8]; float ss = 0.f;
#pragma unroll
            for (int j = 0; j < 8; ++j) { fv[j] = fr[64 * j]; xv[j] = orow[64 * j]; ss += (fv[j][0] * fv[j][0] + fv[j][1] * fv[j][1]) + (fv[j][2] * fv[j][2] + fv[j][3] * fv[j][3]); }
            const float rstd = 1.0f / sqrtf(wave_sum(ss) * (1.0f / DM) + EPS);
#pragma unroll
            for (int j = 0; j < 8; ++j) { const f32x4 a = *(const LAS f32x4*)(A2 + 4 * F.lane + 256 * j); orow[64 * j] = xv[j] + fv[j] * rstd * a; }
        }
    }
}

#ifndef MK_N_LAUNCHES
#define MK_N_LAUNCHES 1
#endif
constexpr int N_PHASES = 11;
struct Args { const float* in[19]; float* out; unsigned char* ws; int ph_lo, ph_hi; };
__global__ void __launch_bounds__(NWAVES * 64, 2) mk_fwd(Args args) {
    extern __shared__ __attribute__((aligned(16))) unsigned char lds[];
    Frame F;
    F.lds = (LAS unsigned char*)lds;
    F.MISC = (volatile LAS unsigned*)(F.lds + MISC_OFF);
    F.tid = threadIdx.x; F.lane = F.tid & 63; F.wave = __builtin_amdgcn_readfirstlane(F.tid >> 6);
    F.G = gridDim.x; F.bid = blockIdx.x;
    F.ws = args.ws; F.out = args.out; F.ctl = (gu32*)(args.ws + WS_CTL);
    for (int u = F.tid; u < (LDS_BYTES - LDSCTL_OFF) / 4; u += NWAVES * 64) ((LAS unsigned*)(F.lds + LDSCTL_OFF))[u] = 0u;
    __syncthreads();
    XcdBarrier bar; bar.bar = (unsigned*)(F.ctl + CW_BAR); bar.x = 0; bar.st = nullptr;
    if (MK_N_LAUNCHES == 1) bar = xcd_barrier_post((unsigned*)(F.ctl + CW_BAR), F.MISC + 8);
    const int lo = args.ph_lo, hi = args.ph_hi;
#define IN(k) (lo <= (k) && (k) < hi)
#define SEAM(k) do { if (IN(k) && IN((k) + 1)) xcd_barrier(bar); } while (0)
#ifndef DUP_PHASE
#define DUP_PHASE (-1)
#endif
#define PH(k) if (IN(k)) for (int rep_ = 0; rep_ < ((k) == DUP_PHASE ? 2 : 1); ++rep_)
#define REP_BAR() do { if (rep_) xcd_barrier(bar); } while (0)
    bf16* H = (bf16*)(F.ws + WS_H); bf16* PROJ = (bf16*)(F.ws + WS_PROJ);
    const int gw = F.bid * NWAVES + F.wave, NGW = F.G * NWAVES;

    PH(0) { REP_BAR(); p0_prologue(F); } SEAM(0);
    PH(1) { REP_BAR(); p1_h1(F); } SEAM(1);
    PH(2) { REP_BAR();
        pg8::Gemm g{H, (const bf16*)(F.ws + WS_BT_IN), MTOK, NP, DM}; pg8::StaticOrder S; S.init(MTOK, NP, F.G, F.bid);
        EpiStoreBf16 E{PROJ, NP, OFF_Q, OFF_K, attn_body::C2};
        pg8::gemm_phase<EpiStoreBf16, pg8::StaticOrder, true, true>(F.lds + RING_OFF, g, S, E);
    } SEAM(2);
    PH(3) { REP_BAR();
        for (int tile = F.bid; tile < MTOK / 32; tile += F.G) p3_conv_tile(F, tile);
        __syncthreads();
        for (int pu = F.bid; pu < 256; pu += F.G) { p3_indexer_block(F, pu); p3_indexer_block(F, 511 - pu); }
    } SEAM(3);
    PH(4) { REP_BAR();
        static_assert(attn_body::ATTN_LDS_BYTES <= RING_BYTES, "attention LDS");
        const attn_body::AttnTensors AT{(const attn_body::bf16*)(PROJ + OFF_Q), (const attn_body::bf16*)(PROJ + OFF_K), (const attn_body::bf16*)(PROJ + OFF_V), (attn_body::bf16*)(F.ws + WS_AOUT), (const unsigned*)(F.ws + WS_MASK)};
        const attn_body::StaticOrder S(F.G, F.bid);
        attn_body::attn_phase<attn_body::StaticOrder>((char*)lds + RING_OFF, AT, S);
    } SEAM(4);
    PH(5) { REP_BAR();
        { pg8::Gemm g{(const bf16*)(F.ws + WS_CACT), (const bf16*)(F.ws + WS_BT_CO), MTOK, DM, DCONV}; pg8::StaticOrder S; S.init(MTOK, DM, F.G, F.bid);
          EpiGateConv E{F.out, PROJ + OFF_G, NP};
          pg8::gemm_phase<EpiGateConv, pg8::StaticOrder, true, true>(F.lds + RING_OFF, g, S, E); }
        { pg8::Gemm g{(const bf16*)(F.ws + WS_AOUT), (const bf16*)(F.ws + WS_BT_AO), MTOK, DM, DCONV}; pg8::StaticOrder S; S.init(MTOK, DM, F.G, F.bid);
          EpiGateAttn E{F.out, PROJ + OFF_G + DM, NP, (bf16*)(F.ws + WS_MERGED)};
          pg8::gemm_phase<EpiGateAttn, pg8::StaticOrder, true, true>(F.lds + RING_OFF, g, S, E); }
    } SEAM(5);
    PH(6) { REP_BAR();
        pg8::Gemm g{(const bf16*)(F.ws + WS_MERGED), (const bf16*)(F.ws + WS_BT_O), MTOK, DM, DM}; pg8::StaticOrder S; S.init(MTOK, DM, F.G, F.bid);
        EpiStoreF32 E{F.out, DM};
        pg8::gemm_phase<EpiStoreF32, pg8::StaticOrder, true, true>(F.lds + RING_OFF, g, S, E);
    } SEAM(6);
    PH(7) { REP_BAR(); p7_rows(F); } SEAM(7);
    PH(8) { REP_BAR();
        pg8::Gemm g{H, (const bf16*)(F.ws + WS_BT_GU), MTOK, NGU, DM}; pg8::StaticOrder S; S.init(MTOK, NGU, F.G, F.bid);
        EpiSwiGLU E{(bf16*)(F.ws + WS_GU)};
        pg8::gemm_phase<EpiSwiGLU, pg8::StaticOrder, true, true>(F.lds + RING_OFF, g, S, E);
    } SEAM(8);
    PH(9) { REP_BAR();
        pg8::Gemm g{(const bf16*)(F.ws + WS_GU), (const bf16*)(F.ws + WS_BT_DN), MTOK, DM, DFF}; pg8::StaticOrder S; S.init(MTOK, DM, F.G, F.bid);
        EpiStoreF32 E{(float*)(F.ws + WS_F), DM};
        pg8::gemm_phase<EpiStoreF32, pg8::StaticOrder, true, true>(F.lds + RING_OFF, g, S, E);
    } SEAM(9);
    PH(10) { REP_BAR(); p10_rows(F); }
#undef IN
#undef SEAM
}

extern "C" void kernel_launch(void* const* d_in, const int* in_sizes, int n_in, void* d_out, int out_size, void* d_ws, size_t ws_size, hipStream_t stream) {
    static int grid = 0;
    if (grid == 0) {
        if (n_in != 19 || in_sizes[0] != MTOK * DM || out_size != MTOK * DM || ws_size < WS_END) { fprintf(stderr, "kernel_launch: unexpected shapes / workspace (n_in %d, in0 %d, out %d, ws %zu < %zu)\n", n_in, n_in > 0 ? in_sizes[0] : -1, out_size, ws_size, (size_t)WS_END); grid = -1; return; }
        int dev = 0, cus = 0, per_cu = 0;
        if (hipGetDevice(&dev) != hipSuccess || hipDeviceGetAttribute(&cus, hipDeviceAttributeMultiprocessorCount, dev) != hipSuccess) { grid = -1; return; }
        if (hipFuncSetAttribute((const void*)mk_fwd, hipFuncAttributeMaxDynamicSharedMemorySize, LDS_BYTES) != hipSuccess) { fprintf(stderr, "kernel_launch: hipFuncSetAttribute failed\n"); grid = -1; return; }
        if (hipOccupancyMaxActiveBlocksPerMultiprocessor(&per_cu, (const void*)mk_fwd, NWAVES * 64, LDS_BYTES) != hipSuccess || per_cu < 1) { fprintf(stderr, "kernel_launch: occupancy query says %d blocks per CU\n", per_cu); (void)hipGetLastError(); grid = -1; return; }
        grid = cus;
    }
    if (grid < 0) return;
    if (hipMemsetAsync((char*)d_ws + WS_CTL, 0, CTL_ZERO_BYTES, stream) != hipSuccess) return;
    Args a{};
    for (int i = 0; i < 19; ++i) a.in[i] = (const float*)d_in[i];
    a.out = (float*)d_out; a.ws = (unsigned char*)d_ws;
#if MK_N_LAUNCHES == 1
    a.ph_lo = 0; a.ph_hi = N_PHASES;
    hipLaunchKernelGGL(mk_fwd, dim3(grid), dim3(NWAVES * 64), LDS_BYTES, stream, a);
#else
    for (int p = 0; p < N_PHASES; ++p) { a.ph_lo = p; a.ph_hi = p + 1; hipLaunchKernelGGL(mk_fwd, dim3(grid), dim3(NWAVES * 64), LDS_BYTES, stream, a); }
#endif
}
```

```cpp
#include <hip/hip_runtime.h>
#include <cstdio>
#include <cstdint>
namespace pg8 {
#define PG8_LAS __attribute__((address_space(3)))
typedef unsigned short bf16_t;
typedef short bf16x8 __attribute__((ext_vector_type(8)));
typedef float f32x4 __attribute__((ext_vector_type(4)));
typedef unsigned u32x4 __attribute__((ext_vector_type(4)));
constexpr int BM = 256, BK = 64, HALF = 128, HTB = HALF * BK * 2  , STAGE_BYTES = 8 * HTB, NXCD = 8, WGM = 8;

__host__ __device__ __forceinline__ int lds_byte(int r, int c) { const int st = (r >> 4) * 2 + (c >> 5), rr = r & 15, cc = c & 31, ob = rr * 64 + cc * 2; return st * 1024 + (ob ^ (((ob >> 9) & 1) << 5)); }
__host__ __device__ __forceinline__ void stage_rc(int b, int& R, int& C) { const int st = b / 1024, sb = b % 1024, swz = sb ^ (((sb >> 9) & 1) << 5); R = (st >> 1) * 16 + swz / 64; C = (st & 1) * 32 + (swz % 64) / 2; }
__host__ __device__ __forceinline__ int perm32(int rho) { const int n = rho >> 4, i = rho & 15; return 8 * (i >> 2) + 4 * n + (i & 3); }

struct Unit { int pm, pn; };
struct Gemm { const bf16_t* A; const bf16_t* Bt; int M, N, K; };

struct StaticOrder {
    int nM, nN, nwg, G, c;
    __host__ __device__ void init(int M, int N, int G_, int c_) { nM = M / BM; nN = N / BM; nwg = nM * nN; G = G_; c = c_; }
    __host__ __device__ bool next(int i, Unit& u) const {
        const long L = (long)i * G + c; if (L >= nwg) return false;
        int wgid = (int)L; { const int q = nwg / NXCD, r = nwg % NXCD, xcd = wgid % NXCD, off = wgid / NXCD; wgid = (xcd < r ? xcd * (q + 1) : r * (q + 1) + (xcd - r) * q) + off; }
        const int nig = WGM * nN, gid = wgid / nig, fm = gid * WGM, gsz = (nM - fm) < WGM ? (nM - fm) : WGM;
        u.pm = fm + ((wgid % nig) % gsz); u.pn = (wgid % nig) / gsz; return true;
    }
    __device__ __forceinline__ void a_ready(const Unit&) const {}
    __device__ __forceinline__ void done(const Unit&) const {}
};

__device__ __forceinline__ unsigned cvt_pk_bf16(float lo, float hi) { unsigned r; asm volatile("v_cvt_pk_bf16_f32 %0, %1, %2" : "=v"(r) : "v"(lo), "v"(hi)); return r; }
typedef float f32x2 __attribute__((ext_vector_type(2)));
template <class Epi, class Sched, bool ALIGN_EPI = false, bool SP2 = false>
__device__ __forceinline__ void gemm_phase(PG8_LAS unsigned char* lds, const Gemm g, const Sched& S, const Epi& E) {
    const int tid = threadIdx.x, wid = __builtin_amdgcn_readfirstlane(tid >> 6), lane = tid & 63, wr = wid >> 2, wc = wid & 3, fr = lane & 15, fq = lane >> 4;
    const int K = g.K, nt = K / BK;
    unsigned voffA[2], voffB[2];
#pragma unroll
    for (int i = 0; i < 2; ++i) { int R, C; stage_rc(tid * 16 + i * 8192, R, C); const int Rb = Epi::PERM ? ((R & ~31) + perm32(R & 31)) : R;
        voffA[i] = (unsigned)(R * K + C) * 2u; voffB[i] = (unsigned)(Rb * K + C) * 2u; }
    const size_t kstep = (size_t)(BK * 2);
    const size_t hstep = (size_t)HALF * K * 2;
    const size_t tstep = 2 * hstep;
    const unsigned ldsw = (unsigned)wid * 1024u;
    const int aoff = lds_byte(wr * 64 + fr, fq * 8), boff = lds_byte(wc * 32 + fr, fq * 8);
#define PG8_SA(b, h) (((b) * 2 + (h)) * HTB)
#define PG8_SB(b, h) ((4 + (b) * 2 + (h)) * HTB)
#define PG8_STAGE(bufoff, gbase, voff) do { _Pragma("unroll") for (int _i = 0; _i < 2; ++_i) \
        __builtin_amdgcn_global_load_lds((const unsigned*)((const char*)(gbase) + (voff)[_i]), (PG8_LAS unsigned*)(lds + (bufoff) + ldsw + _i * 8192), 16, 0, 0); } while (0)
#define PG8_LDA(dst, b, h) do { _Pragma("unroll") for (int m = 0; m < 4; ++m) _Pragma("unroll") for (int k = 0; k < 2; ++k) dst[m][k] = *(const PG8_LAS bf16x8*)(lds + PG8_SA(b, h) + aoff + m * 2048 + k * 1024); } while (0)
#define PG8_LDB(dst, b, h) do { _Pragma("unroll") for (int n = 0; n < 2; ++n) _Pragma("unroll") for (int k = 0; k < 2; ++k) dst[n][k] = *(const PG8_LAS bf16x8*)(lds + PG8_SB(b, h) + boff + n * 2048 + k * 1024); } while (0)
#define PG8_MMA(ai, bj, At, Bt) do { __builtin_amdgcn_s_setprio(1); _Pragma("unroll") for (int m = 0; m < 4; ++m) _Pragma("unroll") for (int n = 0; n < 2; ++n) _Pragma("unroll") for (int k = 0; k < 2; ++k) \
        acc[ai][bj][m][n] = __builtin_amdgcn_mfma_f32_16x16x32_bf16(Bt[n][k], At[m][k], acc[ai][bj][m][n], 0, 0, 0); __builtin_amdgcn_s_setprio(0); } while (0)
#define PG8_WAIT_V(n) asm volatile("s_waitcnt vmcnt(" #n ")" ::: "memory")
#define PG8_WAIT_L(n) asm volatile("s_waitcnt lgkmcnt(" #n ")" ::: "memory")
#define PG8_BAR __builtin_amdgcn_s_barrier()
#define PG8_SCHED __builtin_amdgcn_sched_barrier(0)
    Unit cur, nxt; int ui = 0;
    if (!S.next(0, cur)) return;
    f32x4 acc[2][2][4][2];
#pragma unroll
    for (int a = 0; a < 2; ++a)
#pragma unroll
        for (int b = 0; b < 2; ++b)
#pragma unroll
            for (int m = 0; m < 4; ++m)
#pragma unroll
                for (int n = 0; n < 2; ++n) acc[a][b][m][n] = (f32x4){0.f, 0.f, 0.f, 0.f};
    bf16x8 At[4][2], B0[2][2], B1[2][2];
    const char* cA = (const char*)g.A + (size_t)cur.pm * tstep; const char* cB = (const char*)g.Bt + (size_t)cur.pn * tstep;
    S.a_ready(cur);
    if constexpr (SP2) {
        PG8_STAGE(PG8_SB(0, 0), cB, voffB); PG8_STAGE(PG8_SB(0, 1), cB + hstep, voffB); PG8_STAGE(PG8_SA(0, 0), cA, voffA); PG8_STAGE(PG8_SA(0, 1), cA + hstep, voffA);
        if (wr == 1) PG8_BAR;
        PG8_WAIT_V(2); PG8_BAR;
        PG8_STAGE(PG8_SB(1, 0), cB + kstep, voffB); PG8_STAGE(PG8_SA(1, 0), cA + kstep, voffA); PG8_STAGE(PG8_SB(1, 1), cB + hstep + kstep, voffB);
        PG8_WAIT_V(6); PG8_BAR;
    } else {
        PG8_STAGE(PG8_SB(0, 0), cB, voffB); PG8_STAGE(PG8_SA(0, 0), cA, voffA); PG8_STAGE(PG8_SB(0, 1), cB + hstep, voffB); PG8_STAGE(PG8_SA(0, 1), cA + hstep, voffA);
        if (wr == 1) PG8_BAR;
        PG8_WAIT_V(4); PG8_BAR;
        PG8_STAGE(PG8_SB(1, 0), cB + kstep, voffB); PG8_STAGE(PG8_SA(1, 0), cA + kstep, voffA); PG8_STAGE(PG8_SB(1, 1), cB + hstep + kstep, voffB);
        PG8_WAIT_V(6); PG8_BAR;
    }
    for (;;) {
        const bool has_next = S.next(ui + 1, nxt);
        const char* nA = has_next ? (const char*)g.A + (size_t)nxt.pm * tstep : cA; const char* nB = has_next ? (const char*)g.Bt + (size_t)nxt.pn * tstep : cB;
        for (int t = 0; t < nt; t += 2) {
            const bool last = (t == nt - 2);
            const char* a1 = cA + (size_t)(t + 1) * kstep;
            const char* a2 = last ? nA : cA + (size_t)(t + 2) * kstep; const char* b2 = last ? nB : cB + (size_t)(t + 2) * kstep;
            const char* a3 = a2 + kstep; const char* b3 = b2 + kstep;
            if (last && has_next) S.a_ready(nxt);
            if constexpr (SP2) {
            PG8_LDB(B0, 0, 0); PG8_LDB(B1, 0, 1); PG8_SCHED; PG8_LDA(At, 0, 0); PG8_STAGE(PG8_SA(1, 1), a1 + hstep, voffA);
            PG8_WAIT_V(8); PG8_WAIT_L(0); PG8_BAR; PG8_MMA(0, 0, At, B0); PG8_MMA(0, 1, At, B1); PG8_BAR; PG8_SCHED;
            PG8_LDA(At, 0, 1); PG8_STAGE(PG8_SB(0, 0), b2, voffB); PG8_STAGE(PG8_SB(0, 1), b2 + hstep, voffB); PG8_STAGE(PG8_SA(0, 0), a2, voffA);
            PG8_WAIT_V(8); PG8_WAIT_L(0); PG8_BAR; PG8_MMA(1, 0, At, B0); PG8_MMA(1, 1, At, B1); PG8_BAR; PG8_SCHED;
            PG8_LDB(B0, 1, 0); PG8_LDB(B1, 1, 1); PG8_SCHED; PG8_LDA(At, 1, 0); PG8_STAGE(PG8_SA(0, 1), a2 + hstep, voffA);
            PG8_WAIT_V(8); PG8_WAIT_L(0); PG8_BAR; PG8_MMA(0, 0, At, B0); PG8_MMA(0, 1, At, B1); PG8_BAR; PG8_SCHED;
            PG8_LDA(At, 1, 1); PG8_STAGE(PG8_SB(1, 0), b3, voffB); PG8_STAGE(PG8_SB(1, 1), b3 + hstep, voffB); PG8_STAGE(PG8_SA(1, 0), a3, voffA);
            PG8_WAIT_V(8); PG8_WAIT_L(0); PG8_BAR; PG8_MMA(1, 0, At, B0); PG8_MMA(1, 1, At, B1); PG8_BAR; PG8_SCHED;
            } else {
            PG8_LDB(B0, 0, 0); PG8_SCHED; PG8_LDA(At, 0, 0); PG8_STAGE(PG8_SA(1, 1), a1 + hstep, voffA);
            PG8_WAIT_L(8); PG8_BAR; PG8_WAIT_L(0); PG8_MMA(0, 0, At, B0); PG8_BAR; PG8_SCHED;
            PG8_LDB(B1, 0, 1); PG8_STAGE(PG8_SB(0, 0), b2, voffB);
            PG8_BAR; PG8_WAIT_L(0); PG8_MMA(0, 1, At, B1); PG8_BAR;
            PG8_LDA(At, 0, 1); PG8_STAGE(PG8_SA(0, 0), a2, voffA);
            PG8_BAR; PG8_WAIT_L(0); PG8_MMA(1, 0, At, B0); PG8_BAR; PG8_SCHED;
            PG8_STAGE(PG8_SB(0, 1), b2 + hstep, voffB);
            PG8_WAIT_V(6); PG8_BAR; PG8_MMA(1, 1, At, B1); PG8_BAR;
            PG8_LDB(B0, 1, 0); PG8_SCHED; PG8_LDA(At, 1, 0); PG8_STAGE(PG8_SA(0, 1), a2 + hstep, voffA);
            PG8_WAIT_L(8); PG8_BAR; PG8_WAIT_L(0); PG8_MMA(0, 0, At, B0); PG8_BAR; PG8_SCHED;
            PG8_LDB(B1, 1, 1); PG8_STAGE(PG8_SB(1, 0), b3, voffB);
            PG8_BAR; PG8_WAIT_L(0); PG8_MMA(0, 1, At, B1); PG8_BAR;
            PG8_LDA(At, 1, 1); PG8_STAGE(PG8_SA(1, 0), a3, voffA);
            PG8_BAR; PG8_WAIT_L(0); PG8_MMA(1, 0, At, B0); PG8_BAR; PG8_SCHED;
            PG8_STAGE(PG8_SB(1, 1), b3 + hstep, voffB);
            PG8_WAIT_V(6); PG8_BAR; PG8_MMA(1, 1, At, B1); PG8_BAR;
            }
        }
        if constexpr (ALIGN_EPI) { if (wr == 0) PG8_BAR; }
        if constexpr (!Epi::AFTER_DRAIN) { E(acc, cur, wr, wc, fr, fq); S.done(cur); }
        if (!has_next) break;
#pragma unroll
        for (int a = 0; a < 2; ++a)
#pragma unroll
            for (int b = 0; b < 2; ++b)
#pragma unroll
                for (int m = 0; m < 4; ++m)
#pragma unroll
                    for (int n = 0; n < 2; ++n) acc[a][b][m][n] = (f32x4){0.f, 0.f, 0.f, 0.f};
        cur = nxt; cA = nA; cB = nB; ++ui;
        if constexpr (ALIGN_EPI) { if (wr == 1) PG8_BAR; }
    }
    PG8_WAIT_V(0);
    if constexpr (!ALIGN_EPI) { if (wr == 0) PG8_BAR; }
    PG8_BAR;
    if constexpr (Epi::AFTER_DRAIN) { E.fused(acc, cur, wr, wc, fr, fq, lds, wid, lane); S.done(cur); }
#undef PG8_SA
#undef PG8_SB
#undef PG8_STAGE
#undef PG8_LDA
#undef PG8_LDB
#undef PG8_MMA
#undef PG8_WAIT_V
#undef PG8_WAIT_L
#undef PG8_BAR
#undef PG8_SCHED
}
}
#include <hip/hip_bf16.h>
#include <cmath>
namespace attn_body {
using bf16=__hip_bfloat16;
using bf16x8=__attribute__((ext_vector_type(8)))short;
using s16x4=__attribute__((ext_vector_type(4)))short;
using f32x16=__attribute__((ext_vector_type(16)))float;
using u32x4=__attribute__((ext_vector_type(4)))unsigned;
constexpr int BATCH=2,NHEAD=16,SEQ=4096,D=64,DM=10496,OPITCH=1024;
constexpr int NW=8,QBLK=32,QB=QBLK*NW,KVBLK=64,NQB=SEQ/QB;
constexpr int ATTN_PITCH=DM, ATTN_UNIT_ROWS=QB;
__device__ __forceinline__ int crow(int r,int hi){return (r&3)+8*(r>>2)+4*hi;}
#define SBAR() __builtin_amdgcn_sched_barrier(0)
__device__ __forceinline__ void cmask(f32x16&p0,f32x16&p1,int jb,int qrel,int hi){
  const float NEG=-INFINITY; int kb=64*jb+4*hi;
  #pragma unroll
  for(int r=0;r<16;++r){int kv=kb+(r&3)+8*(r>>2); if(kv>qrel)p0[r]=NEG; if(kv+32>qrel)p1[r]=NEG;}
}

constexpr int NSLOT=3, SLOTB=8192;
constexpr int LDS_K=0, LDS_V=NSLOT*SLOTB, LDS_WS=2*NSLOT*SLOTB, LDS_OST=LDS_WS+NW*64*4, LDS_MSK=LDS_OST+NW*4096, LDS_BYTES=LDS_MSK+NW*768;
constexpr float C2=0.125f*1.4426950408889634f;
__device__ __forceinline__ void glds16(const void*gsrc,unsigned lds_dst){unsigned keep;
  asm volatile("s_mov_b32 %0, m0\n\ts_mov_b32 m0, %2\n\ts_nop 0\n\tglobal_load_lds_dwordx4 %1, off\n\ts_mov_b32 m0, %0":"=&s"(keep):"v"(gsrc),"s"(lds_dst):"memory");}
__device__ __forceinline__ void glds4(const void*sbase,unsigned voff,unsigned lds_dst){unsigned keep;
  asm volatile("s_mov_b32 %0, m0\n\ts_mov_b32 m0, %3\n\ts_nop 4\n\tglobal_load_lds_dword %1, %2\n\ts_mov_b32 m0, %0":"=&s"(keep):"v"(voff),"s"(sbase),"s"(lds_dst):"memory");}
__device__ __forceinline__ float max3f(float a,float b,float c){float r;asm("v_max3_f32 %0, %1, %2, %3":"=v"(r):"v"(a),"v"(b),"v"(c));return r;}
__device__ __forceinline__ float max2f(float a,float b){float r;asm("v_max_f32_e32 %0, %1, %2":"=v"(r):"v"(a),"v"(b));return r;}
__device__ __forceinline__ float fadd_s(float a,float b){float r;asm("v_add_f32_e32 %0, %1, %2":"=v"(r):"v"(a),"v"(b));return r;}
__device__ __forceinline__ float fsub_s(float a,float b){float r;asm("v_sub_f32_e32 %0, %1, %2":"=v"(r):"v"(a),"v"(b));return r;}
typedef float f32x2_t __attribute__((ext_vector_type(2))); typedef __bf16 bf16x2_t __attribute__((ext_vector_type(2)));
__device__ __forceinline__ unsigned cvtpk_s(float lo,float hi){f32x2_t v={lo,hi};bf16x2_t b=__builtin_convertvector(v,bf16x2_t);return __builtin_bit_cast(unsigned,b);}
#define WAIT_BAR(N) asm volatile("s_waitcnt vmcnt(" #N ") lgkmcnt(0)\n\ts_barrier":::"memory")

__device__ __forceinline__ void qkt(f32x16&p0,f32x16&p1,const char*Kslot,const bf16x8*qr,const f32x16&negm,int r32,int hi){
  const char*kb=Kslot+hi*1024+r32*16;
  #pragma unroll
  for(int d0=0;d0<4;++d0){
    const bf16x8 b0=*reinterpret_cast<const bf16x8*>(kb+d0*2048);
    const bf16x8 b1=*reinterpret_cast<const bf16x8*>(kb+d0*2048+512);
    if(d0==0){p0=__builtin_amdgcn_mfma_f32_32x32x16_bf16(b0,qr[0],negm,0,0,0);p1=__builtin_amdgcn_mfma_f32_32x32x16_bf16(b1,qr[0],negm,0,0,0);}
    else{p0=__builtin_amdgcn_mfma_f32_32x32x16_bf16(b0,qr[d0],p0,0,0,0);p1=__builtin_amdgcn_mfma_f32_32x32x16_bf16(b1,qr[d0],p1,0,0,0);}}
}
typedef __attribute__((address_space(3))) const char* lds_cptr;
typedef short v4i16_t __attribute__((ext_vector_type(4)));
__device__ __forceinline__ void kload8(bf16x8*kf,lds_cptr kp){
  kf[0]=*(const __attribute__((address_space(3))) bf16x8*)(kp);      kf[1]=*(const __attribute__((address_space(3))) bf16x8*)(kp+512);
  kf[2]=*(const __attribute__((address_space(3))) bf16x8*)(kp+2048); kf[3]=*(const __attribute__((address_space(3))) bf16x8*)(kp+2560);
  kf[4]=*(const __attribute__((address_space(3))) bf16x8*)(kp+4096); kf[5]=*(const __attribute__((address_space(3))) bf16x8*)(kp+4608);
  kf[6]=*(const __attribute__((address_space(3))) bf16x8*)(kp+6144); kf[7]=*(const __attribute__((address_space(3))) bf16x8*)(kp+6656);
}
__device__ __forceinline__ void kload2(bf16x8*kf,lds_cptr kp,int j){ kf[2*j]=*(const __attribute__((address_space(3))) bf16x8*)(kp+j*2048); kf[2*j+1]=*(const __attribute__((address_space(3))) bf16x8*)(kp+j*2048+512); }
__device__ __forceinline__ s16x4 vtr(lds_cptr p){ return __builtin_bit_cast(s16x4,__builtin_amdgcn_ds_read_tr16_b64_v4i16((__attribute__((address_space(3))) v4i16_t*)p)); }
__device__ __forceinline__ float rowmax(const f32x16&p0,const f32x16&p1){
  float a=max3f(p0[0],p0[1],p1[0]),b=max3f(p0[2],p0[3],p1[1]);a=max3f(a,p1[2],p1[3]);
  #pragma unroll
  for(int r=4;r<16;r+=4){a=max3f(a,p0[r],p0[r+1]);b=max3f(b,p0[r+2],p0[r+3]);a=max3f(a,p1[r],p1[r+1]);b=max3f(b,p1[r+2],p1[r+3]);}
  const float m=max2f(a,b);
  auto rr=__builtin_amdgcn_permlane32_swap(__float_as_uint(m),__float_as_uint(m),false,false);
  return max2f(__uint_as_float(rr[0]),__uint_as_float(rr[1]));
}
__device__ __forceinline__ void pv(f32x16*o,int vb,bf16x8 pa0,bf16x8 pa1,bf16x8 pa2,bf16x8 pa3){
  #pragma unroll
  for(int d0=0;d0<2;++d0){s16x4 lo[4],hi[4];
    #pragma unroll
    for(int ks=0;ks<4;++ks){
      asm volatile("ds_read_b64_tr_b16 %0,%1 offset:%c2":"=&v"(lo[ks]):"v"(vb),"i"(d0*4096+ks*1024):"memory");
      asm volatile("ds_read_b64_tr_b16 %0,%1 offset:%c2":"=&v"(hi[ks]):"v"(vb),"i"(d0*4096+ks*1024+512):"memory");}
    asm volatile("s_waitcnt lgkmcnt(0)":::"memory");SBAR();
    #define PK(k) (bf16x8){lo[k][0],lo[k][1],lo[k][2],lo[k][3],hi[k][0],hi[k][1],hi[k][2],hi[k][3]}
    o[d0]=__builtin_amdgcn_mfma_f32_32x32x16_bf16(pa0,PK(0),o[d0],0,0,0);
    o[d0]=__builtin_amdgcn_mfma_f32_32x32x16_bf16(pa1,PK(1),o[d0],0,0,0);
    o[d0]=__builtin_amdgcn_mfma_f32_32x32x16_bf16(pa2,PK(2),o[d0],0,0,0);
    o[d0]=__builtin_amdgcn_mfma_f32_32x32x16_bf16(pa3,PK(3),o[d0],0,0,0);
    #undef PK
  }
}

#ifndef ATTN_STORE16
#define ATTN_STORE16(p,v) (*(u32x4*)(p)=(v))
#endif
template<int THRL> __device__ __forceinline__ void attn_unit(int b,int h,int qb,const bf16*Q,const bf16*K,const bf16*V,bf16*O,const unsigned*MASK32,char*shm){
  const int tid=threadIdx.x,lane=tid&63,r32=lane&31,hi=lane>>5; const int wid=__builtin_amdgcn_readfirstlane(tid>>6);
  const long rowbase=(long)b*SEQ; const int q0=qb*QB;
  const bf16*Qw=Q+(rowbase+q0+wid*QBLK)*DM+h*D;
  const bf16*Kh=K+rowbase*DM+h*D,*Vh=V+rowbase*DM+h*D;
  const unsigned lds0=(unsigned)(uintptr_t)shm;
  float*wsf=(float*)(shm+LDS_WS)+wid*64;
  const bf16*ksrc=Kh+(long)lane*DM+wid*8;
  const bf16*vsrc=Vh+(long)(16*(wid&3)+(lane>>2))*DM+(wid>>2)*32+(lane&3)*8;
  const unsigned kdst=lds0+LDS_K+wid*1024, vdst=lds0+LDS_V+wid*1024, mdst=lds0+LDS_MSK+wid*768;
  const unsigned*msrc=MASK32+(rowbase+q0+wid*QBLK)*128;
  #define DMA_M(t,slot) glds4(msrc+2*(t),(unsigned)((lane>>1)*512+(lane&1)*4),(unsigned)__builtin_amdgcn_readfirstlane(mdst+(slot)))
  #define MSK(v,w,bit) __uint_as_float(__float_as_uint(v)&(unsigned)__builtin_amdgcn_sbfe((int)(w),(bit),1))
  #define DMA_K(t,slot) glds16(ksrc+(long)(t)*KVBLK*DM,(unsigned)__builtin_amdgcn_readfirstlane(kdst+(slot)))
  #define DMA_V(t,slot) glds16(vsrc+(long)(t)*KVBLK*DM,(unsigned)__builtin_amdgcn_readfirstlane(vdst+(slot)))
  const int vb0=(int)(lds0+LDS_V)+((lane>>4)&1)*32+(lane&3)*8+(4*hi+((lane&15)>>2))*64;
  const char*Kbase=shm+LDS_K; bf16x8 kf[8];
  const lds_cptr shm3=(lds_cptr)shm; const lds_cptr kp0=shm3+LDS_K+hi*1024+r32*16; const lds_cptr vp0=shm3+LDS_V+((lane>>4)&1)*32+(lane&3)*8+(4*hi+((lane&15)>>2))*64;
  const lds_cptr mp0=shm3+LDS_MSK+wid*768+r32*8;
  const int NT=(q0+QB)/KVBLK;
  DMA_M(0,0);DMA_M(1,256);DMA_K(0,0);DMA_V(0,0);DMA_K(1,SLOTB);
  bf16x8 qr[4];
  #pragma unroll
  for(int d0=0;d0<4;++d0)qr[d0]=*reinterpret_cast<const bf16x8*>(&Qw[(long)r32*DM+d0*16+hi*8]);
  float mhat=0.f,l_reg=0.f;f32x16 o[2];o[0]=f32x16{};o[1]=f32x16{};f32x16 negm=f32x16{};asm volatile("":"+v"(negm));
  #define CMASK(P0,P1,t) do{}while(0)
  bool resc=false;
  #define START(P0,P1) do{ const float rm=rowmax(P0,P1); resc=false; \
    { const float dl=rm; mhat=fadd_s(mhat,dl); \
      _Pragma("unroll") for(int r=0;r<16;++r){P0[r]=fsub_s(P0[r],dl);P1[r]=fsub_s(P1[r],dl);} \
      _Pragma("unroll") for(int r=0;r<16;++r)negm[r]=-mhat; asm volatile("":"+v"(negm)); } \
    _Pragma("unroll") for(int r=0;r<16;++r)P0[r]=__builtin_amdgcn_exp2f(P0[r]); }while(0)
  #define RESC() do{ if(resc){ asm volatile("s_waitcnt lgkmcnt(0)":::"memory"); \
      _Pragma("unroll") for(int d_=0;d_<2;++d_) _Pragma("unroll") for(int r=0;r<16;++r)o[d_][r]*=wsf[crow(r,hi)]; } }while(0)
  f32x16 pA0,pA1,pB0,pB1;
  int sl_prev=0,sl_cur=0,sl_next=SLOTB;
  #define ROT() do{sl_prev=sl_cur;sl_cur=sl_next;sl_next=(sl_next==(NSLOT-1)*SLOTB)?0:sl_next+SLOTB;}while(0)
  DMA_K(2,2*SLOTB);
  WAIT_BAR(3);
  qkt(pA0,pA1,Kbase,qr,negm,r32,hi);asm volatile("s_nop 15\n\ts_nop 7":"+v"(pA0),"+v"(pA1));CMASK(pA0,pA1,0);
  START(pA0,pA1);
  _Pragma("unroll") for(int r=0;r<16;++r)pA1[r]=__builtin_amdgcn_exp2f(pA1[r]);
  { const unsigned long long mw_=*(const __attribute__((address_space(3))) unsigned long long*)(mp0); const unsigned mlo_=(unsigned)mw_>>(4*hi), mhi_=(unsigned)(mw_>>32)>>(4*hi);
    _Pragma("unroll") for(int r=0;r<16;++r){ pA0[r]=MSK(pA0[r],mlo_,(r&3)+8*(r>>2)); pA1[r]=MSK(pA1[r],mhi_,(r&3)+8*(r>>2)); } }
  WAIT_BAR(0);
  DMA_K(3,0);DMA_V(1,SLOTB);DMA_M(2,512);
  ROT();
  kload8(kf,kp0+sl_cur);
  WAIT_BAR(3);
  s16x4 vlo[8],vhi[8]; u32x4 pw0,pw1,pw2,pw3;
  #define PKW(P,B) cvtpk_s(P[B],P[B+1])
  #define PAF(k) __builtin_bit_cast(bf16x8,pw##k)
  #define VFR(i) (bf16x8){vlo[i][0],vlo[i][1],vlo[i][2],vlo[i][3],vhi[i][0],vhi[i][1],vhi[i][2],vhi[i][3]}
  #define PIN(x) asm volatile("":"+v"(x))
  #define MX3(a,b,c) __builtin_fmaxf(__builtin_fmaxf((a),(b)),(c))
  #define GAPA(MF,A0,A1,A2,A3,W0,W1,PW) do{ MF; sacc+=A0; sacc+=A1; sacc+=A2; sacc+=A3; PIN(sacc); W0; W1; PIN(PW); SBAR(); }while(0)
  #define EX(v) __builtin_amdgcn_exp2f(v)
  #define GAPB(MF,X,B,MW) do{ MF; X[B]=MSK(EX(X[B]),MW,2*(B)); X[B+1]=MSK(EX(X[B+1]),MW,2*(B)+1); X[B+2]=MSK(EX(X[B+2]),MW,2*(B)+2); X[B+3]=MSK(EX(X[B+3]),MW,2*(B)+3); PIN(X); SBAR(); }while(0)
  #define VRD(i) do{ vlo[i]=vtr(vp_+(((i)>>2)*4096+((i)&3)*1024)); vhi[i]=vtr(vp_+(((i)>>2)*4096+((i)&3)*1024+512)); }while(0)
  #define KRD(G,j) do{ if(G){ kload2(kf,kp0+sl_next,j); SBAR(); } }while(0)
  #define STEP(C0,C1,P0,P1,t,GK,GV,GL,GM) do{ SBAR(); \
    const lds_cptr vp_=vp0+sl_prev; \
    VRD(0); SBAR(); float sacc=(P0[0]+P0[1]); \
    GAPA(C0=__builtin_amdgcn_mfma_f32_32x32x16_bf16(kf[0],qr[0],negm,0,0,0), P0[2],P0[3],P0[4],P0[5],     pw0[0]=PKW(P0,0), pw0[1]=PKW(P0,2), pw0); \
    VRD(4); SBAR(); GAPA(C1=__builtin_amdgcn_mfma_f32_32x32x16_bf16(kf[1],qr[0],negm,0,0,0), P0[6],P0[7],P0[8],P0[9],     pw0[2]=PKW(P0,4), pw0[3]=PKW(P0,6), pw0); \
    VRD(1); SBAR(); GAPA(C0=__builtin_amdgcn_mfma_f32_32x32x16_bf16(kf[2],qr[1],C0,0,0,0),   P0[10],P0[11],P0[12],P0[13], pw1[0]=PKW(P0,8), pw1[1]=PKW(P0,10), pw1); \
    VRD(5); SBAR(); GAPA(C1=__builtin_amdgcn_mfma_f32_32x32x16_bf16(kf[3],qr[1],C1,0,0,0),   P0[14],P0[15],P1[0],P1[1],   pw1[2]=PKW(P0,12),pw1[3]=PKW(P0,14), pw1); \
    VRD(2); SBAR(); GAPA(C0=__builtin_amdgcn_mfma_f32_32x32x16_bf16(kf[4],qr[2],C0,0,0,0),   P1[2],P1[3],P1[4],P1[5],     pw2[0]=PKW(P1,0), pw2[1]=PKW(P1,2), pw2); \
    VRD(6); SBAR(); GAPA(C1=__builtin_amdgcn_mfma_f32_32x32x16_bf16(kf[5],qr[2],C1,0,0,0),   P1[6],P1[7],P1[8],P1[9],     pw2[2]=PKW(P1,4), pw2[3]=PKW(P1,6), pw2); \
    VRD(3); SBAR(); GAPA(C0=__builtin_amdgcn_mfma_f32_32x32x16_bf16(kf[6],qr[3],C0,0,0,0),   P1[10],P1[11],P1[12],P1[13], pw3[0]=PKW(P1,8), pw3[1]=PKW(P1,10), pw3); \
    VRD(7); SBAR(); GAPA(C1=__builtin_amdgcn_mfma_f32_32x32x16_bf16(kf[7],qr[3],C1,0,0,0),   P1[14],P1[15],0.f,0.f,       pw3[2]=PKW(P1,12),pw3[3]=PKW(P1,14), pw3); \
    l_reg+=sacc; \
    const unsigned long long mw_=*(const __attribute__((address_space(3))) unsigned long long*)(mp0+(sl_cur>>5)); \
    if(GK){DMA_K((t)+3,sl_cur);} if(GV){DMA_V((t)+1,sl_next);} if(GM){DMA_M((t)+2,sl_prev>>5);} \
    const unsigned mlo_=(unsigned)mw_>>(4*hi), mhi_=(unsigned)(mw_>>32)>>(4*hi); \
    { float a=MX3(C0[0],C0[1],C1[0]),b=MX3(C0[2],C0[3],C1[1]); a=MX3(a,C1[2],C1[3]); \
      _Pragma("unroll") for(int r=4;r<16;r+=4){a=MX3(a,C0[r],C0[r+1]);b=MX3(b,C0[r+2],C0[r+3]);a=MX3(a,C1[r],C1[r+1]);b=MX3(b,C1[r+2],C1[r+3]);} \
      float rm=__builtin_fmaxf(a,b); { auto rr=__builtin_amdgcn_permlane32_swap(__float_as_uint(rm),__float_as_uint(rm),false,false); rm=__builtin_fmaxf(__uint_as_float(rr[0]),__uint_as_float(rr[1])); } \
      resc=false; \
      if(__builtin_expect(__any(rm>(float)THRL),0)){ const float dl=__builtin_fmaxf(rm,0.f); mhat+=dl; \
        _Pragma("unroll") for(int r=0;r<16;++r){C0[r]-=dl;C1[r]-=dl;} \
        _Pragma("unroll") for(int r=0;r<16;++r)negm[r]=-mhat; asm volatile("":"+v"(negm)); \
        const float f=__builtin_amdgcn_exp2f(-dl); l_reg*=f; if(hi==0)wsf[r32]=f; resc=true; } } \
    SBAR(); \
    GAPB(o[0]=__builtin_amdgcn_mfma_f32_32x32x16_bf16(PAF(0),VFR(0),o[0],0,0,0), C0,0,mlo_); \
    GAPB(o[1]=__builtin_amdgcn_mfma_f32_32x32x16_bf16(PAF(0),VFR(4),o[1],0,0,0), C0,4,mlo_); \
    KRD(GL,0); GAPB(o[0]=__builtin_amdgcn_mfma_f32_32x32x16_bf16(PAF(1),VFR(1),o[0],0,0,0), C0,8,mlo_); \
    KRD(GL,1); GAPB(o[1]=__builtin_amdgcn_mfma_f32_32x32x16_bf16(PAF(1),VFR(5),o[1],0,0,0), C0,12,mlo_); \
    KRD(GL,2); GAPB(o[0]=__builtin_amdgcn_mfma_f32_32x32x16_bf16(PAF(2),VFR(2),o[0],0,0,0), C1,0,mhi_); \
    KRD(GL,3); GAPB(o[1]=__builtin_amdgcn_mfma_f32_32x32x16_bf16(PAF(2),VFR(6),o[1],0,0,0), C1,4,mhi_); \
    GAPB(o[0]=__builtin_amdgcn_mfma_f32_32x32x16_bf16(PAF(3),VFR(3),o[0],0,0,0), C1,8,mhi_); \
    GAPB(o[1]=__builtin_amdgcn_mfma_f32_32x32x16_bf16(PAF(3),VFR(7),o[1],0,0,0), C1,12,mhi_); \
    }while(0)
  int t=1;
  for(;t+5<NT;t+=2){
    STEP(pB0,pB1,pA0,pA1,t,true,true,true,true);     WAIT_BAR(3); RESC(); ROT();
    STEP(pA0,pA1,pB0,pB1,t+1,true,true,true,true);   WAIT_BAR(3); RESC(); ROT();
  }
  #define ENDW(tt) do{ if((tt)+3<NT){WAIT_BAR(3);} else if((tt)+2<NT){WAIT_BAR(2);} else {WAIT_BAR(0);} }while(0)
  for(;t+1<NT;t+=2){
    STEP(pB0,pB1,pA0,pA1,t,(t+3<NT),(t+1<NT),(t+1<NT),(t+2<NT));       ENDW(t);   RESC(); ROT();
    STEP(pA0,pA1,pB0,pB1,t+1,(t+4<NT),(t+2<NT),(t+2<NT),(t+3<NT));     ENDW(t+1); RESC(); ROT();
  }
  STEP(pB0,pB1,pA0,pA1,NT-1,false,false,false,false); RESC();
  { float sacc=pB0[0]+pB0[1]; _Pragma("unroll") for(int r=2;r<16;++r)sacc+=pB0[r]; _Pragma("unroll") for(int r=0;r<16;++r)sacc+=pB1[r]; l_reg+=sacc;
    pw0=(u32x4){PKW(pB0,0),PKW(pB0,2),PKW(pB0,4),PKW(pB0,6)};pw1=(u32x4){PKW(pB0,8),PKW(pB0,10),PKW(pB0,12),PKW(pB0,14)};pw2=(u32x4){PKW(pB1,0),PKW(pB1,2),PKW(pB1,4),PKW(pB1,6)};pw3=(u32x4){PKW(pB1,8),PKW(pB1,10),PKW(pB1,12),PKW(pB1,14)};
    SBAR(); pv(o,vb0+sl_cur,PAF(0),PAF(1),PAF(2),PAF(3)); }
  #undef PKW
  #undef PAF
  #undef VFR
  #undef PIN
  #undef MX3
  #undef GAPA
  #undef GAPB
  #undef EX
  #undef VRD
  #undef KRD
  #undef STEP
  #undef ENDW
  {auto rr=__builtin_amdgcn_permlane32_swap(__float_as_uint(l_reg),__float_as_uint(l_reg),false,false);l_reg=__uint_as_float(rr[0])+__uint_as_float(rr[1]);}
  if(hi==0)wsf[32+r32]=l_reg;asm volatile("s_waitcnt lgkmcnt(0)":::"memory");
  float rli[16];
  #pragma unroll
  for(int r=0;r<16;++r)rli[r]=__builtin_amdgcn_rcpf(wsf[32+crow(r,hi)]);
  bf16*Ow=O+(rowbase+q0+wid*QBLK)*OPITCH+h*D;
  { bf16*stg=(bf16*)(shm+LDS_OST)+wid*2048;
    #pragma unroll
    for(int r=0;r<16;++r){const int orow=crow(r,hi);
      #pragma unroll
      for(int d0=0;d0<2;++d0)stg[orow*64+d0*32+r32]=__float2bfloat16(o[d0][r]*rli[r]);}
    asm volatile("s_waitcnt lgkmcnt(0)":::"memory");
    #pragma unroll
    for(int i=0;i<4;++i){const int row=i*8+(lane>>3),ch=lane&7; const u32x4 v=*(const u32x4*)(stg+row*64+ch*8); ATTN_STORE16(Ow+(long)row*OPITCH+ch*8,v);} }
  asm volatile("s_waitcnt lgkmcnt(0)\n\ts_barrier":::"memory");
  #undef DMA_K
  #undef DMA_V
  #undef DMA_M
  #undef MSK
  #undef CMASK
  #undef START
  #undef RESC
  #undef ROT
}
constexpr int ATTN_LDS_BYTES=LDS_BYTES;
struct AttnTensors { const bf16* Q; const bf16* K; const bf16* V; bf16* O; const unsigned* MASK32; };
struct AttnUnit { int bh; int qb; };
struct StaticOrder {
  int vcu, G;
  __device__ __forceinline__ explicit StaticOrder(int grid,int block):vcu((grid%8==0)?(block%8)*(grid/8)+block/8:block),G(grid){}
  __device__ __forceinline__ bool next(int i,AttnUnit&u)const{ const int p=vcu+(i>>1)*G; if(p>=256)return false; const int s=p&7; u.bh=p>>3; u.qb=(i&1)?15-s:s; return true; }
  __device__ __forceinline__ void a_ready(const AttnUnit&)const{}
  __device__ __forceinline__ void done(const AttnUnit&)const{}
};
template<class Sched,int THRL=8> __device__ __forceinline__ void attn_phase(char*lds,const AttnTensors&T,const Sched&S){
  AttnUnit u;
  for(int i=0;S.next(i,u);++i){ S.a_ready(u); attn_unit<THRL>(u.bh/NHEAD,u.bh%NHEAD,u.qb,T.Q,T.K,T.V,T.O,T.MASK32,lds); S.done(u); }
}
#undef SBAR
#undef WAIT_BAR
}
#define GAS __attribute__((address_space(1)))
#define LAS __attribute__((address_space(3)))
typedef unsigned short bf16;
typedef unsigned v4u __attribute__((ext_vector_type(4)));
typedef float f32x4 __attribute__((ext_vector_type(4)));
typedef short bf16x8 __attribute__((ext_vector_type(8)));
typedef GAS unsigned gu32;
typedef GAS unsigned long long gu64;
#define RLX_AGENT __ATOMIC_RELAXED, __HIP_MEMORY_SCOPE_AGENT
#define LDS_WAIT() asm volatile("s_waitcnt lgkmcnt(0)" ::: "memory")
#define VM_WAIT() asm volatile("s_waitcnt vmcnt(0)" ::: "memory")
__device__ __forceinline__ unsigned long long rt() { return __builtin_amdgcn_s_memrealtime(); }
__device__ __forceinline__ unsigned f2bf(float f) { unsigned u = __builtin_bit_cast(unsigned, f); return (u + 0x7fffu + ((u >> 16) & 1u)) >> 16; }
__device__ __forceinline__ unsigned pk2(float lo, float hi) { return f2bf(lo) | (f2bf(hi) << 16); }
#define XB_TMO      128
#define XB_XCNT(j)  (256  + 64 * (j))
#define XB_XSUB(j)  (1280 + 64 * (j))
#define XB_XGEN(j)  (2304 + 64 * (j))
#define XB_TOP      3328
#define XB_TOPGEN   3392
#define XCD_BAR_WORDS 3456
#define XB_SPIN_CAP (1u << 18)

__device__ __forceinline__ unsigned xb_ld(unsigned* p)              { return __hip_atomic_load(p, __ATOMIC_RELAXED, __HIP_MEMORY_SCOPE_AGENT); }
__device__ __forceinline__ unsigned xb_add(unsigned* p, unsigned v) { return __hip_atomic_fetch_add(p, v, __ATOMIC_RELAXED, __HIP_MEMORY_SCOPE_AGENT); }
__device__ __forceinline__ unsigned xb_xcc_id() { return (unsigned)__builtin_amdgcn_s_getreg((3 << 11) | 20) & 0xFu; }
#define XB_SPIN(cond, bar) do { unsigned _sp = 0; while (cond) { __builtin_amdgcn_s_sleep(1); \
    if ((++_sp & 255u) == 0u) { if (xb_ld(&(bar)[XB_TMO])) break; if (_sp > XB_SPIN_CAP) { atomicAdd(&(bar)[XB_TMO], 1u); break; } } } } while (0)

struct XcdBarrier {
    unsigned* bar; unsigned x;
    volatile LAS unsigned* st;
};

__device__ __forceinline__ XcdBarrier xcd_barrier_post(unsigned* bar, volatile LAS unsigned* st) {
    XcdBarrier b; b.bar = bar; b.x = xb_xcc_id(); b.st = st;
    if (threadIdx.x == 0) (void)xb_add(&bar[XB_XCNT(b.x)], 1u);
    return b;
}
__device__ __forceinline__ void xcd_barrier_complete(unsigned* bar, unsigned x, unsigned& nloc, unsigned& nx) {
    const unsigned G = gridDim.x * gridDim.y * gridDim.z;
    unsigned sum, cnt, mine, sp = 0u;
    for (;;) {
        sum = 0u; cnt = 0u; mine = 0u;
#pragma unroll
        for (unsigned j = 0; j < 16; ++j) { const unsigned c = xb_ld(&bar[XB_XCNT(j)]); sum += c; cnt += (c > 0u) ? 1u : 0u; mine = (j == x) ? c : mine; }
        if (sum == G) break;
        __builtin_amdgcn_s_sleep(1);
        if ((++sp & 255u) == 0u) { if (xb_ld(&bar[XB_TMO])) break; if (sp > XB_SPIN_CAP) { atomicAdd(&bar[XB_TMO], 1u); break; } }
    }
    nloc = mine > 0u ? mine : 1u; nx = cnt > 0u ? cnt : 1u;
}

__device__ __forceinline__ void xcd_barrier(const XcdBarrier& b) {
    asm volatile("s_waitcnt vmcnt(0)" ::: "memory");
    __syncthreads();
    if (threadIdx.x == 0) {
        unsigned* bar = b.bar;
        __builtin_amdgcn_s_waitcnt(0);
        unsigned nloc = b.st[0], nx = b.st[1];
        if (nloc == 0u) { xcd_barrier_complete(bar, b.x, nloc, nx); b.st[0] = nloc; b.st[1] = nx; }
        const unsigned old = xb_add(&bar[XB_XSUB(b.x)], 1u);
        const unsigned gen = old / nloc;
        if (old + 1u == (gen + 1u) * nloc) {
            __builtin_amdgcn_fence(__ATOMIC_RELEASE, "agent");
            asm volatile("s_waitcnt vmcnt(0)" ::: "memory");
            const unsigned og = xb_add(&bar[XB_TOP], 1u);
            const unsigned tg = og / nx;
            if (og + 1u == (tg + 1u) * nx) xb_add(&bar[XB_TOPGEN], 1u);
            else XB_SPIN(xb_ld(&bar[XB_TOPGEN]) == tg, bar);
            __builtin_amdgcn_fence(__ATOMIC_ACQUIRE, "agent");
            xb_add(&bar[XB_XGEN(b.x)], 1u);
            asm volatile("s_waitcnt vmcnt(0)" ::: "memory");
        } else {
            XB_SPIN(xb_ld(&bar[XB_XGEN(b.x)]) == gen, bar);
            __builtin_amdgcn_fence(__ATOMIC_ACQUIRE, "agent");
            asm volatile("s_waitcnt vmcnt(0)" ::: "memory");
        }
    }
    __syncthreads();
}
#ifndef DUP_SUB
#define DUP_SUB 0
#endif
constexpr int NWAVES = 8;
constexpr int DM = 2048, NBATCH = 2, SEQ = 4096, MTOK = NBATCH * SEQ;
constexpr int DCONV = 1024, CONVW = 31, NHEAD = 16, HDIM = 64, TOPK = 256, DFF = 5632;
constexpr int OFF_GLU = 0, OFF_Q = 2048, OFF_K = 3072, OFF_V = 4096, OFF_QI = 5120, OFF_KI = 6144, OFF_WI = 6208, OFF_G = 6224, D_IN = 10320;
constexpr int NP = 10496;
constexpr int NGU = 2 * DFF;
constexpr int KSPLIT = 8, NMOD = 6 * DM;
constexpr float EPS = 1e-6f;
constexpr float LOG2E = 1.4426950408889634f;

constexpr size_t MiB = 1u << 20;
constexpr size_t WS_CTL = 0, CTL_ZERO_BYTES = 1 * MiB;
constexpr size_t WS_MODP = 1 * MiB;
constexpr size_t WS_MODF = 4 * MiB;
constexpr size_t WS_BT_GU = 5 * MiB;
constexpr size_t WS_BT_DN = 49 * MiB;
constexpr size_t WS_BT_O = 71 * MiB;
constexpr size_t WS_BT_CO = 79 * MiB;
constexpr size_t WS_BT_AO = 83 * MiB;
constexpr size_t WS_BT_IN = 87 * MiB;
constexpr size_t WS_H = 128 * MiB;
constexpr size_t WS_PROJ = 160 * MiB;
constexpr size_t WS_CACT = 324 * MiB;
constexpr size_t WS_AOUT = 340 * MiB;
constexpr size_t WS_VT = 356 * MiB;
constexpr size_t WS_MASK = 372 * MiB;
constexpr size_t WS_END = 376 * MiB;
constexpr size_t WS_SCORES = 87 * MiB;
constexpr size_t WS_MERGED = 96 * MiB;
constexpr size_t WS_GU = 160 * MiB;
constexpr size_t WS_F = 248 * MiB;
constexpr int CW_BAR = 4096;

constexpr int RING_OFF = 0, RING_BYTES = 131072;
constexpr int LDSCTL_OFF = RING_BYTES, MISC_OFF = LDSCTL_OFF + 320;
constexpr int LDS_BYTES = 147456;

typedef float f32x16 __attribute__((ext_vector_type(16)));
typedef float f32x2v __attribute__((ext_vector_type(2)));
typedef unsigned u32x2v __attribute__((ext_vector_type(2)));

__device__ __forceinline__ float bf_lo(unsigned u) { return __builtin_bit_cast(float, u << 16); }
__device__ __forceinline__ float bf_hi(unsigned u) { return __builtin_bit_cast(float, u & 0xffff0000u); }
__device__ __forceinline__ float sigmoidf_fast(float v) { return __builtin_amdgcn_rcpf(1.0f + __builtin_amdgcn_exp2f(-v * LOG2E)); }
__device__ __forceinline__ float wave_sum(float v) {
#pragma unroll
    for (int o = 1; o < 64; o <<= 1) v += __shfl_xor(v, o);
    return v;
}

struct EpiStoreBf16 {
    static constexpr bool PERM = true, AFTER_DRAIN = false;
    bf16* O; int ldc; int q_lo, q_hi; float qscale;
    __device__ __forceinline__ void operator()(const f32x4 (&acc)[2][2][4][2], const pg8::Unit& u, int wr, int wc, int fr, int fq) const {
        const int row0 = u.pm * pg8::BM + wr * 64 + fr, colt = u.pn * pg8::BM, col0 = colt + wc * 32 + 8 * fq;
        const float sc = (colt >= q_lo && colt < q_hi) ? qscale : 1.0f;
#pragma unroll
        for (int ai = 0; ai < 2; ++ai)
#pragma unroll
            for (int m = 0; m < 4; ++m) { bf16* rowp = O + (size_t)(row0 + ai * pg8::HALF + m * 16) * ldc + col0;
#pragma unroll
                for (int bj = 0; bj < 2; ++bj) { const f32x4 v0 = acc[ai][bj][m][0] * sc, v1 = acc[ai][bj][m][1] * sc;
                    v4u w; w.x = pg8::cvt_pk_bf16(v0[0], v0[1]); w.y = pg8::cvt_pk_bf16(v0[2], v0[3]); w.z = pg8::cvt_pk_bf16(v1[0], v1[1]); w.w = pg8::cvt_pk_bf16(v1[2], v1[3]);
                    *(v4u*)(rowp + bj * pg8::HALF) = w; } }
    }
};
struct EpiStoreF32 {
    static constexpr bool PERM = false, AFTER_DRAIN = false;
    float* C; int ldc;
    __device__ __forceinline__ void operator()(const f32x4 (&acc)[2][2][4][2], const pg8::Unit& u, int wr, int wc, int fr, int fq) const {
        const int row0 = u.pm * pg8::BM + wr * 64 + fr, col0 = u.pn * pg8::BM + wc * 32 + 4 * fq;
#pragma unroll
        for (int ai = 0; ai < 2; ++ai)
#pragma unroll
            for (int m = 0; m < 4; ++m) { float* rowp = C + (size_t)(row0 + ai * pg8::HALF + m * 16) * ldc + col0;
#pragma unroll
                for (int bj = 0; bj < 2; ++bj)
#pragma unroll
                    for (int n = 0; n < 2; ++n) *(f32x4*)(rowp + bj * pg8::HALF + n * 16) = acc[ai][bj][m][n]; }
    }
};
struct EpiGateConv {
    static constexpr bool PERM = true, AFTER_DRAIN = false;
    float* C; const bf16* G; int ldg;
    __device__ __forceinline__ void operator()(const f32x4 (&acc)[2][2][4][2], const pg8::Unit& u, int wr, int wc, int fr, int fq) const {
        const int row0 = u.pm * pg8::BM + wr * 64 + fr, col0 = u.pn * pg8::BM + wc * 32 + 8 * fq;
#pragma unroll
        for (int ai = 0; ai < 2; ++ai)
#pragma unroll
            for (int m = 0; m < 4; ++m) { const int row = row0 + ai * pg8::HALF + m * 16; float* rowp = C + (size_t)row * DM + col0; const bf16* gp = G + (size_t)row * ldg + col0;
#pragma unroll
                for (int bj = 0; bj < 2; ++bj) { const v4u g = *(const v4u*)(gp + bj * pg8::HALF); const f32x4 a0 = acc[ai][bj][m][0], a1 = acc[ai][bj][m][1];
                    f32x4 o0, o1;
                    o0[0] = a0[0] * sigmoidf_fast(bf_lo(g.x)); o0[1] = a0[1] * sigmoidf_fast(bf_hi(g.x)); o0[2] = a0[2] * sigmoidf_fast(bf_lo(g.y)); o0[3] = a0[3] * sigmoidf_fast(bf_hi(g.y));
                    o1[0] = a1[0] * sigmoidf_fast(bf_lo(g.z)); o1[1] = a1[1] * sigmoidf_fast(bf_hi(g.z)); o1[2] = a1[2] * sigmoidf_fast(bf_lo(g.w)); o1[3] = a1[3] * sigmoidf_fast(bf_hi(g.w));
                    *(f32x4*)(rowp + bj * pg8::HALF) = o0; *(f32x4*)(rowp + bj * pg8::HALF + 4) = o1; } }
    }
};
struct EpiGateAttn {
    static constexpr bool PERM = true, AFTER_DRAIN = false;
    const float* T; const bf16* G; int ldg; bf16* O;
    __device__ __forceinline__ void operator()(const f32x4 (&acc)[2][2][4][2], const pg8::Unit& u, int wr, int wc, int fr, int fq) const {
        const int row0 = u.pm * pg8::BM + wr * 64 + fr, col0 = u.pn * pg8::BM + wc * 32 + 8 * fq;
#pragma unroll
        for (int ai = 0; ai < 2; ++ai)
#pragma unroll
            for (int m = 0; m < 4; ++m) { const int row = row0 + ai * pg8::HALF + m * 16; const float* tp = T + (size_t)row * DM + col0; const bf16* gp = G + (size_t)row * ldg + col0; bf16* op = O + (size_t)row * DM + col0;
#pragma unroll
                for (int bj = 0; bj < 2; ++bj) { const v4u g = *(const v4u*)(gp + bj * pg8::HALF); const f32x4 t0 = *(const f32x4*)(tp + bj * pg8::HALF), t1 = *(const f32x4*)(tp + bj * pg8::HALF + 4);
                    const f32x4 a0 = acc[ai][bj][m][0], a1 = acc[ai][bj][m][1];
                    const float o0 = t0[0] + a0[0] * sigmoidf_fast(bf_lo(g.x)), o1 = t0[1] + a0[1] * sigmoidf_fast(bf_hi(g.x)), o2 = t0[2] + a0[2] * sigmoidf_fast(bf_lo(g.y)), o3 = t0[3] + a0[3] * sigmoidf_fast(bf_hi(g.y));
                    const float o4 = t1[0] + a1[0] * sigmoidf_fast(bf_lo(g.z)), o5 = t1[1] + a1[1] * sigmoidf_fast(bf_hi(g.z)), o6 = t1[2] + a1[2] * sigmoidf_fast(bf_lo(g.w)), o7 = t1[3] + a1[3] * sigmoidf_fast(bf_hi(g.w));
                    v4u w; w.x = pg8::cvt_pk_bf16(o0, o1); w.y = pg8::cvt_pk_bf16(o2, o3); w.z = pg8::cvt_pk_bf16(o4, o5); w.w = pg8::cvt_pk_bf16(o6, o7);
                    *(v4u*)(op + bj * pg8::HALF) = w; } }
    }
};
struct EpiSwiGLU {
    static constexpr bool PERM = true, AFTER_DRAIN = false;
    bf16* O;
    __device__ __forceinline__ void operator()(const f32x4 (&acc)[2][2][4][2], const pg8::Unit& u, int wr, int wc, int fr, int fq) const {
        const int row0 = u.pm * pg8::BM + wr * 64 + fr, col0 = (u.pn * pg8::BM + wc * 32 + 8 * fq) >> 1;
#pragma unroll
        for (int ai = 0; ai < 2; ++ai)
#pragma unroll
            for (int m = 0; m < 4; ++m) { bf16* rowp = O + (size_t)(row0 + ai * pg8::HALF + m * 16) * DFF + col0;
#pragma unroll
                for (int bj = 0; bj < 2; ++bj) { const f32x4 g = acc[ai][bj][m][0], up = acc[ai][bj][m][1];
                    const float h0 = g[0] * sigmoidf_fast(g[0]) * up[0], h1 = g[1] * sigmoidf_fast(g[1]) * up[1], h2 = g[2] * sigmoidf_fast(g[2]) * up[2], h3 = g[3] * sigmoidf_fast(g[3]) * up[3];
                    u32x2v w; w.x = pg8::cvt_pk_bf16(h0, h1); w.y = pg8::cvt_pk_bf16(h2, h3);
                    *(u32x2v*)(rowp + bj * (pg8::HALF / 2)) = w; } }
    }
};

struct Frame {
    LAS unsigned char* lds;
    volatile LAS unsigned* MISC;
    gu32* ctl;
    int tid, lane, wave, G, bid;
    float* out; unsigned char* ws;
};
template <int K> __device__ __forceinline__ const float* kin() {
    unsigned long long v;
    asm volatile("s_load_dwordx2 %0, %1, %2\n\ts_waitcnt lgkmcnt(0)" : "=s"(v) : "s"(__builtin_amdgcn_kernarg_segment_ptr()), "i"(8 * K));
    return (const float*)(const GAS float*)v;
}
enum { I_X = 0, I_C, I_WADA, I_BADA, I_GPREMIX, I_WIN, I_WDW, I_BDW, I_GLN, I_BLN, I_WCO, I_WAO, I_WO, I_GPOSTMIX, I_GPREFFN, I_WGATE, I_WUP, I_WDOWN, I_GPOSTFFN };

template <int MODE>
__device__ __forceinline__ void p0_transpose_item(const float* W, int K, int N, bf16* WT, int row_off, int item, int lane) {
    const int nblk = (N + 63) / 64, kb = item / nblk, nb = item % nblk, k0 = 64 * kb, gn = 64 * nb + lane;
    const bool ok = gn < N; const int gc = ok ? gn : N - 1;
    float v[64];
#pragma unroll
    for (int i = 0; i < 64; ++i) { const float* rowp = W + (size_t)(k0 + i) * N; v[i] = __builtin_nontemporal_load(rowp + gc); }
    if (ok) { const int dr = (MODE == 0) ? (row_off + gn) : (8 * (gn >> 2) + (gn & 3) + row_off);
        GAS v4u* dst = (GAS v4u*)(WT + (size_t)dr * K + k0);
#pragma unroll
        for (int j = 0; j < 8; ++j) { v4u o; o.x = pk2(v[8 * j], v[8 * j + 1]); o.y = pk2(v[8 * j + 2], v[8 * j + 3]); o.z = pk2(v[8 * j + 4], v[8 * j + 5]); o.w = pk2(v[8 * j + 6], v[8 * j + 7]); dst[j] = o; } }
}
constexpr int P0_I_IN = (DM / 64) * ((D_IN + 63) / 64), P0_I_GT = (DM / 64) * (DFF / 64), P0_I_DN = (DFF / 64) * (DM / 64), P0_I_O = (DM / 64) * (DM / 64), P0_I_CO = (DCONV / 64) * (DM / 64);
constexpr int P0_NITEMS = P0_I_IN + 2 * P0_I_GT + P0_I_DN + P0_I_O + 2 * P0_I_CO;
__device__ __forceinline__ void p0_item(Frame& F, int it) {
    bf16* bt_in = (bf16*)(F.ws + WS_BT_IN); bf16* bt_gu = (bf16*)(F.ws + WS_BT_GU); bf16* bt_dn = (bf16*)(F.ws + WS_BT_DN);
    bf16* bt_o = (bf16*)(F.ws + WS_BT_O); bf16* bt_co = (bf16*)(F.ws + WS_BT_CO); bf16* bt_ao = (bf16*)(F.ws + WS_BT_AO);
    int r = it;
    if (r < P0_I_IN) { p0_transpose_item<0>(kin<I_WIN>(), DM, D_IN, bt_in, 0, r, F.lane); return; } r -= P0_I_IN;
    if (r < P0_I_GT) { p0_transpose_item<1>(kin<I_WGATE>(), DM, DFF, bt_gu, 0, r, F.lane); return; } r -= P0_I_GT;
    if (r < P0_I_GT) { p0_transpose_item<1>(kin<I_WUP>(), DM, DFF, bt_gu, 4, r, F.lane); return; } r -= P0_I_GT;
    if (r < P0_I_DN) { p0_transpose_item<0>(kin<I_WDOWN>(), DFF, DM, bt_dn, 0, r, F.lane); return; } r -= P0_I_DN;
    if (r < P0_I_O) { p0_transpose_item<0>(kin<I_WO>(), DM, DM, bt_o, 0, r, F.lane); return; } r -= P0_I_O;
    if (r < P0_I_CO) { p0_transpose_item<0>(kin<I_WCO>(), DCONV, DM, bt_co, 0, r, F.lane); return; } r -= P0_I_CO;
    p0_transpose_item<0>(kin<I_WAO>(), DCONV, DM, bt_ao, 0, r, F.lane);
}
__device__ __forceinline__ void p0_prologue(Frame& F) {
    const int gw = F.bid * NWAVES + F.wave, NGW = F.G * NWAVES;
    constexpr int NGEMV = KSPLIT * (NMOD / 64);
    {
        const float* c = kin<I_C>(); const float* wada = kin<I_WADA>(); float* modp = (float*)(F.ws + WS_MODP);
        for (int unit = gw; unit < NGEMV; unit += NGW) {
            const int ks = unit / (NMOD / 64), nt = unit % (NMOD / 64), k0 = (DM / KSPLIT) * ks, col = 64 * nt + F.lane;
            float a0 = 0.f, a1 = 0.f;
            for (int kq = 0; kq < DM / KSPLIT; kq += 64) {
                const float c0 = c[k0 + kq + F.lane], c1 = c[DM + k0 + kq + F.lane];
                const float s0 = c0 / (1.0f + __expf(-c0)), s1 = c1 / (1.0f + __expf(-c1));
                const float* wp = wada + (size_t)(k0 + kq) * NMOD + col;
                for (int kk0 = 0; kk0 < 64; kk0 += 32) {
                    float w[32];
#pragma unroll
                    for (int q = 0; q < 32; ++q) w[q] = __builtin_nontemporal_load(wp + (size_t)(kk0 + q) * NMOD);
#pragma unroll
                    for (int q = 0; q < 32; ++q) { const float t0 = __builtin_bit_cast(float, __builtin_amdgcn_readlane(__builtin_bit_cast(int, s0), kk0 + q)), t1 = __builtin_bit_cast(float, __builtin_amdgcn_readlane(__builtin_bit_cast(int, s1), kk0 + q)); a0 += t0 * w[q]; a1 += t1 * w[q]; }
                }
            }
            modp[(size_t)(ks * 2 + 0) * NMOD + col] = a0;
            modp[(size_t)(ks * 2 + 1) * NMOD + col] = a1;
        }
    }
    if (NGW == 2048) {
        if (gw < NGEMV) { for (int j = 0; j < 7; ++j) p0_item(F, gw * 7 + j); }
        else { for (int it = NGEMV * 7 + (gw - NGEMV); it < P0_NITEMS; it += 2048 - NGEMV) p0_item(F, it); }
    } else { for (int it = gw; it < P0_NITEMS; it += NGW) p0_item(F, it); }
    {
        GAS v4u* z = (GAS v4u*)((bf16*)(F.ws + WS_BT_IN) + (size_t)D_IN * DM); const int nz = (NP - D_IN) * DM * 2 / 16;
        for (int i = F.bid * (NWAVES * 64) + F.tid; i < nz; i += F.G * NWAVES * 64) z[i] = (v4u){0u, 0u, 0u, 0u};
    }
}

__device__ __forceinline__ float mod_sum(const float* modp, const float* bada, int bb, int col) {
    float s = bada[col];
#pragma unroll 8
    for (int ks = 0; ks < KSPLIT; ++ks) s += modp[(size_t)(ks * 2 + bb) * NMOD + col];
    return s;
}
__device__ __forceinline__ void p1_h1(Frame& F) {
    const float* modp = (const float*)(F.ws + WS_MODP); float* modf = (float*)(F.ws + WS_MODF); const float* bada = kin<I_BADA>();
    LAS float* scaleL = (LAS float*)(F.lds + RING_OFF); LAS float* shiftL = scaleL + DM;
    bf16* H = (bf16*)(F.ws + WS_H);
    for (int idx = F.bid * (NWAVES * 64) + F.tid; idx < 2 * NMOD; idx += F.G * NWAVES * 64) { const int bb = idx / NMOD, col = idx % NMOD; modf[idx] = mod_sum(modp, bada, bb, col); }
    for (int tile = F.bid; tile < MTOK / 32; tile += F.G) {
        const int bb = tile / (SEQ / 32);
        __syncthreads();
        for (int j = 0; j < 8; ++j) { const int col = F.tid + 512 * j; const float s = mod_sum(modp, bada, bb, col);
            if (col < DM) shiftL[col] = s; else scaleL[col - DM] = kin<I_GPREMIX>()[col - DM] * (1.0f + s); }
        __syncthreads();
        for (int i = 0; i < 4; ++i) {
            const int row = tile * 32 + F.wave * 4 + i;
            const f32x4* xr = (const f32x4*)(kin<I_X>() + (size_t)row * DM) + F.lane;
            f32x4 v[8]; float ss = 0.f;
#pragma unroll
            for (int j = 0; j < 8; ++j) { v[j] = xr[64 * j]; ss += (v[j][0] * v[j][0] + v[j][1] * v[j][1]) + (v[j][2] * v[j][2] + v[j][3] * v[j][3]); }
            const float rstd = 1.0f / sqrtf(wave_sum(ss) * (1.0f / DM) + EPS);
            unsigned long long* o8 = (unsigned long long*)(H + (size_t)row * DM) + F.lane;
#pragma unroll
            for (int j = 0; j < 8; ++j) { const f32x4 sc = *(const LAS f32x4*)(scaleL + 4 * F.lane + 256 * j), sh = *(const LAS f32x4*)(shiftL + 4 * F.lane + 256 * j);
                const f32x4 h = v[j] * rstd * sc + sh;
                o8[64 * j] = (unsigned long long)pk2(h[0], h[1]) | ((unsigned long long)pk2(h[2], h[3]) << 32); }
        }
    }
    __syncthreads();
}

template <int II> struct ConvLoop {
    static __device__ __forceinline__ void run(f32x2v (&acc)[32], const f32x2v (&w)[CONVW], const bf16* PROJ, int bb, int s0, int ch) {
        const int sin = s0 - 30 + II; const int sc = sin < 0 ? 0 : sin; const float ok = sin < 0 ? 0.f : 1.f;
        const bf16* rp = PROJ + (size_t)(bb * SEQ + sc) * NP + OFF_GLU + ch;
        const unsigned a2 = *(const unsigned*)rp, g2 = *(const unsigned*)(rp + DCONV);
        f32x2v u; u.x = ok * bf_lo(a2) * sigmoidf_fast(bf_lo(g2)); u.y = ok * bf_hi(a2) * sigmoidf_fast(bf_hi(g2));
        constexpr int lo = II > 30 ? II - 30 : 0, hi = II < 31 ? II : 31;
#pragma unroll
        for (int o = lo; o <= hi; ++o) acc[o] += w[II - o] * u;
        if ((II & 7) == 7) asm volatile("" ::: "memory");
        ConvLoop<II + 1>::run(acc, w, PROJ, bb, s0, ch);
    }
};
template <> struct ConvLoop<62> { static __device__ __forceinline__ void run(f32x2v (&)[32], const f32x2v (&)[CONVW], const bf16*, int, int, int) {} };

__device__ __forceinline__ void p3_conv_tile(Frame& F, int tile) {
    const bf16* PROJ = (const bf16*)(F.ws + WS_PROJ); bf16* CACT = (bf16*)(F.ws + WS_CACT);
    LAS float* red = (LAS float*)(F.lds + RING_OFF);
    LAS float* stat = red + 8 * 64;
    const int bb = tile / (SEQ / 32), s0 = (tile % (SEQ / 32)) * 32, ch = 2 * F.tid;
    f32x2v w[CONVW];
#pragma unroll
    for (int j = 0; j < CONVW; ++j) w[j] = *(const f32x2v*)(kin<I_WDW>() + j * DCONV + ch);
    f32x2v acc[32];
#pragma unroll
    for (int o = 0; o < 32; ++o) acc[o] = (f32x2v){0.f, 0.f};
    ConvLoop<0>::run(acc, w, PROJ, bb, s0, ch);
    const f32x2v bdw = *(const f32x2v*)(kin<I_BDW>() + ch);
    float vals[64];
#pragma unroll
    for (int o = 0; o < 32; ++o) { acc[o] += bdw; vals[2 * o] = acc[o].x + acc[o].y; vals[2 * o + 1] = acc[o].x * acc[o].x + acc[o].y * acc[o].y; }
#define BFLY(d, n) do { const bool up = (F.lane & (d)) != 0; _Pragma("unroll") for (int k = 0; k < (n); ++k) { const float send = up ? vals[k] : vals[k + (n)], keep = up ? vals[k + (n)] : vals[k]; vals[k] = keep + __shfl_xor(send, (d)); } } while (0)
    BFLY(32, 32); BFLY(16, 16); BFLY(8, 8); BFLY(4, 4); BFLY(2, 2); BFLY(1, 1);
#undef BFLY
    __syncthreads();
    red[F.wave * 64 + F.lane] = vals[0];
    __syncthreads();
    if (F.tid < 32) { float s = 0.f, q = 0.f;
#pragma unroll
        for (int wv = 0; wv < 8; ++wv) { s += red[wv * 64 + 2 * F.tid]; q += red[wv * 64 + 2 * F.tid + 1]; }
        const float mean = s * (1.0f / DCONV), var = q * (1.0f / DCONV) - mean * mean;
        stat[2 * F.tid] = mean; stat[2 * F.tid + 1] = 1.0f / sqrtf(var + EPS); }
    __syncthreads();
    const f32x2v gl = *(const f32x2v*)(kin<I_GLN>() + ch), bl = *(const f32x2v*)(kin<I_BLN>() + ch);
#pragma unroll
    for (int o = 0; o < 32; ++o) { const float mean = stat[2 * o], rstd = stat[2 * o + 1];
        const float z0 = (acc[o].x - mean) * rstd * gl.x + bl.x, z1 = (acc[o].y - mean) * rstd * gl.y + bl.y;
        *(unsigned*)(CACT + (size_t)(bb * SEQ + s0 + o) * DCONV + ch) = pg8::cvt_pk_bf16(z0 * sigmoidf_fast(z0), z1 * sigmoidf_fast(z1)); }
}

__device__ __forceinline__ void glds16s(const void* sbase, unsigned voff, unsigned lds_dst) { unsigned keep;
    asm volatile("s_mov_b32 %0, m0\n\ts_mov_b32 m0, %3\n\ts_nop 4\n\tglobal_load_lds_dwordx4 %1, %2\n\ts_mov_b32 m0, %0" : "=&s"(keep) : "v"(voff), "s"(sbase), "s"(lds_dst) : "memory"); }
__device__ __forceinline__ void p3_indexer_block(Frame& F, int bu) {
    const bf16* PROJ = (const bf16*)(F.ws + WS_PROJ); unsigned long long* MASK = (unsigned long long*)(F.ws + WS_MASK);
    const int bb = bu & 1, blk = bu >> 1, q0 = bb * SEQ + 16 * blk, nj = (blk >> 2) + 1, ntile = 2 * nj, nstage = (nj + 3) >> 2;
    const int lane = F.lane, rho = lane & 31, hh = lane >> 5, e = (rho >> 2) & 1, hd = (rho & 3) + 4 * (rho >> 3);
    const int qw = q0 + 2 * F.wave;
    bf16x8 A[4];
    { const bf16* qrow = PROJ + (size_t)(qw + e) * NP + OFF_QI + hd * 64 + 8 * hh;
#pragma unroll
      for (int s = 0; s < 4; ++s) A[s] = *(const bf16x8*)(qrow + 16 * s); }
    float wv[16];
    { const v4u* wrow = (const v4u*)(PROJ + (size_t)(qw + hh) * NP + OFF_WI); const v4u w0 = wrow[0], w1 = wrow[1];
      const float sc = 0.03125f;
      wv[0] = bf_lo(w0.x) * sc; wv[1] = bf_hi(w0.x) * sc; wv[2] = bf_lo(w0.y) * sc; wv[3] = bf_hi(w0.y) * sc; wv[4] = bf_lo(w0.z) * sc; wv[5] = bf_hi(w0.z) * sc; wv[6] = bf_lo(w0.w) * sc; wv[7] = bf_hi(w0.w) * sc;
      wv[8] = bf_lo(w1.x) * sc; wv[9] = bf_hi(w1.x) * sc; wv[10] = bf_lo(w1.y) * sc; wv[11] = bf_hi(w1.y) * sc; wv[12] = bf_lo(w1.z) * sc; wv[13] = bf_hi(w1.z) * sc; wv[14] = bf_lo(w1.w) * sc; wv[15] = bf_hi(w1.w) * sc; }
    const bf16* ksrc = PROJ + (size_t)(bb * SEQ + 32 * F.wave) * NP + OFF_KI;
    const unsigned kvoff = (unsigned)((lane >> 3) * (NP * 2) + (((lane & 7) ^ (lane >> 3)) << 4));
    const unsigned ldsb = (unsigned)(uintptr_t)(F.lds + RING_OFF) + (unsigned)F.wave * 4096u;
#define IDX_DMA(st, slotoff) do { _Pragma("unroll") for (int i_ = 0; i_ < 4; ++i_) glds16s(ksrc + (size_t)(256 * (st) + 8 * i_) * NP, kvoff, (unsigned)__builtin_amdgcn_readfirstlane(ldsb + (unsigned)((slotoff) + i_ * 1024))); } while (0)
    int sl_cur = 0, sl_nn = 65536;
    const LAS unsigned char* rdp = F.lds + RING_OFF + rho * 128;
    const int sw = rho & 7;
    unsigned key[128];
#pragma unroll
    for (int j = 0; j < 128; ++j) key[j] = 0u;
    for (int rp_ = 0; rp_ < (DUP_SUB == 3 ? 2 : 1); ++rp_) {
    if (rp_) asm volatile("s_waitcnt vmcnt(0) lgkmcnt(0)\n\ts_barrier" ::: "memory");
    IDX_DMA(0, 0);
    if (nstage > 1) IDX_DMA(1, 32768);
    sl_cur = 0; sl_nn = 65536;
    for (int g = 0; g < nstage; ++g) {
        if (g + 1 < nstage) asm volatile("s_waitcnt vmcnt(4) lgkmcnt(0)\n\ts_barrier" ::: "memory"); else asm volatile("s_waitcnt vmcnt(0) lgkmcnt(0)\n\ts_barrier" ::: "memory");
        if (g + 2 < nstage) IDX_DMA(g + 2, sl_nn);
#define KCASE(G) case G: _Pragma("unroll") for (int k = 0; k < 4; ++k) key[8 * G + 4 * h4 + k] = tk[k]; break;
#pragma unroll
        for (int h4 = 0; h4 < 2; ++h4) {
            unsigned tk[4];
#pragma unroll
            for (int k = 0; k < 4; ++k) {
                const int kt = 8 * g + 4 * h4 + k;
                tk[k] = 0u;
                if (kt < ntile) {
                    const LAS unsigned char* tp = rdp + sl_cur + (4 * h4 + k) * 4096;
                    f32x16 acc = {0.f, 0.f, 0.f, 0.f, 0.f, 0.f, 0.f, 0.f, 0.f, 0.f, 0.f, 0.f, 0.f, 0.f, 0.f, 0.f};
#pragma unroll
                    for (int s = 0; s < 4; ++s) { const bf16x8 B = *(const LAS bf16x8*)(tp + (((2 * s + hh) ^ sw) << 4)); acc = __builtin_amdgcn_mfma_f32_32x32x16_bf16(A[s], B, acc, 0, 0, 0); }
                    float v = 0.f;
#pragma unroll
                    for (int r = 0; r < 16; ++r) v += wv[r] * __builtin_amdgcn_fmed3f(acc[r], 0.f, INFINITY);
                    tk[k] = (unsigned)((int)fminf(fmaxf(v * 1048576.0f, -8388607.0f), 8388607.0f) + 8388608);
                    asm volatile("" : "+v"(tk[k]));
                }
                if (k & 1) { asm volatile("" ::: "memory"); __builtin_amdgcn_sched_barrier(0); }
            }
            switch (g) { KCASE(0) KCASE(1) KCASE(2) KCASE(3) KCASE(4) KCASE(5) KCASE(6) KCASE(7) KCASE(8) KCASE(9) KCASE(10) KCASE(11) KCASE(12) KCASE(13) KCASE(14) KCASE(15) default: break; }
        }
#undef KCASE
        sl_nn = sl_cur; sl_cur = (sl_cur == 65536) ? 0 : sl_cur + 32768;
    }
    }
#undef IDX_DMA
    unsigned TA = 1u, TB = 1u;
    for (int rp_ = 0; rp_ < (DUP_SUB == 4 ? 2 : 1); ++rp_)
    if (nj * 64 > TOPK) {
        TA = 0u; TB = 0u; bool doneA = false, doneB = false;
        for (int bit = 23; bit >= 0; --bit) {
            const unsigned candA = TA | (1u << bit), candB = TB | (1u << bit);
            const unsigned cand = hh ? candB : candA; int cnt = 0;
#pragma unroll
            for (int g = 0; g < 16; ++g) if (g < nstage) {
#pragma unroll
                for (int k = 0; k < 8; ++k) cnt += (key[8 * g + k] >= cand) ? 1 : 0; }
            cnt += __builtin_amdgcn_update_dpp(0, cnt, 0xB1, 0xF, 0xF, false);
            cnt += __builtin_amdgcn_update_dpp(0, cnt, 0x4E, 0xF, 0xF, false);
            cnt += __builtin_amdgcn_update_dpp(0, cnt, 0x141, 0xF, 0xF, false);
            cnt += __builtin_amdgcn_update_dpp(0, cnt, 0x140, 0xF, 0xF, false);
            const int cA = __builtin_amdgcn_readlane(cnt, 0) + __builtin_amdgcn_readlane(cnt, 16), cB = __builtin_amdgcn_readlane(cnt, 32) + __builtin_amdgcn_readlane(cnt, 48);
            if (!doneA) { if (cA >= TOPK) TA = candA; if (cA == TOPK) doneA = true; }
            if (!doneB) { if (cB >= TOPK) TB = candB; if (cB == TOPK) doneB = true; }
            if (doneA && doneB) break;
        }
    }
    const unsigned T = hh ? TB : TA;
    unsigned a_lo = 0u, a_hi = 0u, b_lo = 0u, b_hi = 0u;
#pragma unroll
    for (int g = 0; g < 16; ++g) if (g < nstage) {
#pragma unroll
        for (int k = 0; k < 8; ++k) { const int j = 8 * g + k; const unsigned long long mk = __ballot(key[j] >= T);
            if (lane == (j >> 1)) { if (j & 1) { a_hi = (unsigned)mk; b_hi = (unsigned)(mk >> 32); } else { a_lo = (unsigned)mk; b_lo = (unsigned)(mk >> 32); } } } }
    MASK[(size_t)qw * 64 + lane] = (unsigned long long)a_lo | ((unsigned long long)a_hi << 32);
    MASK[(size_t)(qw + 1) * 64 + lane] = (unsigned long long)b_lo | ((unsigned long long)b_hi << 32);
    asm volatile("s_waitcnt vmcnt(0) lgkmcnt(0)\n\ts_barrier" ::: "memory");
}

__device__ __forceinline__ void p7_rows(Frame& F) {
    const float* modf = (const float*)(F.ws + WS_MODF); bf16* H = (bf16*)(F.ws + WS_H);
    LAS float* A1 = (LAS float*)(F.lds + RING_OFF); LAS float* S2 = A1 + DM; LAS float* T2 = S2 + DM;
    for (int tile = F.bid; tile < MTOK / 32; tile += F.G) {
        const int bb = tile / (SEQ / 32);
        __syncthreads();
        for (int j = 0; j < 4; ++j) { const int col = F.tid + 512 * j;
            A1[col] = modf[bb * NMOD + 2 * DM + col] * kin<I_GPOSTMIX>()[col];
            S2[col] = kin<I_GPREFFN>()[col] * (1.0f + modf[bb * NMOD + 4 * DM + col]);
            T2[col] = modf[bb * NMOD + 3 * DM + col]; }
        __syncthreads();
        for (int i = 0; i < 4; ++i) {
            const int row = tile * 32 + F.wave * 4 + i;
            const f32x4* xr = (const f32x4*)(kin<I_X>() + (size_t)row * DM) + F.lane;
            f32x4* mr = (f32x4*)(F.out + (size_t)row * DM) + F.lane;
            f32x4 mv[8], xv[8]; float ss = 0.f;
#pragma unroll
            for (int j = 0; j < 8; ++j) { mv[j] = mr[64 * j]; xv[j] = xr[64 * j]; ss += (mv[j][0] * mv[j][0] + mv[j][1] * mv[j][1]) + (mv[j][2] * mv[j][2] + mv[j][3] * mv[j][3]); }
            const float rstd = 1.0f / sqrtf(wave_sum(ss) * (1.0f / DM) + EPS);
            float s1 = 0.f;
#pragma unroll
            for (int j = 0; j < 8; ++j) { const f32x4 a = *(const LAS f32x4*)(A1 + 4 * F.lane + 256 * j); xv[j] = xv[j] + mv[j] * rstd * a;
                s1 += (xv[j][0] * xv[j][0] + xv[j][1] * xv[j][1]) + (xv[j][2] * xv[j][2] + xv[j][3] * xv[j][3]); mr[64 * j] = xv[j]; }
            const float rstd1 = 1.0f / sqrtf(wave_sum(s1) * (1.0f / DM) + EPS);
            unsigned long long* o8 = (unsigned long long*)(H + (size_t)row * DM) + F.lane;
#pragma unroll
            for (int j = 0; j < 8; ++j) { const f32x4 sc = *(const LAS f32x4*)(S2 + 4 * F.lane + 256 * j), sh = *(const LAS f32x4*)(T2 + 4 * F.lane + 256 * j);
                const f32x4 h = xv[j] * rstd1 * sc + sh;
                o8[64 * j] = (unsigned long long)pk2(h[0], h[1]) | ((unsigned long long)pk2(h[2], h[3]) << 32); }
        }
    }
    __syncthreads();
}
__device__ __forceinline__ void p10_rows(Frame& F) {
    const float* modf = (const float*)(F.ws + WS_MODF); const float* Fb = (const float*)(F.ws + WS_F);
    LAS float* A2 = (LAS float*)(F.lds + RING_OFF);
    for (int tile = F.bid; tile < MTOK / 32; tile += F.G) {
        const int bb = tile / (SEQ / 32);
        __syncthreads();
        for (int j = 0; j < 4; ++j) { const int col = F.tid + 512 * j; A2[col] = modf[bb * NMOD + 5 * DM + col] * kin<I_GPOSTFFN>()[col]; }
        __syncthreads();
        for (int i = 0; i < 4; ++i) {
            const int row = tile * 32 + F.wave * 4 + i;
            const f32x4* fr = (const f32x4*)(Fb + (size_t)row * DM) + F.lane;
            f32x4* orow = (f32x4*)(F.out + (size_t)row * DM) + F.lane;
            f32x4 fv[8], xv[8]; float ss = 0.f;
#pragma unroll
            for (int j = 0; j < 8; ++j) { fv[j] = fr[64 * j]; xv[j] = orow[64 * j]; ss += (fv[j][0] * fv[j][0] + fv[j][1] * fv[j][1]) + (fv[j][2] * fv[j][2] + fv[j][3] * fv[j][3]); }
            const float rstd = 1.0f / sqrtf(wave_sum(ss) * (1.0f / DM) + EPS);
#pragma unroll
            for (int j = 0; j < 8; ++j) { const f32x4 a = *(const LAS f32x4*)(A2 + 4 * F.lane + 256 * j); orow[64 * j] = xv[j] + fv[j] * rstd * a; }
        }
    }
}

#ifndef MK_N_LAUNCHES
#define MK_N_LAUNCHES 1
#endif
constexpr int N_PHASES = 11;
struct Args { const float* in[19]; float* out; unsigned char* ws; int ph_lo, ph_hi; };
__global__ void __launch_bounds__(NWAVES * 64, 2) mk_fwd(Args args) {
    extern __shared__ __attribute__((aligned(16))) unsigned char lds[];
    Frame F;
    F.lds = (LAS unsigned char*)lds;
    F.MISC = (volatile LAS unsigned*)(F.lds + MISC_OFF);
    F.tid = threadIdx.x; F.lane = F.tid & 63; F.wave = __builtin_amdgcn_readfirstlane(F.tid >> 6);
    F.G = gridDim.x; F.bid = blockIdx.x;
    F.ws = args.ws; F.out = args.out; F.ctl = (gu32*)(args.ws + WS_CTL);
    for (int u = F.tid; u < (LDS_BYTES - LDSCTL_OFF) / 4; u += NWAVES * 64) ((LAS unsigned*)(F.lds + LDSCTL_OFF))[u] = 0u;
    __syncthreads();
    XcdBarrier bar; bar.bar = (unsigned*)(F.ctl + CW_BAR); bar.x = 0; bar.st = nullptr;
    if (MK_N_LAUNCHES == 1) bar = xcd_barrier_post((unsigned*)(F.ctl + CW_BAR), F.MISC + 8);
    const int lo = args.ph_lo, hi = args.ph_hi;
#define IN(k) (lo <= (k) && (k) < hi)
#define SEAM(k) do { if (IN(k) && IN((k) + 1)) xcd_barrier(bar); } while (0)
#ifndef DUP_PHASE
#define DUP_PHASE (-1)
#endif
#define PH(k) if (IN(k)) for (int rep_ = 0; rep_ < ((k) == DUP_PHASE ? 2 : 1); ++rep_)
#define REP_BAR() do { if (rep_) xcd_barrier(bar); } while (0)
    bf16* H = (bf16*)(F.ws + WS_H); bf16* PROJ = (bf16*)(F.ws + WS_PROJ);
    const int gw = F.bid * NWAVES + F.wave, NGW = F.G * NWAVES;

    PH(0) { REP_BAR(); p0_prologue(F); } SEAM(0);
    PH(1) { REP_BAR(); p1_h1(F); } SEAM(1);
    PH(2) { REP_BAR();
        pg8::Gemm g{H, (const bf16*)(F.ws + WS_BT_IN), MTOK, NP, DM}; pg8::StaticOrder S; S.init(MTOK, NP, F.G, F.bid);
        EpiStoreBf16 E{PROJ, NP, OFF_Q, OFF_K, attn_body::C2};
        pg8::gemm_phase<EpiStoreBf16, pg8::StaticOrder, true, true>(F.lds + RING_OFF, g, S, E);
    } SEAM(2);
    PH(3) { REP_BAR();
        for (int rs_ = 0; rs_ < (DUP_SUB == 1 ? 2 : 1); ++rs_)
        for (int tile = F.bid; tile < MTOK / 32; tile += F.G) p3_conv_tile(F, tile);
        __syncthreads();
        for (int rs_ = 0; rs_ < (DUP_SUB == 2 ? 2 : 1); ++rs_)
        for (int pu = F.bid; pu < 256; pu += F.G) for (int half = 0; half < 2; ++half) p3_indexer_block(F, half ? 511 - pu : pu);
    } SEAM(3);
    PH(4) { REP_BAR();
        static_assert(attn_body::ATTN_LDS_BYTES <= RING_BYTES, "attention LDS");
        const attn_body::AttnTensors AT{(const attn_body::bf16*)(PROJ + OFF_Q), (const attn_body::bf16*)(PROJ + OFF_K), (const attn_body::bf16*)(PROJ + OFF_V), (attn_body::bf16*)(F.ws + WS_AOUT), (const unsigned*)(F.ws + WS_MASK)};
        const attn_body::StaticOrder S(F.G, F.bid);
        attn_body::attn_phase<attn_body::StaticOrder>((char*)lds + RING_OFF, AT, S);
    } SEAM(4);
    PH(5) { REP_BAR();
        { pg8::Gemm g{(const bf16*)(F.ws + WS_CACT), (const bf16*)(F.ws + WS_BT_CO), MTOK, DM, DCONV}; pg8::StaticOrder S; S.init(MTOK, DM, F.G, F.bid);
          EpiGateConv E{F.out, PROJ + OFF_G, NP};
          pg8::gemm_phase<EpiGateConv, pg8::StaticOrder, true, true>(F.lds + RING_OFF, g, S, E); }
        { pg8::Gemm g{(const bf16*)(F.ws + WS_AOUT), (const bf16*)(F.ws + WS_BT_AO), MTOK, DM, DCONV}; pg8::StaticOrder S; S.init(MTOK, DM, F.G, F.bid);
          EpiGateAttn E{F.out, PROJ + OFF_G + DM, NP, (bf16*)(F.ws + WS_MERGED)};
          pg8::gemm_phase<EpiGateAttn, pg8::StaticOrder, true, true>(F.lds + RING_OFF, g, S, E); }
    } SEAM(5);
    PH(6) { REP_BAR();
        pg8::Gemm g{(const bf16*)(F.ws + WS_MERGED), (const bf16*)(F.ws + WS_BT_O), MTOK, DM, DM}; pg8::StaticOrder S; S.init(MTOK, DM, F.G, F.bid);
        EpiStoreF32 E{F.out, DM};
        pg8::gemm_phase<EpiStoreF32, pg8::StaticOrder, true, true>(F.lds + RING_OFF, g, S, E);
    } SEAM(6);
    PH(7) { REP_BAR(); p7_rows(F); } SEAM(7);
    PH(8) { REP_BAR();
        pg8::Gemm g{H, (const bf16*)(F.ws + WS_BT_GU), MTOK, NGU, DM}; pg8::StaticOrder S; S.init(MTOK, NGU, F.G, F.bid);
        EpiSwiGLU E{(bf16*)(F.ws + WS_GU)};
        pg8::gemm_phase<EpiSwiGLU, pg8::StaticOrder, true, true>(F.lds + RING_OFF, g, S, E);
    } SEAM(8);
    PH(9) { REP_BAR();
        pg8::Gemm g{(const bf16*)(F.ws + WS_GU), (const bf16*)(F.ws + WS_BT_DN), MTOK, DM, DFF}; pg8::StaticOrder S; S.init(MTOK, DM, F.G, F.bid);
        EpiStoreF32 E{(float*)(F.ws + WS_F), DM};
        pg8::gemm_phase<EpiStoreF32, pg8::StaticOrder, true, true>(F.lds + RING_OFF, g, S, E);
    } SEAM(9);
    PH(10) { REP_BAR(); p10_rows(F); }
#undef IN
#undef SEAM
}

extern "C" void kernel_launch(void* const* d_in, const int* in_sizes, int n_in, void* d_out, int out_size, void* d_ws, size_t ws_size, hipStream_t stream) {
    static int grid = 0;
    if (grid == 0) {
        if (n_in != 19 || in_sizes[0] != MTOK * DM || out_size != MTOK * DM || ws_size < WS_END) { fprintf(stderr, "kernel_launch: unexpected shapes / workspace (n_in %d, in0 %d, out %d, ws %zu < %zu)\n", n_in, n_in > 0 ? in_sizes[0] : -1, out_size, ws_size, (size_t)WS_END); grid = -1; return; }
        int dev = 0, cus = 0, per_cu = 0;
        if (hipGetDevice(&dev) != hipSuccess || hipDeviceGetAttribute(&cus, hipDeviceAttributeMultiprocessorCount, dev) != hipSuccess) { grid = -1; return; }
        if (hipFuncSetAttribute((const void*)mk_fwd, hipFuncAttributeMaxDynamicSharedMemorySize, LDS_BYTES) != hipSuccess) { fprintf(stderr, "kernel_launch: hipFuncSetAttribute failed\n"); grid = -1; return; }
        if (hipOccupancyMaxActiveBlocksPerMultiprocessor(&per_cu, (const void*)mk_fwd, NWAVES * 64, LDS_BYTES) != hipSuccess || per_cu < 1) { fprintf(stderr, "kernel_launch: occupancy query says %d blocks per CU\n", per_cu); (void)hipGetLastError(); grid = -1; return; }
        grid = cus;
    }
    if (grid < 0) return;
    if (hipMemsetAsync((char*)d_ws + WS_CTL, 0, CTL_ZERO_BYTES, stream) != hipSuccess) return;
    Args a{};
    for (int i = 0; i < 19; ++i) a.in[i] = (const float*)d_in[i];
    a.out = (float*)d_out; a.ws = (unsigned char*)d_ws;
#if MK_N_LAUNCHES == 1
    a.ph_lo = 0; a.ph_hi = N_PHASES;
    hipLaunchKernelGGL(mk_fwd, dim3(grid), dim3(NWAVES * 64), LDS_BYTES, stream, a);
#else
    for (int p = 0; p < N_PHASES; ++p) { a.ph_lo = p; a.ph_hi = p + 1; hipLaunchKernelGGL(mk_fwd, dim3(grid), dim3(NWAVES * 64), LDS_BYTES, stream, a); }
#endif
}
```

```cpp
#include <hip/hip_runtime.h>
#include <cstdio>
#include <cstdint>
namespace pg8 {
#define PG8_LAS __attribute__((address_space(3)))
typedef unsigned short bf16_t;
typedef short bf16x8 __attribute__((ext_vector_type(8)));
typedef float f32x4 __attribute__((ext_vector_type(4)));
typedef unsigned u32x4 __attribute__((ext_vector_type(4)));
constexpr int BM = 256, BK = 64, HALF = 128, HTB = HALF * BK * 2  , STAGE_BYTES = 8 * HTB, NXCD = 8, WGM = 8;

__host__ __device__ __forceinline__ int lds_byte(int r, int c) { const int st = (r >> 4) * 2 + (c >> 5), rr = r & 15, cc = c & 31, ob = rr * 64 + cc * 2; return st * 1024 + (ob ^ (((ob >> 9) & 1) << 5)); }
__host__ __device__ __forceinline__ void stage_rc(int b, int& R, int& C) { const int st = b / 1024, sb = b % 1024, swz = sb ^ (((sb >> 9) & 1) << 5); R = (st >> 1) * 16 + swz / 64; C = (st & 1) * 32 + (swz % 64) / 2; }
__host__ __device__ __forceinline__ int perm32(int rho) { const int n = rho >> 4, i = rho & 15; return 8 * (i >> 2) + 4 * n + (i & 3); }

struct Unit { int pm, pn; };
struct Gemm { const bf16_t* A; const bf16_t* Bt; int M, N, K; };

struct StaticOrder {
    int nM, nN, nwg, G, c;
    __host__ __device__ void init(int M, int N, int G_, int c_) { nM = M / BM; nN = N / BM; nwg = nM * nN; G = G_; c = c_; }
    __host__ __device__ bool next(int i, Unit& u) const {
        const long L = (long)i * G + c; if (L >= nwg) return false;
        int wgid = (int)L; { const int q = nwg / NXCD, r = nwg % NXCD, xcd = wgid % NXCD, off = wgid / NXCD; wgid = (xcd < r ? xcd * (q + 1) : r * (q + 1) + (xcd - r) * q) + off; }
        const int nig = WGM * nN, gid = wgid / nig, fm = gid * WGM, gsz = (nM - fm) < WGM ? (nM - fm) : WGM;
        u.pm = fm + ((wgid % nig) % gsz); u.pn = (wgid % nig) / gsz; return true;
    }
    __device__ __forceinline__ void a_ready(const Unit&) const {}
    __device__ __forceinline__ void done(const Unit&) const {}
};

__device__ __forceinline__ unsigned cvt_pk_bf16(float lo, float hi) { unsigned r; asm volatile("v_cvt_pk_bf16_f32 %0, %1, %2" : "=v"(r) : "v"(lo), "v"(hi)); return r; }
typedef float f32x2 __attribute__((ext_vector_type(2)));
template <class Epi, class Sched, bool ALIGN_EPI = false, bool SP2 = false>
__device__ __forceinline__ void gemm_phase(PG8_LAS unsigned char* lds, const Gemm g, const Sched& S, const Epi& E) {
    const int tid = threadIdx.x, wid = __builtin_amdgcn_readfirstlane(tid >> 6), lane = tid & 63, wr = wid >> 2, wc = wid & 3, fr = lane & 15, fq = lane >> 4;
    const int K = g.K, nt = K / BK;
    unsigned voffA[2], voffB[2];
#pragma unroll
    for (int i = 0; i < 2; ++i) { int R, C; stage_rc(tid * 16 + i * 8192, R, C); const int Rb = Epi::PERM ? ((R & ~31) + perm32(R & 31)) : R;
        voffA[i] = (unsigned)(R * K + C) * 2u; voffB[i] = (unsigned)(Rb * K + C) * 2u; }
    const size_t kstep = (size_t)(BK * 2);
    const size_t hstep = (size_t)HALF * K * 2;
    const size_t tstep = 2 * hstep;
    const unsigned ldsw = (unsigned)wid * 1024u;
    const int aoff = lds_byte(wr * 64 + fr, fq * 8), boff = lds_byte(wc * 32 + fr, fq * 8);
#define PG8_SA(b, h) (((b) * 2 + (h)) * HTB)
#define PG8_SB(b, h) ((4 + (b) * 2 + (h)) * HTB)
#define PG8_STAGE(bufoff, gbase, voff) do { _Pragma("unroll") for (int _i = 0; _i < 2; ++_i) \
        __builtin_amdgcn_global_load_lds((const unsigned*)((const char*)(gbase) + (voff)[_i]), (PG8_LAS unsigned*)(lds + (bufoff) + ldsw + _i * 8192), 16, 0, 0); } while (0)
#define PG8_LDA(dst, b, h) do { _Pragma("unroll") for (int m = 0; m < 4; ++m) _Pragma("unroll") for (int k = 0; k < 2; ++k) dst[m][k] = *(const PG8_LAS bf16x8*)(lds + PG8_SA(b, h) + aoff + m * 2048 + k * 1024); } while (0)
#define PG8_LDB(dst, b, h) do { _Pragma("unroll") for (int n = 0; n < 2; ++n) _Pragma("unroll") for (int k = 0; k < 2; ++k) dst[n][k] = *(const PG8_LAS bf16x8*)(lds + PG8_SB(b, h) + boff + n * 2048 + k * 1024); } while (0)
#define PG8_MMA(ai, bj, At, Bt) do { __builtin_amdgcn_s_setprio(1); _Pragma("unroll") for (int m = 0; m < 4; ++m) _Pragma("unroll") for (int n = 0; n < 2; ++n) _Pragma("unroll") for (int k = 0; k < 2; ++k) \
        acc[ai][bj][m][n] = __builtin_amdgcn_mfma_f32_16x16x32_bf16(Bt[n][k], At[m][k], acc[ai][bj][m][n], 0, 0, 0); __builtin_amdgcn_s_setprio(0); } while (0)
#define PG8_WAIT_V(n) asm volatile("s_waitcnt vmcnt(" #n ")" ::: "memory")
#define PG8_WAIT_L(n) asm volatile("s_waitcnt lgkmcnt(" #n ")" ::: "memory")
#define PG8_BAR __builtin_amdgcn_s_barrier()
#define PG8_SCHED __builtin_amdgcn_sched_barrier(0)
    Unit cur, nxt; int ui = 0;
    if (!S.next(0, cur)) return;
    f32x4 acc[2][2][4][2];
#pragma unroll
    for (int a = 0; a < 2; ++a)
#pragma unroll
        for (int b = 0; b < 2; ++b)
#pragma unroll
            for (int m = 0; m < 4; ++m)
#pragma unroll
                for (int n = 0; n < 2; ++n) acc[a][b][m][n] = (f32x4){0.f, 0.f, 0.f, 0.f};
    bf16x8 At[4][2], B0[2][2], B1[2][2];
    const char* cA = (const char*)g.A + (size_t)cur.pm * tstep; const char* cB = (const char*)g.Bt + (size_t)cur.pn * tstep;
    S.a_ready(cur);
    if constexpr (SP2) {
        PG8_STAGE(PG8_SB(0, 0), cB, voffB); PG8_STAGE(PG8_SB(0, 1), cB + hstep, voffB); PG8_STAGE(PG8_SA(0, 0), cA, voffA); PG8_STAGE(PG8_SA(0, 1), cA + hstep, voffA);
        if (wr == 1) PG8_BAR;
        PG8_WAIT_V(2); PG8_BAR;
        PG8_STAGE(PG8_SB(1, 0), cB + kstep, voffB); PG8_STAGE(PG8_SA(1, 0), cA + kstep, voffA); PG8_STAGE(PG8_SB(1, 1), cB + hstep + kstep, voffB);
        PG8_WAIT_V(6); PG8_BAR;
    } else {
        PG8_STAGE(PG8_SB(0, 0), cB, voffB); PG8_STAGE(PG8_SA(0, 0), cA, voffA); PG8_STAGE(PG8_SB(0, 1), cB + hstep, voffB); PG8_STAGE(PG8_SA(0, 1), cA + hstep, voffA);
        if (wr == 1) PG8_BAR;
        PG8_WAIT_V(4); PG8_BAR;
        PG8_STAGE(PG8_SB(1, 0), cB + kstep, voffB); PG8_STAGE(PG8_SA(1, 0), cA + kstep, voffA); PG8_STAGE(PG8_SB(1, 1), cB + hstep + kstep, voffB);
        PG8_WAIT_V(6); PG8_BAR;
    }
    for (;;) {
        const bool has_next = S.next(ui + 1, nxt);
        const char* nA = has_next ? (const char*)g.A + (size_t)nxt.pm * tstep : cA; const char* nB = has_next ? (const char*)g.Bt + (size_t)nxt.pn * tstep : cB;
        for (int t = 0; t < nt; t += 2) {
            const bool last = (t == nt - 2);
            const char* a1 = cA + (size_t)(t + 1) * kstep;
            const char* a2 = last ? nA : cA + (size_t)(t + 2) * kstep; const char* b2 = last ? nB : cB + (size_t)(t + 2) * kstep;
            const char* a3 = a2 + kstep; const char* b3 = b2 + kstep;
            if (last && has_next) S.a_ready(nxt);
            if constexpr (SP2) {
            PG8_LDB(B0, 0, 0); PG8_LDB(B1, 0, 1); PG8_SCHED; PG8_LDA(At, 0, 0); PG8_STAGE(PG8_SA(1, 1), a1 + hstep, voffA);
            PG8_WAIT_V(8); PG8_WAIT_L(0); PG8_BAR; PG8_MMA(0, 0, At, B0); PG8_MMA(0, 1, At, B1); PG8_BAR; PG8_SCHED;
            PG8_LDA(At, 0, 1); PG8_STAGE(PG8_SB(0, 0), b2, voffB); PG8_STAGE(PG8_SB(0, 1), b2 + hstep, voffB); PG8_STAGE(PG8_SA(0, 0), a2, voffA);
            PG8_WAIT_V(8); PG8_WAIT_L(0); PG8_BAR; PG8_MMA(1, 0, At, B0); PG8_MMA(1, 1, At, B1); PG8_BAR; PG8_SCHED;
            PG8_LDB(B0, 1, 0); PG8_LDB(B1, 1, 1); PG8_SCHED; PG8_LDA(At, 1, 0); PG8_STAGE(PG8_SA(0, 1), a2 + hstep, voffA);
            PG8_WAIT_V(8); PG8_WAIT_L(0); PG8_BAR; PG8_MMA(0, 0, At, B0); PG8_MMA(0, 1, At, B1); PG8_BAR; PG8_SCHED;
            PG8_LDA(At, 1, 1); PG8_STAGE(PG8_SB(1, 0), b3, voffB); PG8_STAGE(PG8_SB(1, 1), b3 + hstep, voffB); PG8_STAGE(PG8_SA(1, 0), a3, voffA);
            PG8_WAIT_V(8); PG8_WAIT_L(0); PG8_BAR; PG8_MMA(1, 0, At, B0); PG8_MMA(1, 1, At, B1); PG8_BAR; PG8_SCHED;
            } else {
            PG8_LDB(B0, 0, 0); PG8_SCHED; PG8_LDA(At, 0, 0); PG8_STAGE(PG8_SA(1, 1), a1 + hstep, voffA);
            PG8_WAIT_L(8); PG8_BAR; PG8_WAIT_L(0); PG8_MMA(0, 0, At, B0); PG8_BAR; PG8_SCHED;
            PG8_LDB(B1, 0, 1); PG8_STAGE(PG8_SB(0, 0), b2, voffB);
            PG8_BAR; PG8_WAIT_L(0); PG8_MMA(0, 1, At, B1); PG8_BAR;
            PG8_LDA(At, 0, 1); PG8_STAGE(PG8_SA(0, 0), a2, voffA);
            PG8_BAR; PG8_WAIT_L(0); PG8_MMA(1, 0, At, B0); PG8_BAR; PG8_SCHED;
            PG8_STAGE(PG8_SB(0, 1), b2 + hstep, voffB);
            PG8_WAIT_V(6); PG8_BAR; PG8_MMA(1, 1, At, B1); PG8_BAR;
            PG8_LDB(B0, 1, 0); PG8_SCHED; PG8_LDA(At, 1, 0); PG8_STAGE(PG8_SA(0, 1), a2 + hstep, voffA);
            PG8_WAIT_L(8); PG8_BAR; PG8_WAIT_L(0); PG8_MMA(0, 0, At, B0); PG8_BAR; PG8_SCHED;
            PG8_LDB(B1, 1, 1); PG8_STAGE(PG8_SB(1, 0), b3, voffB);
            PG8_BAR; PG8_WAIT_L(0); PG8_MMA(0, 1, At, B1); PG8_BAR;
            PG8_LDA(At, 1, 1); PG8_STAGE(PG8_SA(1, 0), a3, voffA);
            PG8_BAR; PG8_WAIT_L(0); PG8_MMA(1, 0, At, B0); PG8_BAR; PG8_SCHED;
            PG8_STAGE(PG8_SB(1, 1), b3 + hstep, voffB);
            PG8_WAIT_V(6); PG8_BAR; PG8_MMA(1, 1, At, B1); PG8_BAR;
            }
        }
        if constexpr (ALIGN_EPI) { if (wr == 0) PG8_BAR; }
        if constexpr (!Epi::AFTER_DRAIN) { E(acc, cur, wr, wc, fr, fq); S.done(cur); }
        if (!has_next) break;
#pragma unroll
        for (int a = 0; a < 2; ++a)
#pragma unroll
            for (int b = 0; b < 2; ++b)
#pragma unroll
                for (int m = 0; m < 4; ++m)
#pragma unroll
                    for (int n = 0; n < 2; ++n) acc[a][b][m][n] = (f32x4){0.f, 0.f, 0.f, 0.f};
        cur = nxt; cA = nA; cB = nB; ++ui;
        if constexpr (ALIGN_EPI) { if (wr == 1) PG8_BAR; }
    }
    PG8_WAIT_V(0);
    if constexpr (!ALIGN_EPI) { if (wr == 0) PG8_BAR; }
    PG8_BAR;
    if constexpr (Epi::AFTER_DRAIN) { E.fused(acc, cur, wr, wc, fr, fq, lds, wid, lane); S.done(cur); }
#undef PG8_SA
#undef PG8_SB
#undef PG8_STAGE
#undef PG8_LDA
#undef PG8_LDB
#undef PG8_MMA
#undef PG8_WAIT_V
#undef PG8_WAIT_L
#undef PG8_BAR
#undef PG8_SCHED
}
}
#include <hip/hip_bf16.h>
#include <cmath>
namespace attn_body {
using bf16=__hip_bfloat16;
using bf16x8=__attribute__((ext_vector_type(8)))short;
using s16x4=__attribute__((ext_vector_type(4)))short;
using f32x16=__attribute__((ext_vector_type(16)))float;
using u32x4=__attribute__((ext_vector_type(4)))unsigned;
constexpr int BATCH=2,NHEAD=16,SEQ=4096,D=64,DM=10240,OPITCH=1024;
constexpr int NW=8,QBLK=32,QB=QBLK*NW,KVBLK=64,NQB=SEQ/QB;
constexpr int ATTN_PITCH=DM, ATTN_UNIT_ROWS=QB;
__device__ __forceinline__ int crow(int r,int hi){return (r&3)+8*(r>>2)+4*hi;}
#define SBAR() __builtin_amdgcn_sched_barrier(0)
__device__ __forceinline__ void cmask(f32x16&p0,f32x16&p1,int jb,int qrel,int hi){
  const float NEG=-INFINITY; int kb=64*jb+4*hi;
  #pragma unroll
  for(int r=0;r<16;++r){int kv=kb+(r&3)+8*(r>>2); if(kv>qrel)p0[r]=NEG; if(kv+32>qrel)p1[r]=NEG;}
}

constexpr int NSLOT=3, SLOTB=8192;
constexpr int LDS_K=0, LDS_V=NSLOT*SLOTB, LDS_WS=2*NSLOT*SLOTB, LDS_OST=LDS_WS+NW*64*4, LDS_MSK=LDS_OST+NW*4096, LDS_BYTES=LDS_MSK+NW*768;
constexpr float C2=0.125f*1.4426950408889634f;
__device__ __forceinline__ void glds16(const void*gsrc,unsigned lds_dst){unsigned keep;
  asm volatile("s_mov_b32 %0, m0\n\ts_mov_b32 m0, %2\n\ts_nop 0\n\tglobal_load_lds_dwordx4 %1, off\n\ts_mov_b32 m0, %0":"=&s"(keep):"v"(gsrc),"s"(lds_dst):"memory");}
__device__ __forceinline__ void glds4(const void*sbase,unsigned voff,unsigned lds_dst){unsigned keep;
  asm volatile("s_mov_b32 %0, m0\n\ts_mov_b32 m0, %3\n\ts_nop 4\n\tglobal_load_lds_dword %1, %2\n\ts_mov_b32 m0, %0":"=&s"(keep):"v"(voff),"s"(sbase),"s"(lds_dst):"memory");}
__device__ __forceinline__ float max3f(float a,float b,float c){float r;asm("v_max3_f32 %0, %1, %2, %3":"=v"(r):"v"(a),"v"(b),"v"(c));return r;}
__device__ __forceinline__ float max2f(float a,float b){float r;asm("v_max_f32_e32 %0, %1, %2":"=v"(r):"v"(a),"v"(b));return r;}
__device__ __forceinline__ float fadd_s(float a,float b){float r;asm("v_add_f32_e32 %0, %1, %2":"=v"(r):"v"(a),"v"(b));return r;}
__device__ __forceinline__ float fsub_s(float a,float b){float r;asm("v_sub_f32_e32 %0, %1, %2":"=v"(r):"v"(a),"v"(b));return r;}
typedef float f32x2_t __attribute__((ext_vector_type(2))); typedef __bf16 bf16x2_t __attribute__((ext_vector_type(2)));
__device__ __forceinline__ unsigned cvtpk_s(float lo,float hi){f32x2_t v={lo,hi};bf16x2_t b=__builtin_convertvector(v,bf16x2_t);return __builtin_bit_cast(unsigned,b);}
#define WAIT_BAR(N) asm volatile("s_waitcnt vmcnt(" #N ") lgkmcnt(0)\n\ts_barrier":::"memory")

__device__ __forceinline__ void qkt(f32x16&p0,f32x16&p1,const char*Kslot,const bf16x8*qr,const f32x16&negm,int r32,int hi){
  const char*kb=Kslot+hi*1024+r32*16;
  #pragma unroll
  for(int d0=0;d0<4;++d0){
    const bf16x8 b0=*reinterpret_cast<const bf16x8*>(kb+d0*2048);
    const bf16x8 b1=*reinterpret_cast<const bf16x8*>(kb+d0*2048+512);
    if(d0==0){p0=__builtin_amdgcn_mfma_f32_32x32x16_bf16(b0,qr[0],negm,0,0,0);p1=__builtin_amdgcn_mfma_f32_32x32x16_bf16(b1,qr[0],negm,0,0,0);}
    else{p0=__builtin_amdgcn_mfma_f32_32x32x16_bf16(b0,qr[d0],p0,0,0,0);p1=__builtin_amdgcn_mfma_f32_32x32x16_bf16(b1,qr[d0],p1,0,0,0);}}
}
typedef __attribute__((address_space(3))) const char* lds_cptr;
typedef short v4i16_t __attribute__((ext_vector_type(4)));
__device__ __forceinline__ void kload8(bf16x8*kf,lds_cptr kp){
  kf[0]=*(const __attribute__((address_space(3))) bf16x8*)(kp);      kf[1]=*(const __attribute__((address_space(3))) bf16x8*)(kp+512);
  kf[2]=*(const __attribute__((address_space(3))) bf16x8*)(kp+2048); kf[3]=*(const __attribute__((address_space(3))) bf16x8*)(kp+2560);
  kf[4]=*(const __attribute__((address_space(3))) bf16x8*)(kp+4096); kf[5]=*(const __attribute__((address_space(3))) bf16x8*)(kp+4608);
  kf[6]=*(const __attribute__((address_space(3))) bf16x8*)(kp+6144); kf[7]=*(const __attribute__((address_space(3))) bf16x8*)(kp+6656);
}
__device__ __forceinline__ void kload2(bf16x8*kf,lds_cptr kp,int j){ kf[2*j]=*(const __attribute__((address_space(3))) bf16x8*)(kp+j*2048); kf[2*j+1]=*(const __attribute__((address_space(3))) bf16x8*)(kp+j*2048+512); }
__device__ __forceinline__ s16x4 vtr(lds_cptr p){ return __builtin_bit_cast(s16x4,__builtin_amdgcn_ds_read_tr16_b64_v4i16((__attribute__((address_space(3))) v4i16_t*)p)); }
__device__ __forceinline__ float rowmax(const f32x16&p0,const f32x16&p1){
  float a=max3f(p0[0],p0[1],p1[0]),b=max3f(p0[2],p0[3],p1[1]);a=max3f(a,p1[2],p1[3]);
  #pragma unroll
  for(int r=4;r<16;r+=4){a=max3f(a,p0[r],p0[r+1]);b=max3f(b,p0[r+2],p0[r+3]);a=max3f(a,p1[r],p1[r+1]);b=max3f(b,p1[r+2],p1[r+3]);}
  const float m=max2f(a,b);
  auto rr=__builtin_amdgcn_permlane32_swap(__float_as_uint(m),__float_as_uint(m),false,false);
  return max2f(__uint_as_float(rr[0]),__uint_as_float(rr[1]));
}
__device__ __forceinline__ void pv(f32x16*o,int vb,bf16x8 pa0,bf16x8 pa1,bf16x8 pa2,bf16x8 pa3){
  #pragma unroll
  for(int d0=0;d0<2;++d0){s16x4 lo[4],hi[4];
    #pragma unroll
    for(int ks=0;ks<4;++ks){
      asm volatile("ds_read_b64_tr_b16 %0,%1 offset:%c2":"=&v"(lo[ks]):"v"(vb),"i"(d0*4096+ks*1024):"memory");
      asm volatile("ds_read_b64_tr_b16 %0,%1 offset:%c2":"=&v"(hi[ks]):"v"(vb),"i"(d0*4096+ks*1024+512):"memory");}
    asm volatile("s_waitcnt lgkmcnt(0)":::"memory");SBAR();
    #define PK(k) (bf16x8){lo[k][0],lo[k][1],lo[k][2],lo[k][3],hi[k][0],hi[k][1],hi[k][2],hi[k][3]}
    o[d0]=__builtin_amdgcn_mfma_f32_32x32x16_bf16(pa0,PK(0),o[d0],0,0,0);
    o[d0]=__builtin_amdgcn_mfma_f32_32x32x16_bf16(pa1,PK(1),o[d0],0,0,0);
    o[d0]=__builtin_amdgcn_mfma_f32_32x32x16_bf16(pa2,PK(2),o[d0],0,0,0);
    o[d0]=__builtin_amdgcn_mfma_f32_32x32x16_bf16(pa3,PK(3),o[d0],0,0,0);
    #undef PK
  }
}

#ifndef ATTN_STORE16
#define ATTN_STORE16(p,v) (*(u32x4*)(p)=(v))
#endif
template<int THRL> __device__ __forceinline__ void attn_unit(int b,int h,int qb,const bf16*Q,const bf16*K,const bf16*V,bf16*O,const unsigned*MASK32,char*shm){
  const int tid=threadIdx.x,lane=tid&63,r32=lane&31,hi=lane>>5; const int wid=__builtin_amdgcn_readfirstlane(tid>>6);
  const long rowbase=(long)b*SEQ; const int q0=qb*QB;
  const bf16*Qw=Q+(rowbase+q0+wid*QBLK)*DM+h*D;
  const bf16*Kh=K+rowbase*DM+h*D,*Vh=V+rowbase*DM+h*D;
  const unsigned lds0=(unsigned)(uintptr_t)shm;
  float*wsf=(float*)(shm+LDS_WS)+wid*64;
  const bf16*ksrc=Kh+(long)lane*DM+wid*8;
  const bf16*vsrc=Vh+(long)(16*(wid&3)+(lane>>2))*DM+(wid>>2)*32+(lane&3)*8;
  const unsigned kdst=lds0+LDS_K+wid*1024, vdst=lds0+LDS_V+wid*1024, mdst=lds0+LDS_MSK+wid*768;
  const unsigned*msrc=MASK32+(rowbase+q0+wid*QBLK)*128;
  #define DMA_M(t,slot) glds4(msrc+2*(t),(unsigned)((lane>>1)*512+(lane&1)*4),(unsigned)__builtin_amdgcn_readfirstlane(mdst+(slot)))
  #define MSK(v,w,bit) __uint_as_float(__float_as_uint(v)&(unsigned)__builtin_amdgcn_sbfe((int)(w),(bit),1))
  #define DMA_K(t,slot) glds16(ksrc+(long)(t)*KVBLK*DM,(unsigned)__builtin_amdgcn_readfirstlane(kdst+(slot)))
  #define DMA_V(t,slot) glds16(vsrc+(long)(t)*KVBLK*DM,(unsigned)__builtin_amdgcn_readfirstlane(vdst+(slot)))
  const int vb0=(int)(lds0+LDS_V)+((lane>>4)&1)*32+(lane&3)*8+(4*hi+((lane&15)>>2))*64;
  const char*Kbase=shm+LDS_K; bf16x8 kf[8];
  const lds_cptr shm3=(lds_cptr)shm; const lds_cptr kp0=shm3+LDS_K+hi*1024+r32*16; const lds_cptr vp0=shm3+LDS_V+((lane>>4)&1)*32+(lane&3)*8+(4*hi+((lane&15)>>2))*64;
  const lds_cptr mp0=shm3+LDS_MSK+wid*768+r32*8;
  const int NT=(q0+QB)/KVBLK;
  DMA_M(0,0);DMA_M(1,256);DMA_K(0,0);DMA_V(0,0);DMA_K(1,SLOTB);
  bf16x8 qr[4];
  #pragma unroll
  for(int d0=0;d0<4;++d0)qr[d0]=*reinterpret_cast<const bf16x8*>(&Qw[(long)r32*DM+d0*16+hi*8]);
  float mhat=0.f,l_reg=0.f;f32x16 o[2];o[0]=f32x16{};o[1]=f32x16{};f32x16 negm=f32x16{};asm volatile("":"+v"(negm));
  #define CMASK(P0,P1,t) do{}while(0)
  bool resc=false;
  #define START(P0,P1) do{ const float rm=rowmax(P0,P1); resc=false; \
    { const float dl=rm; mhat=fadd_s(mhat,dl); \
      _Pragma("unroll") for(int r=0;r<16;++r){P0[r]=fsub_s(P0[r],dl);P1[r]=fsub_s(P1[r],dl);} \
      _Pragma("unroll") for(int r=0;r<16;++r)negm[r]=-mhat; asm volatile("":"+v"(negm)); } \
    _Pragma("unroll") for(int r=0;r<16;++r)P0[r]=__builtin_amdgcn_exp2f(P0[r]); }while(0)
  #define RESC() do{ if(resc){ asm volatile("s_waitcnt lgkmcnt(0)":::"memory"); \
      _Pragma("unroll") for(int d_=0;d_<2;++d_) _Pragma("unroll") for(int r=0;r<16;++r)o[d_][r]*=wsf[crow(r,hi)]; } }while(0)
  f32x16 pA0,pA1,pB0,pB1;
  int sl_prev=0,sl_cur=0,sl_next=SLOTB;
  #define ROT() do{sl_prev=sl_cur;sl_cur=sl_next;sl_next=(sl_next==(NSLOT-1)*SLOTB)?0:sl_next+SLOTB;}while(0)
  DMA_K(2,2*SLOTB);
  WAIT_BAR(3);
  qkt(pA0,pA1,Kbase,qr,negm,r32,hi);asm volatile("s_nop 15\n\ts_nop 7":"+v"(pA0),"+v"(pA1));CMASK(pA0,pA1,0);
  START(pA0,pA1);
  _Pragma("unroll") for(int r=0;r<16;++r)pA1[r]=__builtin_amdgcn_exp2f(pA1[r]);
  { const unsigned long long mw_=*(const __attribute__((address_space(3))) unsigned long long*)(mp0); const unsigned mlo_=(unsigned)mw_>>(4*hi), mhi_=(unsigned)(mw_>>32)>>(4*hi);
    _Pragma("unroll") for(int r=0;r<16;++r){ pA0[r]=MSK(pA0[r],mlo_,(r&3)+8*(r>>2)); pA1[r]=MSK(pA1[r],mhi_,(r&3)+8*(r>>2)); } }
  WAIT_BAR(0);
  DMA_K(3,0);DMA_V(1,SLOTB);DMA_M(2,512);
  ROT();
  kload8(kf,kp0+sl_cur);
  WAIT_BAR(3);
  s16x4 vlo[8],vhi[8]; u32x4 pw0,pw1,pw2,pw3;
  #define PKW(P,B) cvtpk_s(P[B],P[B+1])
  #define PAF(k) __builtin_bit_cast(bf16x8,pw##k)
  #define VFR(i) (bf16x8){vlo[i][0],vlo[i][1],vlo[i][2],vlo[i][3],vhi[i][0],vhi[i][1],vhi[i][2],vhi[i][3]}
  #define PIN(x) asm volatile("":"+v"(x))
  #define MX3(a,b,c) __builtin_fmaxf(__builtin_fmaxf((a),(b)),(c))
  #define GAPA(MF,A0,A1,A2,A3,W0,W1,PW) do{ MF; sacc+=A0; sacc+=A1; sacc+=A2; sacc+=A3; PIN(sacc); W0; W1; PIN(PW); SBAR(); }while(0)
  #define EX(v) __builtin_amdgcn_exp2f(v)
  #define GAPB(MF,X,B,MW) do{ MF; X[B]=MSK(EX(X[B]),MW,2*(B)); X[B+1]=MSK(EX(X[B+1]),MW,2*(B)+1); X[B+2]=MSK(EX(X[B+2]),MW,2*(B)+2); X[B+3]=MSK(EX(X[B+3]),MW,2*(B)+3); PIN(X); SBAR(); }while(0)
  #define VRD(i) do{ vlo[i]=vtr(vp_+(((i)>>2)*4096+((i)&3)*1024)); vhi[i]=vtr(vp_+(((i)>>2)*4096+((i)&3)*1024+512)); }while(0)
  #define KRD(G,j) do{ if(G){ kload2(kf,kp0+sl_next,j); SBAR(); } }while(0)
  #define STEP(C0,C1,P0,P1,t,GK,GV,GL,GM) do{ SBAR(); \
    const lds_cptr vp_=vp0+sl_prev; \
    VRD(0); SBAR(); float sacc=(P0[0]+P0[1]); \
    GAPA(C0=__builtin_amdgcn_mfma_f32_32x32x16_bf16(kf[0],qr[0],negm,0,0,0), P0[2],P0[3],P0[4],P0[5],     pw0[0]=PKW(P0,0), pw0[1]=PKW(P0,2), pw0); \
    VRD(4); SBAR(); GAPA(C1=__builtin_amdgcn_mfma_f32_32x32x16_bf16(kf[1],qr[0],negm,0,0,0), P0[6],P0[7],P0[8],P0[9],     pw0[2]=PKW(P0,4), pw0[3]=PKW(P0,6), pw0); \
    VRD(1); SBAR(); GAPA(C0=__builtin_amdgcn_mfma_f32_32x32x16_bf16(kf[2],qr[1],C0,0,0,0),   P0[10],P0[11],P0[12],P0[13], pw1[0]=PKW(P0,8), pw1[1]=PKW(P0,10), pw1); \
    VRD(5); SBAR(); GAPA(C1=__builtin_amdgcn_mfma_f32_32x32x16_bf16(kf[3],qr[1],C1,0,0,0),   P0[14],P0[15],P1[0],P1[1],   pw1[2]=PKW(P0,12),pw1[3]=PKW(P0,14), pw1); \
    VRD(2); SBAR(); GAPA(C0=__builtin_amdgcn_mfma_f32_32x32x16_bf16(kf[4],qr[2],C0,0,0,0),   P1[2],P1[3],P1[4],P1[5],     pw2[0]=PKW(P1,0), pw2[1]=PKW(P1,2), pw2); \
    VRD(6); SBAR(); GAPA(C1=__builtin_amdgcn_mfma_f32_32x32x16_bf16(kf[5],qr[2],C1,0,0,0),   P1[6],P1[7],P1[8],P1[9],     pw2[2]=PKW(P1,4), pw2[3]=PKW(P1,6), pw2); \
    VRD(3); SBAR(); GAPA(C0=__builtin_amdgcn_mfma_f32_32x32x16_bf16(kf[6],qr[3],C0,0,0,0),   P1[10],P1[11],P1[12],P1[13], pw3[0]=PKW(P1,8), pw3[1]=PKW(P1,10), pw3); \
    VRD(7); SBAR(); GAPA(C1=__builtin_amdgcn_mfma_f32_32x32x16_bf16(kf[7],qr[3],C1,0,0,0),   P1[14],P1[15],0.f,0.f,       pw3[2]=PKW(P1,12),pw3[3]=PKW(P1,14), pw3); \
    l_reg+=sacc; \
    const unsigned long long mw_=*(const __attribute__((address_space(3))) unsigned long long*)(mp0+(sl_cur>>5)); \
    if(GK){DMA_K((t)+3,sl_cur);} if(GV){DMA_V((t)+1,sl_next);} if(GM){DMA_M((t)+2,sl_prev>>5);} \
    const unsigned mlo_=(unsigned)mw_>>(4*hi), mhi_=(unsigned)(mw_>>32)>>(4*hi); \
    { float a=MX3(C0[0],C0[1],C1[0]),b=MX3(C0[2],C0[3],C1[1]); a=MX3(a,C1[2],C1[3]); \
      _Pragma("unroll") for(int r=4;r<16;r+=4){a=MX3(a,C0[r],C0[r+1]);b=MX3(b,C0[r+2],C0[r+3]);a=MX3(a,C1[r],C1[r+1]);b=MX3(b,C1[r+2],C1[r+3]);} \
      float rm=__builtin_fmaxf(a,b); { auto rr=__builtin_amdgcn_permlane32_swap(__float_as_uint(rm),__float_as_uint(rm),false,false); rm=__builtin_fmaxf(__uint_as_float(rr[0]),__uint_as_float(rr[1])); } \
      resc=false; \
      if(__builtin_expect(__any(rm>(float)THRL),0)){ const float dl=__builtin_fmaxf(rm,0.f); mhat+=dl; \
        _Pragma("unroll") for(int r=0;r<16;++r){C0[r]-=dl;C1[r]-=dl;} \
        _Pragma("unroll") for(int r=0;r<16;++r)negm[r]=-mhat; asm volatile("":"+v"(negm)); \
        const float f=__builtin_amdgcn_exp2f(-dl); l_reg*=f; if(hi==0)wsf[r32]=f; resc=true; } } \
    SBAR(); \
    GAPB(o[0]=__builtin_amdgcn_mfma_f32_32x32x16_bf16(PAF(0),VFR(0),o[0],0,0,0), C0,0,mlo_); \
    GAPB(o[1]=__builtin_amdgcn_mfma_f32_32x32x16_bf16(PAF(0),VFR(4),o[1],0,0,0), C0,4,mlo_); \
    KRD(GL,0); GAPB(o[0]=__builtin_amdgcn_mfma_f32_32x32x16_bf16(PAF(1),VFR(1),o[0],0,0,0), C0,8,mlo_); \
    KRD(GL,1); GAPB(o[1]=__builtin_amdgcn_mfma_f32_32x32x16_bf16(PAF(1),VFR(5),o[1],0,0,0), C0,12,mlo_); \
    KRD(GL,2); GAPB(o[0]=__builtin_amdgcn_mfma_f32_32x32x16_bf16(PAF(2),VFR(2),o[0],0,0,0), C1,0,mhi_); \
    KRD(GL,3); GAPB(o[1]=__builtin_amdgcn_mfma_f32_32x32x16_bf16(PAF(2),VFR(6),o[1],0,0,0), C1,4,mhi_); \
    GAPB(o[0]=__builtin_amdgcn_mfma_f32_32x32x16_bf16(PAF(3),VFR(3),o[0],0,0,0), C1,8,mhi_); \
    GAPB(o[1]=__builtin_amdgcn_mfma_f32_32x32x16_bf16(PAF(3),VFR(7),o[1],0,0,0), C1,12,mhi_); \
    }while(0)
  int t=1;
  for(;t+5<NT;t+=2){
    STEP(pB0,pB1,pA0,pA1,t,true,true,true,true);     WAIT_BAR(3); RESC(); ROT();
    STEP(pA0,pA1,pB0,pB1,t+1,true,true,true,true);   WAIT_BAR(3); RESC(); ROT();
  }
  #define ENDW(tt) do{ if((tt)+3<NT){WAIT_BAR(3);} else if((tt)+2<NT){WAIT_BAR(2);} else {WAIT_BAR(0);} }while(0)
  for(;t+1<NT;t+=2){
    STEP(pB0,pB1,pA0,pA1,t,(t+3<NT),(t+1<NT),(t+1<NT),(t+2<NT));       ENDW(t);   RESC(); ROT();
    STEP(pA0,pA1,pB0,pB1,t+1,(t+4<NT),(t+2<NT),(t+2<NT),(t+3<NT));     ENDW(t+1); RESC(); ROT();
  }
  STEP(pB0,pB1,pA0,pA1,NT-1,false,false,false,false); RESC();
  { float sacc=pB0[0]+pB0[1]; _Pragma("unroll") for(int r=2;r<16;++r)sacc+=pB0[r]; _Pragma("unroll") for(int r=0;r<16;++r)sacc+=pB1[r]; l_reg+=sacc;
    pw0=(u32x4){PKW(pB0,0),PKW(pB0,2),PKW(pB0,4),PKW(pB0,6)};pw1=(u32x4){PKW(pB0,8),PKW(pB0,10),PKW(pB0,12),PKW(pB0,14)};pw2=(u32x4){PKW(pB1,0),PKW(pB1,2),PKW(pB1,4),PKW(pB1,6)};pw3=(u32x4){PKW(pB1,8),PKW(pB1,10),PKW(pB1,12),PKW(pB1,14)};
    SBAR(); pv(o,vb0+sl_cur,PAF(0),PAF(1),PAF(2),PAF(3)); }
  #undef PKW
  #undef PAF
  #undef VFR
  #undef PIN
  #undef MX3
  #undef GAPA
  #undef GAPB
  #undef EX
  #undef VRD
  #undef KRD
  #undef STEP
  #undef ENDW
  {auto rr=__builtin_amdgcn_permlane32_swap(__float_as_uint(l_reg),__float_as_uint(l_reg),false,false);l_reg=__uint_as_float(rr[0])+__uint_as_float(rr[1]);}
  if(hi==0)wsf[32+r32]=l_reg;asm volatile("s_waitcnt lgkmcnt(0)":::"memory");
  float rli[16];
  #pragma unroll
  for(int r=0;r<16;++r)rli[r]=__builtin_amdgcn_rcpf(wsf[32+crow(r,hi)]);
  bf16*Ow=O+(rowbase+q0+wid*QBLK)*OPITCH+h*D;
  { bf16*stg=(bf16*)(shm+LDS_OST)+wid*2048;
    #pragma unroll
    for(int r=0;r<16;++r){const int orow=crow(r,hi);
      #pragma unroll
      for(int d0=0;d0<2;++d0)stg[orow*64+d0*32+r32]=__float2bfloat16(o[d0][r]*rli[r]);}
    asm volatile("s_waitcnt lgkmcnt(0)":::"memory");
    #pragma unroll
    for(int i=0;i<4;++i){const int row=i*8+(lane>>3),ch=lane&7; const u32x4 v=*(const u32x4*)(stg+row*64+ch*8); ATTN_STORE16(Ow+(long)row*OPITCH+ch*8,v);} }
  asm volatile("s_waitcnt lgkmcnt(0)\n\ts_barrier":::"memory");
  #undef DMA_K
  #undef DMA_V
  #undef DMA_M
  #undef MSK
  #undef CMASK
  #undef START
  #undef RESC
  #undef ROT
}
constexpr int ATTN_LDS_BYTES=LDS_BYTES;
struct AttnTensors { const bf16* Q; const bf16* K; const bf16* V; bf16* O; const unsigned* MASK32; };
struct AttnUnit { int bh; int qb; };
struct StaticOrder {
  int vcu, G;
  __device__ __forceinline__ explicit StaticOrder(int grid,int block):vcu((grid%8==0)?(block%8)*(grid/8)+block/8:block),G(grid){}
  __device__ __forceinline__ bool next(int i,AttnUnit&u)const{ const int p=vcu+(i>>1)*G; if(p>=256)return false; const int s=p&7; u.bh=p>>3; u.qb=(i&1)?15-s:s; return true; }
  __device__ __forceinline__ void a_ready(const AttnUnit&)const{}
  __device__ __forceinline__ void done(const AttnUnit&)const{}
};
template<class Sched,int THRL=8> __device__ __forceinline__ void attn_phase(char*lds,const AttnTensors&T,const Sched&S){
  AttnUnit u;
  for(int i=0;S.next(i,u);++i){ S.a_ready(u); attn_unit<THRL>(u.bh/NHEAD,u.bh%NHEAD,u.qb,T.Q,T.K,T.V,T.O,T.MASK32,lds); S.done(u); }
}
#undef SBAR
#undef WAIT_BAR
}
#define GAS __attribute__((address_space(1)))
#define LAS __attribute__((address_space(3)))
typedef unsigned short bf16;
typedef unsigned v4u __attribute__((ext_vector_type(4)));
typedef float f32x4 __attribute__((ext_vector_type(4)));
typedef short bf16x8 __attribute__((ext_vector_type(8)));
typedef GAS unsigned gu32;
typedef GAS unsigned long long gu64;
#define RLX_AGENT __ATOMIC_RELAXED, __HIP_MEMORY_SCOPE_AGENT
#define LDS_WAIT() asm volatile("s_waitcnt lgkmcnt(0)" ::: "memory")
#define VM_WAIT() asm volatile("s_waitcnt vmcnt(0)" ::: "memory")
__device__ __forceinline__ unsigned long long rt() { return __builtin_amdgcn_s_memrealtime(); }
__device__ __forceinline__ unsigned f2bf(float f) { unsigned u = __builtin_bit_cast(unsigned, f); return (u + 0x7fffu + ((u >> 16) & 1u)) >> 16; }
__device__ __forceinline__ unsigned pk2(float lo, float hi) { return f2bf(lo) | (f2bf(hi) << 16); }
#define XB_TMO      128
#define XB_XCNT(j)  (256  + 64 * (j))
#define XB_XSUB(j)  (1280 + 64 * (j))
#define XB_XGEN(j)  (2304 + 64 * (j))
#define XB_TOP      3328
#define XB_TOPGEN   3392
#define XCD_BAR_WORDS 3456
#define XB_SPIN_CAP (1u << 18)

__device__ __forceinline__ unsigned xb_ld(unsigned* p)              { return __hip_atomic_load(p, __ATOMIC_RELAXED, __HIP_MEMORY_SCOPE_AGENT); }
__device__ __forceinline__ unsigned xb_add(unsigned* p, unsigned v) { return __hip_atomic_fetch_add(p, v, __ATOMIC_RELAXED, __HIP_MEMORY_SCOPE_AGENT); }
__device__ __forceinline__ unsigned xb_xcc_id() { return (unsigned)__builtin_amdgcn_s_getreg((3 << 11) | 20) & 0xFu; }
#define XB_SPIN(cond, bar) do { unsigned _sp = 0; while (cond) { __builtin_amdgcn_s_sleep(1); \
    if ((++_sp & 255u) == 0u) { if (xb_ld(&(bar)[XB_TMO])) break; if (_sp > XB_SPIN_CAP) { atomicAdd(&(bar)[XB_TMO], 1u); break; } } } } while (0)

struct XcdBarrier {
    unsigned* bar; unsigned x;
    volatile LAS unsigned* st;
};

__device__ __forceinline__ XcdBarrier xcd_barrier_post(unsigned* bar, volatile LAS unsigned* st) {
    XcdBarrier b; b.bar = bar; b.x = xb_xcc_id(); b.st = st;
    if (threadIdx.x == 0) (void)xb_add(&bar[XB_XCNT(b.x)], 1u);
    return b;
}
__device__ __forceinline__ void xcd_barrier_complete(unsigned* bar, unsigned x, unsigned& nloc, unsigned& nx) {
    const unsigned G = gridDim.x * gridDim.y * gridDim.z;
    unsigned sum, cnt, mine, sp = 0u;
    for (;;) {
        sum = 0u; cnt = 0u; mine = 0u;
#pragma unroll
        for (unsigned j = 0; j < 16; ++j) { const unsigned c = xb_ld(&bar[XB_XCNT(j)]); sum += c; cnt += (c > 0u) ? 1u : 0u; mine = (j == x) ? c : mine; }
        if (sum == G) break;
        __builtin_amdgcn_s_sleep(1);
        if ((++sp & 255u) == 0u) { if (xb_ld(&bar[XB_TMO])) break; if (sp > XB_SPIN_CAP) { atomicAdd(&bar[XB_TMO], 1u); break; } }
    }
    nloc = mine > 0u ? mine : 1u; nx = cnt > 0u ? cnt : 1u;
}

__device__ __forceinline__ void xcd_barrier(const XcdBarrier& b) {
    asm volatile("s_waitcnt vmcnt(0)" ::: "memory");
    __syncthreads();
    if (threadIdx.x == 0) {
        unsigned* bar = b.bar;
        __builtin_amdgcn_s_waitcnt(0);
        unsigned nloc = b.st[0], nx = b.st[1];
        if (nloc == 0u) { xcd_barrier_complete(bar, b.x, nloc, nx); b.st[0] = nloc; b.st[1] = nx; }
        const unsigned old = xb_add(&bar[XB_XSUB(b.x)], 1u);
        const unsigned gen = old / nloc;
        if (old + 1u == (gen + 1u) * nloc) {
            __builtin_amdgcn_fence(__ATOMIC_RELEASE, "agent");
            asm volatile("s_waitcnt vmcnt(0)" ::: "memory");
            const unsigned og = xb_add(&bar[XB_TOP], 1u);
            const unsigned tg = og / nx;
            if (og + 1u == (tg + 1u) * nx) xb_add(&bar[XB_TOPGEN], 1u);
            else XB_SPIN(xb_ld(&bar[XB_TOPGEN]) == tg, bar);
            __builtin_amdgcn_fence(__ATOMIC_ACQUIRE, "agent");
            xb_add(&bar[XB_XGEN(b.x)], 1u);
            asm volatile("s_waitcnt vmcnt(0)" ::: "memory");
        } else {
            XB_SPIN(xb_ld(&bar[XB_XGEN(b.x)]) == gen, bar);
            __builtin_amdgcn_fence(__ATOMIC_ACQUIRE, "agent");
            asm volatile("s_waitcnt vmcnt(0)" ::: "memory");
        }
    }
    __syncthreads();
}
#ifndef DUP_SUB
#define DUP_SUB 0
#endif
constexpr int NWAVES = 8;
constexpr int DM = 2048, NBATCH = 2, SEQ = 4096, MTOK = NBATCH * SEQ;
constexpr int DCONV = 1024, CONVW = 31, NHEAD = 16, HDIM = 64, TOPK = 256, DFF = 5632;
constexpr int OFF_GLU = 0, OFF_Q = 2048, OFF_K = 3072, OFF_V = 4096, OFF_QI = 5120, OFF_G = 6144, D_IN = 10320;
constexpr int SRC_KI = 6144, SRC_G = 6224, NSMALL = 96;
constexpr int NP = 10240;
constexpr int NGU = 2 * DFF;
constexpr int KSPLIT = 8, NMOD = 6 * DM;
constexpr float EPS = 1e-6f;
constexpr float LOG2E = 1.4426950408889634f;

constexpr size_t MiB = 1u << 20;
constexpr size_t WS_CTL = 0, CTL_ZERO_BYTES = 1 * MiB;
constexpr size_t WS_MODP = 1 * MiB;
constexpr size_t WS_MODF = 4 * MiB;
constexpr size_t WS_BT_GU = 5 * MiB;
constexpr size_t WS_BT_DN = 49 * MiB;
constexpr size_t WS_BT_O = 71 * MiB;
constexpr size_t WS_BT_CO = 79 * MiB;
constexpr size_t WS_BT_AO = 83 * MiB;
constexpr size_t WS_BT_IN = 87 * MiB;
constexpr size_t WS_H = 128 * MiB;
constexpr size_t WS_PROJ = 160 * MiB;
constexpr size_t WS_CACT = 324 * MiB;
constexpr size_t WS_AOUT = 340 * MiB;
constexpr size_t WS_VT = 356 * MiB;
constexpr size_t WS_MASK = 372 * MiB;
constexpr size_t WS_KI = 376 * MiB;
constexpr size_t WS_WI = 377 * MiB;
constexpr size_t WS_END = 378 * MiB;
constexpr size_t WS_SCORES = 87 * MiB;
constexpr size_t WS_MERGED = 96 * MiB;
constexpr size_t WS_GU = 160 * MiB;
constexpr size_t WS_F = 248 * MiB;
constexpr int CW_BAR = 4096;

constexpr int RING_OFF = 0, RING_BYTES = 131072;
constexpr int LDSCTL_OFF = RING_BYTES, MISC_OFF = LDSCTL_OFF + 320;
constexpr int LDS_BYTES = 147456;

typedef float f32x16 __attribute__((ext_vector_type(16)));
typedef float f32x2v __attribute__((ext_vector_type(2)));
typedef unsigned u32x2v __attribute__((ext_vector_type(2)));

__device__ __forceinline__ float bf_lo(unsigned u) { return __builtin_bit_cast(float, u << 16); }
__device__ __forceinline__ float bf_hi(unsigned u) { return __builtin_bit_cast(float, u & 0xffff0000u); }
__device__ __forceinline__ float sigmoidf_fast(float v) { return __builtin_amdgcn_rcpf(1.0f + __builtin_amdgcn_exp2f(-v * LOG2E)); }
__device__ __forceinline__ float wave_sum(float v) {
#pragma unroll
    for (int o = 1; o < 64; o <<= 1) v += __shfl_xor(v, o);
    return v;
}

struct EpiStoreBf16 {
    static constexpr bool PERM = true, AFTER_DRAIN = false;
    bf16* O; int ldc; int q_lo, q_hi; float qscale;
    __device__ __forceinline__ void operator()(const f32x4 (&acc)[2][2][4][2], const pg8::Unit& u, int wr, int wc, int fr, int fq) const {
        const int row0 = u.pm * pg8::BM + wr * 64 + fr, colt = u.pn * pg8::BM, col0 = colt + wc * 32 + 8 * fq;
        const float sc = (colt >= q_lo && colt < q_hi) ? qscale : 1.0f;
#pragma unroll
        for (int ai = 0; ai < 2; ++ai)
#pragma unroll
            for (int m = 0; m < 4; ++m) { bf16* rowp = O + (size_t)(row0 + ai * pg8::HALF + m * 16) * ldc + col0;
#pragma unroll
                for (int bj = 0; bj < 2; ++bj) { const f32x4 v0 = acc[ai][bj][m][0] * sc, v1 = acc[ai][bj][m][1] * sc;
                    v4u w; w.x = pg8::cvt_pk_bf16(v0[0], v0[1]); w.y = pg8::cvt_pk_bf16(v0[2], v0[3]); w.z = pg8::cvt_pk_bf16(v1[0], v1[1]); w.w = pg8::cvt_pk_bf16(v1[2], v1[3]);
                    *(v4u*)(rowp + bj * pg8::HALF) = w; } }
    }
};
struct EpiStoreF32 {
    static constexpr bool PERM = false, AFTER_DRAIN = false;
    float* C; int ldc;
    __device__ __forceinline__ void operator()(const f32x4 (&acc)[2][2][4][2], const pg8::Unit& u, int wr, int wc, int fr, int fq) const {
        const int row0 = u.pm * pg8::BM + wr * 64 + fr, col0 = u.pn * pg8::BM + wc * 32 + 4 * fq;
#pragma unroll
        for (int ai = 0; ai < 2; ++ai)
#pragma unroll
            for (int m = 0; m < 4; ++m) { float* rowp = C + (size_t)(row0 + ai * pg8::HALF + m * 16) * ldc + col0;
#pragma unroll
                for (int bj = 0; bj < 2; ++bj)
#pragma unroll
                    for (int n = 0; n < 2; ++n) *(f32x4*)(rowp + bj * pg8::HALF + n * 16) = acc[ai][bj][m][n]; }
    }
};
struct EpiGateConv {
    static constexpr bool PERM = true, AFTER_DRAIN = false;
    float* C; const bf16* G; int ldg;
    __device__ __forceinline__ void operator()(const f32x4 (&acc)[2][2][4][2], const pg8::Unit& u, int wr, int wc, int fr, int fq) const {
        const int row0 = u.pm * pg8::BM + wr * 64 + fr, col0 = u.pn * pg8::BM + wc * 32 + 8 * fq;
#pragma unroll
        for (int ai = 0; ai < 2; ++ai)
#pragma unroll
            for (int m = 0; m < 4; ++m) { const int row = row0 + ai * pg8::HALF + m * 16; float* rowp = C + (size_t)row * DM + col0; const bf16* gp = G + (size_t)row * ldg + col0;
#pragma unroll
                for (int bj = 0; bj < 2; ++bj) { const v4u g = *(const v4u*)(gp + bj * pg8::HALF); const f32x4 a0 = acc[ai][bj][m][0], a1 = acc[ai][bj][m][1];
                    f32x4 o0, o1;
                    o0[0] = a0[0] * sigmoidf_fast(bf_lo(g.x)); o0[1] = a0[1] * sigmoidf_fast(bf_hi(g.x)); o0[2] = a0[2] * sigmoidf_fast(bf_lo(g.y)); o0[3] = a0[3] * sigmoidf_fast(bf_hi(g.y));
                    o1[0] = a1[0] * sigmoidf_fast(bf_lo(g.z)); o1[1] = a1[1] * sigmoidf_fast(bf_hi(g.z)); o1[2] = a1[2] * sigmoidf_fast(bf_lo(g.w)); o1[3] = a1[3] * sigmoidf_fast(bf_hi(g.w));
                    *(f32x4*)(rowp + bj * pg8::HALF) = o0; *(f32x4*)(rowp + bj * pg8::HALF + 4) = o1; } }
    }
};
struct EpiGateAttn {
    static constexpr bool PERM = true, AFTER_DRAIN = false;
    const float* T; const bf16* G; int ldg; bf16* O;
    __device__ __forceinline__ void operator()(const f32x4 (&acc)[2][2][4][2], const pg8::Unit& u, int wr, int wc, int fr, int fq) const {
        const int row0 = u.pm * pg8::BM + wr * 64 + fr, col0 = u.pn * pg8::BM + wc * 32 + 8 * fq;
#pragma unroll
        for (int ai = 0; ai < 2; ++ai)
#pragma unroll
            for (int m = 0; m < 4; ++m) { const int row = row0 + ai * pg8::HALF + m * 16; const float* tp = T + (size_t)row * DM + col0; const bf16* gp = G + (size_t)row * ldg + col0; bf16* op = O + (size_t)row * DM + col0;
#pragma unroll
                for (int bj = 0; bj < 2; ++bj) { const v4u g = *(const v4u*)(gp + bj * pg8::HALF); const f32x4 t0 = *(const f32x4*)(tp + bj * pg8::HALF), t1 = *(const f32x4*)(tp + bj * pg8::HALF + 4);
                    const f32x4 a0 = acc[ai][bj][m][0], a1 = acc[ai][bj][m][1];
                    const float o0 = t0[0] + a0[0] * sigmoidf_fast(bf_lo(g.x)), o1 = t0[1] + a0[1] * sigmoidf_fast(bf_hi(g.x)), o2 = t0[2] + a0[2] * sigmoidf_fast(bf_lo(g.y)), o3 = t0[3] + a0[3] * sigmoidf_fast(bf_hi(g.y));
                    const float o4 = t1[0] + a1[0] * sigmoidf_fast(bf_lo(g.z)), o5 = t1[1] + a1[1] * sigmoidf_fast(bf_hi(g.z)), o6 = t1[2] + a1[2] * sigmoidf_fast(bf_lo(g.w)), o7 = t1[3] + a1[3] * sigmoidf_fast(bf_hi(g.w));
                    v4u w; w.x = pg8::cvt_pk_bf16(o0, o1); w.y = pg8::cvt_pk_bf16(o2, o3); w.z = pg8::cvt_pk_bf16(o4, o5); w.w = pg8::cvt_pk_bf16(o6, o7);
                    *(v4u*)(op + bj * pg8::HALF) = w; } }
    }
};
struct EpiSwiGLU {
    static constexpr bool PERM = true, AFTER_DRAIN = false;
    bf16* O;
    __device__ __forceinline__ void operator()(const f32x4 (&acc)[2][2][4][2], const pg8::Unit& u, int wr, int wc, int fr, int fq) const {
        const int row0 = u.pm * pg8::BM + wr * 64 + fr, col0 = (u.pn * pg8::BM + wc * 32 + 8 * fq) >> 1;
#pragma unroll
        for (int ai = 0; ai < 2; ++ai)
#pragma unroll
            for (int m = 0; m < 4; ++m) { bf16* rowp = O + (size_t)(row0 + ai * pg8::HALF + m * 16) * DFF + col0;
#pragma unroll
                for (int bj = 0; bj < 2; ++bj) { const f32x4 g = acc[ai][bj][m][0], up = acc[ai][bj][m][1];
                    const float h0 = g[0] * sigmoidf_fast(g[0]) * up[0], h1 = g[1] * sigmoidf_fast(g[1]) * up[1], h2 = g[2] * sigmoidf_fast(g[2]) * up[2], h3 = g[3] * sigmoidf_fast(g[3]) * up[3];
                    u32x2v w; w.x = pg8::cvt_pk_bf16(h0, h1); w.y = pg8::cvt_pk_bf16(h2, h3);
                    *(u32x2v*)(rowp + bj * (pg8::HALF / 2)) = w; } }
    }
};

struct Frame {
    LAS unsigned char* lds;
    volatile LAS unsigned* MISC;
    gu32* ctl;
    int tid, lane, wave, G, bid;
    float* out; unsigned char* ws;
};
template <int K> __device__ __forceinline__ const float* kin() {
    unsigned long long v;
    asm volatile("s_load_dwordx2 %0, %1, %2\n\ts_waitcnt lgkmcnt(0)" : "=s"(v) : "s"(__builtin_amdgcn_kernarg_segment_ptr()), "i"(8 * K));
    return (const float*)(const GAS float*)v;
}
enum { I_X = 0, I_C, I_WADA, I_BADA, I_GPREMIX, I_WIN, I_WDW, I_BDW, I_GLN, I_BLN, I_WCO, I_WAO, I_WO, I_GPOSTMIX, I_GPREFFN, I_WGATE, I_WUP, I_WDOWN, I_GPOSTFFN };

template <int MODE>
__device__ __forceinline__ void p0_transpose_item(const float* W, int K, int N, bf16* WT, int row_off, int item, int lane) {
    const int nblk = (N + 63) / 64, kb = item / nblk, nb = item % nblk, k0 = 64 * kb, gn = 64 * nb + lane;
    const bool ok = gn < N; const int gc = ok ? gn : N - 1;
    float v[64];
#pragma unroll
    for (int i = 0; i < 64; ++i) { const float* rowp = W + (size_t)(k0 + i) * N; v[i] = __builtin_nontemporal_load(rowp + gc); }
    if (ok) {
        if (MODE == 2 && gn >= SRC_KI && gn < SRC_G) {
            const int j = gn - SRC_KI, cb = j >> 5, r = j & 31;
            GAS v4u* dst = (GAS v4u*)(WT + (size_t)NP * K);
#pragma unroll
            for (int jj = 0; jj < 8; ++jj) { const int kk = k0 + 8 * jj, sI = kk >> 4, h2 = (kk >> 3) & 1;
                v4u o; o.x = pk2(v[8 * jj], v[8 * jj + 1]); o.y = pk2(v[8 * jj + 2], v[8 * jj + 3]); o.z = pk2(v[8 * jj + 4], v[8 * jj + 5]); o.w = pk2(v[8 * jj + 6], v[8 * jj + 7]);
                dst[(size_t)(sI * 3 + cb) * 64 + h2 * 32 + r] = o; }
        } else {
        const int dr = (MODE == 0) ? (row_off + gn) : (MODE == 1) ? (8 * (gn >> 2) + (gn & 3) + row_off) : (gn < SRC_KI ? gn : gn - (SRC_G - SRC_KI));
        GAS v4u* dst = (GAS v4u*)(WT + (size_t)dr * K + k0);
#pragma unroll
        for (int j = 0; j < 8; ++j) { v4u o; o.x = pk2(v[8 * j], v[8 * j + 1]); o.y = pk2(v[8 * j + 2], v[8 * j + 3]); o.z = pk2(v[8 * j + 4], v[8 * j + 5]); o.w = pk2(v[8 * j + 6], v[8 * j + 7]); dst[j] = o; } }
    }
}
constexpr int P0_I_IN = (DM / 64) * ((D_IN + 63) / 64), P0_I_GT = (DM / 64) * (DFF / 64), P0_I_DN = (DFF / 64) * (DM / 64), P0_I_O = (DM / 64) * (DM / 64), P0_I_CO = (DCONV / 64) * (DM / 64);
constexpr int P0_NITEMS = P0_I_IN + 2 * P0_I_GT + P0_I_DN + P0_I_O + 2 * P0_I_CO;
__device__ __forceinline__ void p0_item(Frame& F, int it) {
    bf16* bt_in = (bf16*)(F.ws + WS_BT_IN); bf16* bt_gu = (bf16*)(F.ws + WS_BT_GU); bf16* bt_dn = (bf16*)(F.ws + WS_BT_DN);
    bf16* bt_o = (bf16*)(F.ws + WS_BT_O); bf16* bt_co = (bf16*)(F.ws + WS_BT_CO); bf16* bt_ao = (bf16*)(F.ws + WS_BT_AO);
    int r = it;
    if (r < P0_I_IN) { p0_transpose_item<2>(kin<I_WIN>(), DM, D_IN, bt_in, 0, r, F.lane); return; } r -= P0_I_IN;
    if (r < P0_I_GT) { p0_transpose_item<1>(kin<I_WGATE>(), DM, DFF, bt_gu, 0, r, F.lane); return; } r -= P0_I_GT;
    if (r < P0_I_GT) { p0_transpose_item<1>(kin<I_WUP>(), DM, DFF, bt_gu, 4, r, F.lane); return; } r -= P0_I_GT;
    if (r < P0_I_DN) { p0_transpose_item<0>(kin<I_WDOWN>(), DFF, DM, bt_dn, 0, r, F.lane); return; } r -= P0_I_DN;
    if (r < P0_I_O) { p0_transpose_item<0>(kin<I_WO>(), DM, DM, bt_o, 0, r, F.lane); return; } r -= P0_I_O;
    if (r < P0_I_CO) { p0_transpose_item<0>(kin<I_WCO>(), DCONV, DM, bt_co, 0, r, F.lane); return; } r -= P0_I_CO;
    p0_transpose_item<0>(kin<I_WAO>(), DCONV, DM, bt_ao, 0, r, F.lane);
}
__device__ __forceinline__ void p0_prologue(Frame& F) {
    const int gw = F.bid * NWAVES + F.wave, NGW = F.G * NWAVES;
    constexpr int NGEMV = KSPLIT * (NMOD / 64);
    {
        const float* c = kin<I_C>(); const float* wada = kin<I_WADA>(); float* modp = (float*)(F.ws + WS_MODP);
        for (int unit = gw; unit < NGEMV; unit += NGW) {
            const int ks = unit / (NMOD / 64), nt = unit % (NMOD / 64), k0 = (DM / KSPLIT) * ks, col = 64 * nt + F.lane;
            float a0 = 0.f, a1 = 0.f;
            for (int kq = 0; kq < DM / KSPLIT; kq += 64) {
                const float c0 = c[k0 + kq + F.lane], c1 = c[DM + k0 + kq + F.lane];
                const float s0 = c0 / (1.0f + __expf(-c0)), s1 = c1 / (1.0f + __expf(-c1));
                const float* wp = wada + (size_t)(k0 + kq) * NMOD + col;
                for (int kk0 = 0; kk0 < 64; kk0 += 32) {
                    float w[32];
#pragma unroll
                    for (int q = 0; q < 32; ++q) w[q] = __builtin_nontemporal_load(wp + (size_t)(kk0 + q) * NMOD);
#pragma unroll
                    for (int q = 0; q < 32; ++q) { const float t0 = __builtin_bit_cast(float, __builtin_amdgcn_readlane(__builtin_bit_cast(int, s0), kk0 + q)), t1 = __builtin_bit_cast(float, __builtin_amdgcn_readlane(__builtin_bit_cast(int, s1), kk0 + q)); a0 += t0 * w[q]; a1 += t1 * w[q]; }
                }
            }
            modp[(size_t)(ks * 2 + 0) * NMOD + col] = a0;
            modp[(size_t)(ks * 2 + 1) * NMOD + col] = a1;
        }
    }
    if (NGW == 2048) {
        if (gw < NGEMV) { for (int j = 0; j < 7; ++j) p0_item(F, gw * 7 + j); }
        else { for (int it = NGEMV * 7 + (gw - NGEMV); it < P0_NITEMS; it += 2048 - NGEMV) p0_item(F, it); }
    } else { for (int it = gw; it < P0_NITEMS; it += NGW) p0_item(F, it); }
    {
        GAS v4u* z = (GAS v4u*)((bf16*)(F.ws + WS_BT_IN) + (size_t)NP * DM);
        for (int i = F.bid * (NWAVES * 64) + F.tid; i < 4096; i += F.G * NWAVES * 64) { const int sI = i >> 5, h2 = (i >> 4) & 1, rr = i & 15; z[(size_t)(sI * 3 + 2) * 64 + h2 * 32 + 16 + rr] = (v4u){0u, 0u, 0u, 0u}; }
    }
}

__device__ __forceinline__ float mod_sum(const float* modp, const float* bada, int bb, int col) {
    float s = bada[col];
#pragma unroll 8
    for (int ks = 0; ks < KSPLIT; ++ks) s += modp[(size_t)(ks * 2 + bb) * NMOD + col];
    return s;
}
__device__ __forceinline__ void p1_h1(Frame& F) {
    const float* modp = (const float*)(F.ws + WS_MODP); float* modf = (float*)(F.ws + WS_MODF); const float* bada = kin<I_BADA>();
    LAS float* scaleL = (LAS float*)(F.lds + RING_OFF); LAS float* shiftL = scaleL + DM;
    bf16* H = (bf16*)(F.ws + WS_H);
    for (int idx = F.bid * (NWAVES * 64) + F.tid; idx < 2 * NMOD; idx += F.G * NWAVES * 64) { const int bb = idx / NMOD, col = idx % NMOD; modf[idx] = mod_sum(modp, bada, bb, col); }
    for (int tile = F.bid; tile < MTOK / 32; tile += F.G) {
        const int bb = tile / (SEQ / 32);
        __syncthreads();
        for (int j = 0; j < 8; ++j) { const int col = F.tid + 512 * j; const float s = mod_sum(modp, bada, bb, col);
            if (col < DM) shiftL[col] = s; else scaleL[col - DM] = kin<I_GPREMIX>()[col - DM] * (1.0f + s); }
        __syncthreads();
        for (int i = 0; i < 4; ++i) {
            const int row = tile * 32 + F.wave * 4 + i;
            const f32x4* xr = (const f32x4*)(kin<I_X>() + (size_t)row * DM) + F.lane;
            f32x4 v[8]; float ss = 0.f;
#pragma unroll
            for (int j = 0; j < 8; ++j) { v[j] = xr[64 * j]; ss += (v[j][0] * v[j][0] + v[j][1] * v[j][1]) + (v[j][2] * v[j][2] + v[j][3] * v[j][3]); }
            const float rstd = 1.0f / sqrtf(wave_sum(ss) * (1.0f / DM) + EPS);
            unsigned long long* o8 = (unsigned long long*)(H + (size_t)row * DM) + F.lane;
#pragma unroll
            for (int j = 0; j < 8; ++j) { const f32x4 sc = *(const LAS f32x4*)(scaleL + 4 * F.lane + 256 * j), sh = *(const LAS f32x4*)(shiftL + 4 * F.lane + 256 * j);
                const f32x4 h = v[j] * rstd * sc + sh;
                o8[64 * j] = (unsigned long long)pk2(h[0], h[1]) | ((unsigned long long)pk2(h[2], h[3]) << 32); }
        }
    }
    __syncthreads();
}

template <int II> struct ConvLoop {
    static __device__ __forceinline__ void run(f32x2v (&acc)[32], const f32x2v (&w)[CONVW], const bf16* PROJ, int bb, int s0, int ch) {
        const int sin = s0 - 30 + II; const int sc = sin < 0 ? 0 : sin; const float ok = sin < 0 ? 0.f : 1.f;
        const bf16* rp = PROJ + (size_t)(bb * SEQ + sc) * NP + OFF_GLU + ch;
        const unsigned a2 = *(const unsigned*)rp, g2 = *(const unsigned*)(rp + DCONV);
        f32x2v u; u.x = ok * bf_lo(a2) * sigmoidf_fast(bf_lo(g2)); u.y = ok * bf_hi(a2) * sigmoidf_fast(bf_hi(g2));
        constexpr int lo = II > 30 ? II - 30 : 0, hi = II < 31 ? II : 31;
#pragma unroll
        for (int o = lo; o <= hi; ++o) acc[o] += w[II - o] * u;
        if ((II & 7) == 7) asm volatile("" ::: "memory");
        ConvLoop<II + 1>::run(acc, w, PROJ, bb, s0, ch);
    }
};
template <> struct ConvLoop<62> { static __device__ __forceinline__ void run(f32x2v (&)[32], const f32x2v (&)[CONVW], const bf16*, int, int, int) {} };

__device__ __forceinline__ void p2_small_tile(Frame& F, int tile) {
    const bf16* H = (const bf16*)(F.ws + WS_H); const bf16* BS = (const bf16*)(F.ws + WS_BT_IN) + (size_t)NP * DM;
    bf16* KI = (bf16*)(F.ws + WS_KI); float* WI = (float*)(F.ws + WS_WI);
    LAS float* red = (LAS float*)(F.lds + RING_OFF);
    const int lane = F.lane, r = lane & 31, hh = lane >> 5, row0 = 32 * tile, kb = 256 * F.wave + 8 * hh;
    const bf16* ap = H + (size_t)(row0 + r) * DM + kb;
    const bf16x8* bfp = (const bf16x8*)BS + lane;
    f32x16 acc[3];
#pragma unroll
    for (int cb = 0; cb < 3; ++cb) acc[cb] = (f32x16){0.f, 0.f, 0.f, 0.f, 0.f, 0.f, 0.f, 0.f, 0.f, 0.f, 0.f, 0.f, 0.f, 0.f, 0.f, 0.f};
#pragma unroll
    for (int s4 = 0; s4 < 4; ++s4) {
        bf16x8 a[4], b[4][3];
#pragma unroll
        for (int s = 0; s < 4; ++s) { a[s] = *(const bf16x8*)(ap + 16 * (4 * s4 + s));
#pragma unroll
            for (int cb = 0; cb < 3; ++cb) b[s][cb] = bfp[(size_t)((16 * F.wave + 4 * s4 + s) * 3 + cb) * 64]; }
        __builtin_amdgcn_sched_barrier(0);
#pragma unroll
        for (int s = 0; s < 4; ++s)
#pragma unroll
            for (int cb = 0; cb < 3; ++cb) acc[cb] = __builtin_amdgcn_mfma_f32_32x32x16_bf16(a[s], b[s][cb], acc[cb], 0, 0, 0);
    }
    __syncthreads();
#pragma unroll
    for (int cb = 0; cb < 3; ++cb)
#pragma unroll
        for (int g = 0; g < 16; ++g) red[((F.wave * 3 + cb) * 16 + g) * 64 + lane] = acc[cb][g];
    __syncthreads();
    for (int e = F.tid; e < 3 * 16 * 64; e += NWAVES * 64) {
        float sum = 0.f;
#pragma unroll
        for (int w = 0; w < 8; ++w) sum += red[w * 3072 + e];
        const int cb = e >> 10, g = (e >> 6) & 15, ln = e & 63, row = (g & 3) + 8 * (g >> 2) + 4 * (ln >> 5), col = 32 * cb + (ln & 31);
        if (col < 64) KI[(size_t)(row0 + row) * 64 + col] = (bf16)f2bf(sum);
        else if (col < 80) WI[(size_t)(row0 + row) * 16 + (col - 64)] = sum;
    }
    __syncthreads();
}

__device__ __forceinline__ void p3_conv_tile(Frame& F, int tile) {
    const bf16* PROJ = (const bf16*)(F.ws + WS_PROJ); bf16* CACT = (bf16*)(F.ws + WS_CACT);
    LAS float* red = (LAS float*)(F.lds + RING_OFF);
    LAS float* stat = red + 8 * 64;
    const int bb = tile / (SEQ / 32), s0 = (tile % (SEQ / 32)) * 32, ch = 2 * F.tid;
    f32x2v w[CONVW];
#pragma unroll
    for (int j = 0; j < CONVW; ++j) w[j] = *(const f32x2v*)(kin<I_WDW>() + j * DCONV + ch);
    f32x2v acc[32];
#pragma unroll
    for (int o = 0; o < 32; ++o) acc[o] = (f32x2v){0.f, 0.f};
    ConvLoop<0>::run(acc, w, PROJ, bb, s0, ch);
    const f32x2v bdw = *(const f32x2v*)(kin<I_BDW>() + ch);
    float vals[64];
#pragma unroll
    for (int o = 0; o < 32; ++o) { acc[o] += bdw; vals[2 * o] = acc[o].x + acc[o].y; vals[2 * o + 1] = acc[o].x * acc[o].x + acc[o].y * acc[o].y; }
#define BFLY(d, n) do { const bool up = (F.lane & (d)) != 0; _Pragma("unroll") for (int k = 0; k < (n); ++k) { const float send = up ? vals[k] : vals[k + (n)], keep = up ? vals[k + (n)] : vals[k]; vals[k] = keep + __shfl_xor(send, (d)); } } while (0)
    BFLY(32, 32); BFLY(16, 16); BFLY(8, 8); BFLY(4, 4); BFLY(2, 2); BFLY(1, 1);
#undef BFLY
    __syncthreads();
    red[F.wave * 64 + F.lane] = vals[0];
    __syncthreads();
    if (F.tid < 32) { float s = 0.f, q = 0.f;
#pragma unroll
        for (int wv = 0; wv < 8; ++wv) { s += red[wv * 64 + 2 * F.tid]; q += red[wv * 64 + 2 * F.tid + 1]; }
        const float mean = s * (1.0f / DCONV), var = q * (1.0f / DCONV) - mean * mean;
        stat[2 * F.tid] = mean; stat[2 * F.tid + 1] = 1.0f / sqrtf(var + EPS); }
    __syncthreads();
    const f32x2v gl = *(const f32x2v*)(kin<I_GLN>() + ch), bl = *(const f32x2v*)(kin<I_BLN>() + ch);
#pragma unroll
    for (int o = 0; o < 32; ++o) { const float mean = stat[2 * o], rstd = stat[2 * o + 1];
        const float z0 = (acc[o].x - mean) * rstd * gl.x + bl.x, z1 = (acc[o].y - mean) * rstd * gl.y + bl.y;
        *(unsigned*)(CACT + (size_t)(bb * SEQ + s0 + o) * DCONV + ch) = pg8::cvt_pk_bf16(z0 * sigmoidf_fast(z0), z1 * sigmoidf_fast(z1)); }
}

__device__ __forceinline__ void glds16s(const void* sbase, unsigned voff, unsigned lds_dst) { unsigned keep;
    asm volatile("s_mov_b32 %0, m0\n\ts_mov_b32 m0, %3\n\ts_nop 4\n\tglobal_load_lds_dwordx4 %1, %2\n\ts_mov_b32 m0, %0" : "=&s"(keep) : "v"(voff), "s"(sbase), "s"(lds_dst) : "memory"); }
__device__ __forceinline__ void p3_indexer_block(Frame& F, int bu) {
    const bf16* PROJ = (const bf16*)(F.ws + WS_PROJ); unsigned long long* MASK = (unsigned long long*)(F.ws + WS_MASK);
    const int bb = bu & 1, blk = bu >> 1, q0 = bb * SEQ + 16 * blk, nj = (blk >> 2) + 1, ntile = 2 * nj, nstage = (nj + 3) >> 2;
    const int lane = F.lane, rho = lane & 31, hh = lane >> 5, e = (rho >> 2) & 1, hd = (rho & 3) + 4 * (rho >> 3);
    const int qw = q0 + 2 * F.wave;
    bf16x8 A[4];
    { const bf16* qrow = PROJ + (size_t)(qw + e) * NP + OFF_QI + hd * 64 + 8 * hh;
#pragma unroll
      for (int s = 0; s < 4; ++s) A[s] = *(const bf16x8*)(qrow + 16 * s); }
    float wv[16];
    { const f32x4* wrow = (const f32x4*)((const float*)(F.ws + WS_WI) + (size_t)(qw + hh) * 16);
      const float sc = 0.03125f;
#pragma unroll
      for (int i = 0; i < 4; ++i) { const f32x4 w4 = wrow[i]; wv[4 * i] = w4[0] * sc; wv[4 * i + 1] = w4[1] * sc; wv[4 * i + 2] = w4[2] * sc; wv[4 * i + 3] = w4[3] * sc; } }
    const bf16* ksrc = (const bf16*)(F.ws + WS_KI) + (size_t)(bb * SEQ + 32 * F.wave) * 64;
    const unsigned kvoff = (unsigned)((lane >> 3) * 128 + (((lane & 7) ^ (lane >> 3)) << 4));
    const unsigned ldsb = (unsigned)(uintptr_t)(F.lds + RING_OFF) + (unsigned)F.wave * 4096u;
#define IDX_DMA(st, slotoff) do { _Pragma("unroll") for (int i_ = 0; i_ < 4; ++i_) glds16s(ksrc + (size_t)(256 * (st) + 8 * i_) * 64, kvoff, (unsigned)__builtin_amdgcn_readfirstlane(ldsb + (unsigned)((slotoff) + i_ * 1024))); } while (0)
    int sl_cur = 0, sl_nn = 65536;
    const LAS unsigned char* rdp = F.lds + RING_OFF + rho * 128;
    const int sw = rho & 7;
    unsigned key[64];
#pragma unroll
    for (int j = 0; j < 64; ++j) key[j] = 0u;
    for (int rp_ = 0; rp_ < (DUP_SUB == 3 ? 2 : 1); ++rp_) {
    if (rp_) asm volatile("s_waitcnt vmcnt(0) lgkmcnt(0)\n\ts_barrier" ::: "memory");
    IDX_DMA(0, 0);
    if (nstage > 1) IDX_DMA(1, 32768);
    sl_cur = 0; sl_nn = 65536;
    for (int g = 0; g < nstage; ++g) {
        if (g + 1 < nstage) asm volatile("s_waitcnt vmcnt(4) lgkmcnt(0)\n\ts_barrier" ::: "memory"); else asm volatile("s_waitcnt vmcnt(0) lgkmcnt(0)\n\ts_barrier" ::: "memory");
        if (g + 2 < nstage) IDX_DMA(g + 2, sl_nn);
        unsigned tk[8];
#pragma unroll
        for (int h4 = 0; h4 < 2; ++h4) {
            f32x16 acc[4];
#pragma unroll
            for (int t = 0; t < 4; ++t) acc[t] = (f32x16){0.f, 0.f, 0.f, 0.f, 0.f, 0.f, 0.f, 0.f, 0.f, 0.f, 0.f, 0.f, 0.f, 0.f, 0.f, 0.f};
#pragma unroll
            for (int s = 0; s < 4; ++s) {
                bf16x8 B[4];
#pragma unroll
                for (int t = 0; t < 4; ++t) B[t] = *(const LAS bf16x8*)(rdp + sl_cur + (4 * h4 + t) * 4096 + (((2 * s + hh) ^ sw) << 4));
#pragma unroll
                for (int t = 0; t < 4; ++t) acc[t] = __builtin_amdgcn_mfma_f32_32x32x16_bf16(A[s], B[t], acc[t], 0, 0, 0);
            }
#pragma unroll
            for (int t = 0; t < 4; ++t) {
                const int kt = 8 * g + 4 * h4 + t;
                float v4[4] = {0.f, 0.f, 0.f, 0.f};
#pragma unroll
                for (int r = 0; r < 16; ++r) { const float xr = acc[t][r]; const int ai = __float_as_int(xr); const int ri = ai > 0 ? ai : 0; v4[r & 3] += wv[r] * __int_as_float(ri); }
                const float v = (v4[0] + v4[1]) + (v4[2] + v4[3]);
                const unsigned kk = (unsigned)((int)fminf(fmaxf(v * 4096.0f, -32767.0f), 32767.0f) + 32768);
                tk[4 * h4 + t] = (kt < ntile) ? kk : 0u;
                asm volatile("" : "+v"(tk[4 * h4 + t]));
            }
            __builtin_amdgcn_sched_barrier(0);
        }
        unsigned pk[4];
#pragma unroll
        for (int i = 0; i < 4; ++i) pk[i] = tk[2 * i] | (tk[2 * i + 1] << 16);
#define KCASE(G) case G: _Pragma("unroll") for (int i = 0; i < 4; ++i) key[4 * G + i] = pk[i]; break;
        switch (g) { KCASE(0) KCASE(1) KCASE(2) KCASE(3) KCASE(4) KCASE(5) KCASE(6) KCASE(7) KCASE(8) KCASE(9) KCASE(10) KCASE(11) KCASE(12) KCASE(13) KCASE(14) KCASE(15) default: break; }
#undef KCASE
        sl_nn = sl_cur; sl_cur = (sl_cur == 65536) ? 0 : sl_cur + 32768;
    }
    }
#undef IDX_DMA
    unsigned TA = 1u, TB = 1u;
    for (int rp_ = 0; rp_ < (DUP_SUB == 4 ? 2 : 1); ++rp_)
    if (nj * 64 > TOPK) {
        TA = 0u; TB = 0u; bool doneA = false, doneB = false;
        for (int bit = 15; bit >= 0; --bit) {
            const unsigned candA = TA | (1u << bit), candB = TB | (1u << bit);
            const unsigned cand16 = (hh ? candB : candA) << 16; int cnt = 0;
#pragma unroll
            for (int g = 0; g < 16; ++g) if (g < nstage) {
#pragma unroll
                for (int i = 0; i < 4; ++i) { const unsigned p = key[4 * g + i]; cnt += (p >= cand16) ? 1 : 0; cnt += ((p << 16) >= cand16) ? 1 : 0; } }
            cnt += __builtin_amdgcn_update_dpp(0, cnt, 0xB1, 0xF, 0xF, false);
            cnt += __builtin_amdgcn_update_dpp(0, cnt, 0x4E, 0xF, 0xF, false);
            cnt += __builtin_amdgcn_update_dpp(0, cnt, 0x141, 0xF, 0xF, false);
            cnt += __builtin_amdgcn_update_dpp(0, cnt, 0x140, 0xF, 0xF, false);
            const int cA = __builtin_amdgcn_readlane(cnt, 0) + __builtin_amdgcn_readlane(cnt, 16), cB = __builtin_amdgcn_readlane(cnt, 32) + __builtin_amdgcn_readlane(cnt, 48);
            if (!doneA) { if (cA >= TOPK) TA = candA; if (cA == TOPK) doneA = true; }
            if (!doneB) { if (cB >= TOPK) TB = candB; if (cB == TOPK) doneB = true; }
            if (doneA && doneB) break;
        }
    }
    const unsigned T16 = (hh ? TB : TA) << 16;
    unsigned a_lo = 0u, a_hi = 0u, b_lo = 0u, b_hi = 0u;
#pragma unroll
    for (int g = 0; g < 16; ++g) if (g < nstage) {
#pragma unroll
        for (int i = 0; i < 4; ++i) { const unsigned p = key[4 * g + i];
            const unsigned long long m0 = __ballot((p << 16) >= T16), m1 = __ballot(p >= T16);
            if (lane == 4 * g + i) { a_lo = (unsigned)m0; b_lo = (unsigned)(m0 >> 32); a_hi = (unsigned)m1; b_hi = (unsigned)(m1 >> 32); } } }
    MASK[(size_t)qw * 64 + lane] = (unsigned long long)a_lo | ((unsigned long long)a_hi << 32);
    MASK[(size_t)(qw + 1) * 64 + lane] = (unsigned long long)b_lo | ((unsigned long long)b_hi << 32);
    asm volatile("s_waitcnt vmcnt(0) lgkmcnt(0)\n\ts_barrier" ::: "memory");
}

__device__ __forceinline__ void p7_rows(Frame& F) {
    const float* modf = (const float*)(F.ws + WS_MODF); bf16* H = (bf16*)(F.ws + WS_H);
    LAS float* A1 = (LAS float*)(F.lds + RING_OFF); LAS float* S2 = A1 + DM; LAS float* T2 = S2 + DM;
    for (int tile = F.bid; tile < MTOK / 32; tile += F.G) {
        const int bb = tile / (SEQ / 32);
        __syncthreads();
        for (int j = 0; j < 4; ++j) { const int col = F.tid + 512 * j;
            A1[col] = modf[bb * NMOD + 2 * DM + col] * kin<I_GPOSTMIX>()[col];
            S2[col] = kin<I_GPREFFN>()[col] * (1.0f + modf[bb * NMOD + 4 * DM + col]);
            T2[col] = modf[bb * NMOD + 3 * DM + col]; }
        __syncthreads();
        for (int i = 0; i < 4; ++i) {
            const int row = tile * 32 + F.wave * 4 + i;
            const f32x4* xr = (const f32x4*)(kin<I_X>() + (size_t)row * DM) + F.lane;
            f32x4* mr = (f32x4*)(F.out + (size_t)row * DM) + F.lane;
            f32x4 mv[8], xv[8]; float ss = 0.f;
#pragma unroll
            for (int j = 0; j < 8; ++j) { mv[j] = mr[64 * j]; xv[j] = xr[64 * j]; ss += (mv[j][0] * mv[j][0] + mv[j][1] * mv[j][1]) + (mv[j][2] * mv[j][2] + mv[j][3] * mv[j][3]); }
            const float rstd = 1.0f / sqrtf(wave_sum(ss) * (1.0f / DM) + EPS);
            float s1 = 0.f;
#pragma unroll
            for (int j = 0; j < 8; ++j) { const f32x4 a = *(const LAS f32x4*)(A1 + 4 * F.lane + 256 * j); xv[j] = xv[j] + mv[j] * rstd * a;
                s1 += (xv[j][0] * xv[j][0] + xv[j][1] * xv[j][1]) + (xv[j][2] * xv[j][2] + xv[j][3] * xv[j][3]); mr[64 * j] = xv[j]; }
            const float rstd1 = 1.0f / sqrtf(wave_sum(s1) * (1.0f / DM) + EPS);
            unsigned long long* o8 = (unsigned long long*)(H + (size_t)row * DM) + F.lane;
#pragma unroll
            for (int j = 0; j < 8; ++j) { const f32x4 sc = *(const LAS f32x4*)(S2 + 4 * F.lane + 256 * j), sh = *(const LAS f32x4*)(T2 + 4 * F.lane + 256 * j);
                const f32x4 h = xv[j] * rstd1 * sc + sh;
                o8[64 * j] = (unsigned long long)pk2(h[0], h[1]) | ((unsigned long long)pk2(h[2], h[3]) << 32); }
        }
    }
    __syncthreads();
}
__device__ __forceinline__ void p10_rows(Frame& F) {
    const float* modf = (const float*)(F.ws + WS_MODF); const float* Fb = (const float*)(F.ws + WS_F);
    LAS float* A2 = (LAS float*)(F.lds + RING_OFF);
    for (int tile = F.bid; tile < MTOK / 32; tile += F.G) {
        const int bb = tile / (SEQ / 32);
        __syncthreads();
        for (int j = 0; j < 4; ++j) { const int col = F.tid + 512 * j; A2[col] = modf[bb * NMOD + 5 * DM + col] * kin<I_GPOSTFFN>()[col]; }
        __syncthreads();
        for (int i = 0; i < 4; ++i) {
            const int row = tile * 32 + F.wave * 4 + i;
            const f32x4* fr = (const f32x4*)(Fb + (size_t)row * DM) + F.lane;
            f32x4* orow = (f32x4*)(F.out + (size_t)row * DM) + F.lane;
            f32x4 fv[8], xv[8]; float ss = 0.f;
#pragma unroll
            for (int j = 0; j < 8; ++j) { fv[j] = fr[64 * j]; xv[j] = orow[64 * j]; ss += (fv[j][0] * fv[j][0] + fv[j][1] * fv[j][1]) + (fv[j][2] * fv[j][2] + fv[j][3] * fv[j][3]); }
            const float rstd = 1.0f / sqrtf(wave_sum(ss) * (1.0f / DM) + EPS);
#pragma unroll
            for (int j = 0; j < 8; ++j) { const f32x4 a = *(const LAS f32x4*)(A2 + 4 * F.lane + 256 * j); orow[64 * j] = xv[j] + fv[j] * rstd * a; }
        }
    }
}

#ifndef MK_N_LAUNCHES
#define MK_N_LAUNCHES 1
#endif
constexpr int N_PHASES = 11;
struct Args { const float* in[19]; float* out; unsigned char* ws; int ph_lo, ph_hi; };
__global__ void __launch_bounds__(NWAVES * 64, 2) mk_fwd(Args args) {
    extern __shared__ __attribute__((aligned(16))) unsigned char lds[];
    Frame F;
    F.lds = (LAS unsigned char*)lds;
    F.MISC = (volatile LAS unsigned*)(F.lds + MISC_OFF);
    F.tid = threadIdx.x; F.lane = F.tid & 63; F.wave = __builtin_amdgcn_readfirstlane(F.tid >> 6);
    F.G = gridDim.x; F.bid = blockIdx.x;
    F.ws = args.ws; F.out = args.out; F.ctl = (gu32*)(args.ws + WS_CTL);
    for (int u = F.tid; u < (LDS_BYTES - LDSCTL_OFF) / 4; u += NWAVES * 64) ((LAS unsigned*)(F.lds + LDSCTL_OFF))[u] = 0u;
    __syncthreads();
    XcdBarrier bar; bar.bar = (unsigned*)(F.ctl + CW_BAR); bar.x = 0; bar.st = nullptr;
    if (MK_N_LAUNCHES == 1) bar = xcd_barrier_post((unsigned*)(F.ctl + CW_BAR), F.MISC + 8);
    const int lo = args.ph_lo, hi = args.ph_hi;
#define IN(k) (lo <= (k) && (k) < hi)
#define SEAM(k) do { if (IN(k) && IN((k) + 1)) xcd_barrier(bar); } while (0)
#ifndef DUP_PHASE
#define DUP_PHASE (-1)
#endif
#define PH(k) if (IN(k)) for (int rep_ = 0; rep_ < ((k) == DUP_PHASE ? 2 : 1); ++rep_)
#define REP_BAR() do { if (rep_) xcd_barrier(bar); } while (0)
    bf16* H = (bf16*)(F.ws + WS_H); bf16* PROJ = (bf16*)(F.ws + WS_PROJ);
    const int gw = F.bid * NWAVES + F.wave, NGW = F.G * NWAVES;

    PH(0) { REP_BAR(); p0_prologue(F); } SEAM(0);
    PH(1) { REP_BAR(); p1_h1(F); } SEAM(1);
    PH(2) { REP_BAR();
        pg8::Gemm g{H, (const bf16*)(F.ws + WS_BT_IN), MTOK, NP, DM}; pg8::StaticOrder S; S.init(MTOK, NP, F.G, F.bid);
        EpiStoreBf16 E{PROJ, NP, OFF_Q, OFF_K, attn_body::C2};
        pg8::gemm_phase<EpiStoreBf16, pg8::StaticOrder, true, true>(F.lds + RING_OFF, g, S, E);
#if DUP_SUB == 6
        pg8::gemm_phase<EpiStoreBf16, pg8::StaticOrder, true, true>(F.lds + RING_OFF, g, S, E);
#endif
        for (int rs_ = 0; rs_ < (DUP_SUB == 5 ? 2 : 1); ++rs_)
        for (int tile = F.bid; tile < MTOK / 32; tile += F.G) p2_small_tile(F, tile);
    } SEAM(2);
    PH(3) { REP_BAR();
        for (int rs_ = 0; rs_ < (DUP_SUB == 1 ? 2 : 1); ++rs_)
        for (int tile = F.bid; tile < MTOK / 32; tile += F.G) p3_conv_tile(F, tile);
        __syncthreads();
        for (int rs_ = 0; rs_ < (DUP_SUB == 2 ? 2 : 1); ++rs_)
        for (int pu = F.bid; pu < 256; pu += F.G) for (int half = 0; half < 2; ++half) p3_indexer_block(F, half ? 511 - pu : pu);
    } SEAM(3);
    PH(4) { REP_BAR();
        static_assert(attn_body::ATTN_LDS_BYTES <= RING_BYTES, "attention LDS");
        const attn_body::AttnTensors AT{(const attn_body::bf16*)(PROJ + OFF_Q), (const attn_body::bf16*)(PROJ + OFF_K), (const attn_body::bf16*)(PROJ + OFF_V), (attn_body::bf16*)(F.ws + WS_AOUT), (const unsigned*)(F.ws + WS_MASK)};
        const attn_body::StaticOrder S(F.G, F.bid);
        attn_body::attn_phase<attn_body::StaticOrder>((char*)lds + RING_OFF, AT, S);
    } SEAM(4);
    PH(5) { REP_BAR();
        { pg8::Gemm g{(const bf16*)(F.ws + WS_CACT), (const bf16*)(F.ws + WS_BT_CO), MTOK, DM, DCONV}; pg8::StaticOrder S; S.init(MTOK, DM, F.G, F.bid);
          EpiGateConv E{F.out, PROJ + OFF_G, NP};
          pg8::gemm_phase<EpiGateConv, pg8::StaticOrder, true, true>(F.lds + RING_OFF, g, S, E); }
        { pg8::Gemm g{(const bf16*)(F.ws + WS_AOUT), (const bf16*)(F.ws + WS_BT_AO), MTOK, DM, DCONV}; pg8::StaticOrder S; S.init(MTOK, DM, F.G, F.bid);
          EpiGateAttn E{F.out, PROJ + OFF_G + DM, NP, (bf16*)(F.ws + WS_MERGED)};
          pg8::gemm_phase<EpiGateAttn, pg8::StaticOrder, true, true>(F.lds + RING_OFF, g, S, E);
#if DUP_SUB == 7
          pg8::gemm_phase<EpiGateAttn, pg8::StaticOrder, true, true>(F.lds + RING_OFF, g, S, E);
#endif
        }
    } SEAM(5);
    PH(6) { REP_BAR();
        pg8::Gemm g{(const bf16*)(F.ws + WS_MERGED), (const bf16*)(F.ws + WS_BT_O), MTOK, DM, DM}; pg8::StaticOrder S; S.init(MTOK, DM, F.G, F.bid);
        EpiStoreF32 E{F.out, DM};
        pg8::gemm_phase<EpiStoreF32, pg8::StaticOrder, true, true>(F.lds + RING_OFF, g, S, E);
    } SEAM(6);
    PH(7) { REP_BAR(); p7_rows(F); } SEAM(7);
    PH(8) { REP_BAR();
        pg8::Gemm g{H, (const bf16*)(F.ws + WS_BT_GU), MTOK, NGU, DM}; pg8::StaticOrder S; S.init(MTOK, NGU, F.G, F.bid);
        EpiSwiGLU E{(bf16*)(F.ws + WS_GU)};
        pg8::gemm_phase<EpiSwiGLU, pg8::StaticOrder, true, true>(F.lds + RING_OFF, g, S, E);
#if DUP_SUB == 9
        pg8::gemm_phase<EpiSwiGLU, pg8::StaticOrder, true, true>(F.lds + RING_OFF, g, S, E);
#endif
    } SEAM(8);
    PH(9) { REP_BAR();
        pg8::Gemm g{(const bf16*)(F.ws + WS_GU), (const bf16*)(F.ws + WS_BT_DN), MTOK, DM, DFF}; pg8::StaticOrder S; S.init(MTOK, DM, F.G, F.bid);
        EpiStoreF32 E{(float*)(F.ws + WS_F), DM};
        pg8::gemm_phase<EpiStoreF32, pg8::StaticOrder, true, true>(F.lds + RING_OFF, g, S, E);
    } SEAM(9);
#if DUP_SUB == 11
    for (int rb_ = 0; rb_ < 10; ++rb_) xcd_barrier(bar);
#endif
    PH(10) { REP_BAR(); p10_rows(F); }
#undef IN
#undef SEAM
}

extern "C" void kernel_launch(void* const* d_in, const int* in_sizes, int n_in, void* d_out, int out_size, void* d_ws, size_t ws_size, hipStream_t stream) {
    static int grid = 0;
    if (grid == 0) {
        if (n_in != 19 || in_sizes[0] != MTOK * DM || out_size != MTOK * DM || ws_size < WS_END) { fprintf(stderr, "kernel_launch: unexpected shapes / workspace (n_in %d, in0 %d, out %d, ws %zu < %zu)\n", n_in, n_in > 0 ? in_sizes[0] : -1, out_size, ws_size, (size_t)WS_END); grid = -1; return; }
        int dev = 0, cus = 0, per_cu = 0;
        if (hipGetDevice(&dev) != hipSuccess || hipDeviceGetAttribute(&cus, hipDeviceAttributeMultiprocessorCount, dev) != hipSuccess) { grid = -1; return; }
        if (hipFuncSetAttribute((const void*)mk_fwd, hipFuncAttributeMaxDynamicSharedMemorySize, LDS_BYTES) != hipSuccess) { fprintf(stderr, "kernel_launch: hipFuncSetAttribute failed\n"); grid = -1; return; }
        if (hipOccupancyMaxActiveBlocksPerMultiprocessor(&per_cu, (const void*)mk_fwd, NWAVES * 64, LDS_BYTES) != hipSuccess || per_cu < 1) { fprintf(stderr, "kernel_launch: occupancy query says %d blocks per CU\n", per_cu); (void)hipGetLastError(); grid = -1; return; }
        grid = cus;
    }
    if (grid < 0) return;
    if (hipMemsetAsync((char*)d_ws + WS_CTL, 0, CTL_ZERO_BYTES, stream) != hipSuccess) return;
    Args a{};
    for (int i = 0; i < 19; ++i) a.in[i] = (const float*)d_in[i];
    a.out = (float*)d_out; a.ws = (unsigned char*)d_ws;
#if MK_N_LAUNCHES == 1
    a.ph_lo = 0; a.ph_hi = N_PHASES;
    hipLaunchKernelGGL(mk_fwd, dim3(grid), dim3(NWAVES * 64), LDS_BYTES, stream, a);
#else
    for (int p = 0; p < N_PHASES; ++p) { a.ph_lo = p; a.ph_hi = p + 1; hipLaunchKernelGGL(mk_fwd, dim3(grid), dim3(NWAVES * 64), LDS_BYTES, stream, a); }
#endif
}
```
